# Optimizing an MI355X kernel written in HIP

```python
import math
import jax, jax.numpy as jnp
from jax import lax
import numpy as np


D_MODEL = 1024
BATCH = 16
SEQ = 2048
DEPTH = 2
DEC_BATCH = 8
DEC_SEQ = 8192
PAST_LEN = 128

D_PLE = 256
RW_HEADS = 8
RW_HEAD_DIM = 64
RW_WIDTH = RW_HEADS * RW_HEAD_DIM
W_LORA = 64
A_LORA = 64
RW_CONV_COLS = 3 * RW_WIDTH + 2 * W_LORA + A_LORA
DA_HEADS = 4
DA_QK_DIM = 64
DA_V_DIM = 2 * DA_QK_DIM
DA_WIDTH = DA_HEADS * DA_V_DIM
MIX_WIDTH = RW_WIDTH + DA_WIDTH
IN_COLS = RW_CONV_COLS + RW_WIDTH + 4 * DA_WIDTH
CONV_WIDTH = 3
Q_BLOCK = 128
NORM_EPS = 1e-6
LN_X_EPS = 64e-5
KK_EPS = 1e-12
ALIBI_MAX_BIAS = 8.0

kernel_name = 'hybrid_rwkv7_diffattn_encoder'


def rmsnorm(x, g, eps=NORM_EPS):
    xf = x.astype(jnp.float32)
    y = xf * lax.rsqrt(jnp.mean(xf * xf, axis=-1, keepdims=True) + eps)
    return (y * g.astype(jnp.float32)).astype(x.dtype)


def centred_conv(x, w, b):
    pad = CONV_WIDTH // 2
    S = x.shape[1]
    xp = jnp.pad(x, ((0, 0), (pad, pad), (0, 0)))
    out = b
    for i in range(CONV_WIDTH):
        out = out + xp[:, i:i + S] * w[i]
    return out


def both_dirs(t):
    tm = jnp.moveaxis(t, 1, 0)
    return jnp.stack([tm, tm[::-1]], axis=1)


def rwkv7_mixer(c, w0, w_up, a0, a_up, k_k, k_a, r_k, ln_g, ln_b):
    f32 = jnp.float32
    B, S, _ = c.shape
    H, N = RW_HEADS, RW_HEAD_DIM
    o = 3 * RW_WIDTH
    r = c[..., :RW_WIDTH].astype(f32).reshape(B, S, H, N)
    k = c[..., RW_WIDTH:2 * RW_WIDTH].astype(f32).reshape(B, S, H, N)
    v = c[..., 2 * RW_WIDTH:o].astype(f32).reshape(B, S, H, N)
    zw = c[..., o:o + 2 * W_LORA].astype(f32).reshape(B, S, 2, W_LORA)
    za = c[..., o + 2 * W_LORA:].astype(f32)
    w_logit = w0.astype(f32) + jnp.einsum('bsdr,drc->bsdc', jnp.tanh(zw), w_up.astype(f32))
    decay = jnp.exp(-jnp.exp(-jax.nn.softplus(-w_logit) - 0.5)).reshape(B, S, 2, H, N)
    a = jax.nn.sigmoid(a0.astype(f32) + za @ a_up.astype(f32)).reshape(B, S, H, N)
    kk = k * k_k.astype(f32).reshape(H, N)
    kk = kk * lax.rsqrt(jnp.sum(kk * kk, axis=-1, keepdims=True) + KK_EPS)
    k = k * (1.0 + (a - 1.0) * k_a.astype(f32).reshape(H, N))
    dtm = jnp.moveaxis(decay, 1, 0)
    w_s = jnp.stack([dtm[:, :, 0], dtm[::-1, :, 1]], axis=1)
    xs = (both_dirs(r), w_s, both_dirs(k), both_dirs(v), both_dirs(-kk), both_dirs(kk * a))

    def step(state, inp):
        r_t, w_t, k_t, v_t, a_t, b_t = inp
        sa = jnp.einsum('dbhij,dbhj->dbhi', state, a_t)
        state = (state * w_t[..., None, :] + sa[..., :, None] * b_t[..., None, :]
                 + v_t[..., :, None] * k_t[..., None, :])
        y_t = jnp.einsum('dbhij,dbhj->dbhi', state, r_t)
        return state, y_t

    state0 = jnp.zeros((2, B, H, N, N), f32)
    _, ys = lax.scan(step, state0, xs)
    y = jnp.moveaxis(ys[:, 0] + ys[::-1, 1], 0, 1)
    mu = jnp.mean(y, axis=-1, keepdims=True)
    var = jnp.mean(jnp.square(y - mu), axis=-1, keepdims=True)
    y = ((y - mu) * lax.rsqrt(var + LN_X_EPS) * ln_g.astype(f32).reshape(H, N)
         + ln_b.astype(f32).reshape(H, N))
    bonus = jnp.sum(r * k * r_k.astype(f32), axis=-1, keepdims=True) * v
    return (y + bonus).reshape(B, S, RW_WIDTH)


def diff_attention_mixer(q, k, v, q_norm, k_norm, lam_vec, subln, lam_init):
    f32 = jnp.float32
    B, S, _ = q.shape
    H, d, dv = DA_HEADS, DA_QK_DIM, DA_V_DIM
    q = rmsnorm(q.reshape(B, S, H, 2, d), q_norm) * (d ** -0.5)
    k = rmsnorm(k.reshape(B, S, H, 2, d), k_norm)
    v = v.reshape(B, S, H, dv)
    lv = lam_vec.astype(f32)
    lam = jnp.exp(jnp.sum(lv[0] * lv[1])) - jnp.exp(jnp.sum(lv[2] * lv[3])) + lam_init
    slopes = 2.0 ** (-ALIBI_MAX_BIAS * jnp.arange(1, H + 1, dtype=f32) / H)
    nb = S // Q_BLOCK
    q_blocks = jnp.moveaxis(q.reshape(B, nb, Q_BLOCK, H, 2, d), 1, 0)
    starts = jnp.arange(nb, dtype=jnp.int32) * Q_BLOCK
    kpos = jnp.arange(S, dtype=jnp.int32)

    def attend(args):
        qb, q0 = args
        s = jnp.einsum('bqhmd,bkhmd->bhmqk', qb, k, preferred_element_type=f32)
        qpos = q0 + jnp.arange(Q_BLOCK, dtype=jnp.int32)
        dist = jnp.abs(qpos[:, None] - kpos[None, :]).astype(f32)
        s = s - slopes[None, :, None, None, None] * dist
        pr = jax.nn.softmax(s, axis=-1)
        att = pr[:, :, 0] - lam * pr[:, :, 1]
        return jnp.einsum('bhqk,bkhe->bqhe', att.astype(v.dtype), v)

    o = lax.map(attend, (q_blocks, starts))
    o = jnp.moveaxis(o, 0, 1).reshape(B, S, H, dv)
    o = rmsnorm(o, subln) * (1.0 - lam_init)
    return o.reshape(B, S, DA_WIDTH)


def hybrid_layer(h, p_i, lam_init, prm):
    u = rmsnorm(h, prm['norm_pre'])
    proj = u @ prm['w_in']
    o0 = RW_CONV_COLS
    o1 = o0 + RW_WIDTH
    o2 = o1 + DA_WIDTH
    o3 = o2 + DA_WIDTH
    o4 = o3 + DA_WIDTH
    c = centred_conv(proj[..., :o0], prm['rw_conv_w'], prm['rw_conv_b'])
    y_rw = rwkv7_mixer(c, prm['rw_w0'], prm['rw_w_up'], prm['rw_a0'], prm['rw_a_up'],
                       prm['rw_k_k'], prm['rw_k_a'], prm['rw_r_k'], prm['rw_ln_g'], prm['rw_ln_b'])
    y_rw = y_rw.astype(h.dtype) * jax.nn.silu(proj[..., o0:o1])
    y_da = diff_attention_mixer(proj[..., o1:o2], proj[..., o2:o3], proj[..., o3:o4],
                                prm['da_q_norm'], prm['da_k_norm'], prm['da_lambda'],
                                prm['da_subln'], lam_init)
    y_da = y_da.astype(h.dtype) * jax.nn.silu(proj[..., o4:])
    h = h + jnp.concatenate([y_rw, y_da], axis=-1) @ prm['w_out']
    e = rmsnorm(p_i @ prm['ple_proj'], prm['ple_norm'])
    gate = jax.nn.sigmoid(h @ prm['ple_gate_w'] + prm['ple_gate_b'])
    return h + gate * e


def run_trunk(x, p, params):
    h = x
    for i in range(DEPTH):
        prm = {name: arr[i] for name, arr in params.items()}
        lam_init = 0.8 - 0.6 * math.exp(-0.3 * i)
        h = hybrid_layer(h, p[i], lam_init, prm)
    return h


def setup_inputs(seed: int = 0) -> dict:
    key = jax.random.key(seed)
    ks = jax.random.split(key, 32)
    f32 = jnp.float32

    def nrm(k, shape, s):
        return s * jax.random.normal(k, shape, f32)

    return {
        'x_prompt': nrm(ks[0], (BATCH, SEQ, D_MODEL), 1.0),
        'x_sample': nrm(ks[1], (DEC_BATCH, DEC_SEQ, D_MODEL), 1.0),
        'p_prompt': nrm(ks[2], (DEPTH, BATCH, SEQ, D_PLE), 1.0),
        'p_sample': nrm(ks[3], (DEPTH, DEC_BATCH, DEC_SEQ, D_PLE), 1.0),
        'norm_pre': 1.0 + nrm(ks[4], (DEPTH, D_MODEL), 0.05),
        'w_in': nrm(ks[5], (DEPTH, D_MODEL, IN_COLS), D_MODEL ** -0.5),
        'w_out': nrm(ks[6], (DEPTH, MIX_WIDTH, D_MODEL), MIX_WIDTH ** -0.5),
        'rw_conv_w': jnp.array([0.25, 1.0, 0.25], f32)[None, :, None]
                     + nrm(ks[7], (DEPTH, CONV_WIDTH, RW_CONV_COLS), 0.05),
        'rw_conv_b': nrm(ks[8], (DEPTH, RW_CONV_COLS), 0.01),
        'rw_w0': nrm(ks[9], (DEPTH, 2, RW_WIDTH), 1.0) - 0.5,
        'rw_w_up': nrm(ks[10], (DEPTH, 2, W_LORA, RW_WIDTH), 0.5 * W_LORA ** -0.5),
        'rw_a0': nrm(ks[11], (DEPTH, RW_WIDTH), 0.1),
        'rw_a_up': nrm(ks[12], (DEPTH, A_LORA, RW_WIDTH), 0.5 * A_LORA ** -0.5),
        'rw_k_k': 0.85 + nrm(ks[13], (DEPTH, RW_WIDTH), 0.05),
        'rw_k_a': 1.0 + nrm(ks[14], (DEPTH, RW_WIDTH), 0.05),
        'rw_r_k': nrm(ks[15], (DEPTH, RW_HEADS, RW_HEAD_DIM), 0.1),
        'rw_ln_g': 1.0 + nrm(ks[16], (DEPTH, RW_WIDTH), 0.05),
        'rw_ln_b': nrm(ks[17], (DEPTH, RW_WIDTH), 0.01),
        'da_q_norm': 1.0 + nrm(ks[18], (DEPTH, 2, DA_QK_DIM), 0.05),
        'da_k_norm': 1.0 + nrm(ks[19], (DEPTH, 2, DA_QK_DIM), 0.05),
        'da_lambda': nrm(ks[20], (DEPTH, 4, DA_QK_DIM), 0.1),
        'da_subln': 1.0 + nrm(ks[21], (DEPTH, DA_V_DIM), 0.05),
        'ple_proj': nrm(ks[22], (DEPTH, D_PLE, D_MODEL), D_PLE ** -0.5),
        'ple_norm': 1.0 + nrm(ks[23], (DEPTH, D_MODEL), 0.05),
        'ple_gate_w': nrm(ks[24], (DEPTH, D_MODEL, D_MODEL), D_MODEL ** -0.5),
        'ple_gate_b': nrm(ks[25], (DEPTH, D_MODEL), 0.01),
    }


def reference(x_prompt, x_sample, p_prompt, p_sample, norm_pre, w_in, w_out,
              rw_conv_w, rw_conv_b, rw_w0, rw_w_up, rw_a0, rw_a_up, rw_k_k, rw_k_a, rw_r_k,
              rw_ln_g, rw_ln_b, da_q_norm, da_k_norm, da_lambda, da_subln,
              ple_proj, ple_norm, ple_gate_w, ple_gate_b):
    params = dict(norm_pre=norm_pre, w_in=w_in, w_out=w_out,
                  rw_conv_w=rw_conv_w, rw_conv_b=rw_conv_b, rw_w0=rw_w0, rw_w_up=rw_w_up,
                  rw_a0=rw_a0, rw_a_up=rw_a_up, rw_k_k=rw_k_k, rw_k_a=rw_k_a, rw_r_k=rw_r_k,
                  rw_ln_g=rw_ln_g, rw_ln_b=rw_ln_b, da_q_norm=da_q_norm, da_k_norm=da_k_norm,
                  da_lambda=da_lambda, da_subln=da_subln, ple_proj=ple_proj, ple_norm=ple_norm,
                  ple_gate_w=ple_gate_w, ple_gate_b=ple_gate_b)
    y_prompt = run_trunk(x_prompt, p_prompt, params)
    y_sample = run_trunk(x_sample, p_sample, params)
    return (y_prompt, y_sample)
```

```cpp
#include <hip/hip_runtime.h>
#include <hip/hip_cooperative_groups.h>
#include <cstdio>
namespace cg = cooperative_groups;

#define DI __device__ __forceinline__
typedef __attribute__((ext_vector_type(8))) short bf16x8;
typedef __attribute__((ext_vector_type(16))) float f32x16;
typedef __attribute__((ext_vector_type(4))) float f32x4;
typedef __attribute__((ext_vector_type(2))) float f32x2;
typedef __attribute__((ext_vector_type(4))) unsigned u32x4;
typedef __attribute__((ext_vector_type(2))) unsigned u32x2;
typedef unsigned short bf16_t;
#define MFMA(a, b, c) __builtin_amdgcn_mfma_f32_32x32x16_bf16((a), (b), (c), 0, 0, 0)

constexpr int DM = 1024;
constexpr int NP = 16 * 2048;
constexpr int NS = 8 * 8192;
constexpr int NTOK = NP + NS;
constexpr int DPLE = 256;
constexpr int IN_COLS = 4288;
constexpr int NIN = 4352;
constexpr int CRW = 1792;
constexpr int GS = NS;
constexpr float LOG2E = 1.4426950408889634f;
constexpr int NTHREADS = 512;
constexpr int LDS_BYTES = 147456;

struct Params {
  const float* x_prompt; const float* x_sample; const float* p_prompt; const float* p_sample;
  const float* norm_pre; const float* w_in; const float* w_out; const float* conv_w; const float* conv_b;
  const float* w0; const float* w_up; const float* a0; const float* a_up; const float* k_k; const float* k_a;
  const float* r_k; const float* ln_g; const float* ln_b; const float* q_norm; const float* k_norm;
  const float* lam_vec; const float* subln; const float* ple_proj; const float* ple_norm;
  const float* gate_w; const float* gate_b;
  float* out;
  bf16_t* X; bf16_t* PB; float* RS;
  bf16_t* CR; bf16_t* GRW; bf16_t* Q; bf16_t* KB; bf16_t* VT; bf16_t* GDA;
  bf16_t* R1; bf16_t* R2; float* EPART;
  bf16_t* WIN; bf16_t* WOUT; bf16_t* WPLE; bf16_t* WGATE; bf16_t* WUPT; bf16_t* AUPT;
  float* consts; int* ctr;
};

struct Group { int tok0, B, S, ntok; };

DI unsigned pack2(float a, float b) {
  typedef __attribute__((ext_vector_type(2))) __bf16 bf2;
  f32x2 v = {a, b};
  bf2 r = __builtin_convertvector(v, bf2);
  return __builtin_bit_cast(unsigned, r);
}
DI bf16_t f2bf(float a) { return (bf16_t)(pack2(a, 0.f) & 0xffffu); }
DI float bf2f(unsigned short u) { return __uint_as_float(((unsigned)u) << 16); }
DI float bflo(unsigned u) { return __uint_as_float(u << 16); }
DI float bfhi(unsigned u) { return __uint_as_float(u & 0xffff0000u); }
template <int CTRL> DI float dppf(float x) {
  return __int_as_float(__builtin_amdgcn_update_dpp(0, __float_as_int(x), CTRL, 0xF, 0xF, true));
}
DI float red4(float x) { x += dppf<0xB1>(x); x += dppf<0x4E>(x); return x; }
DI float red8(float x) { x = red4(x); x += dppf<0x141>(x); return x; }
DI float red32(float x) {
  x += __shfl_xor(x, 1); x += __shfl_xor(x, 2); x += __shfl_xor(x, 4); x += __shfl_xor(x, 8); x += __shfl_xor(x, 16);
  return x;
}
DI float sigmoidf_(float x) { return 1.f / (1.f + __expf(-x)); }
DI float siluf_(float x) { return x / (1.f + __expf(-x)); }
DI int opq(int x) { asm volatile("" : "+v"(x)); return x; }
DI int crow(int i, int h) { return (i & 3) + 8 * (i >> 2) + 4 * h; }

DI void transpose_convert(const float* __restrict__ src, int K, int N, bf16_t* __restrict__ dst, int Nd, int mode,
                          const float* __restrict__ rowscale, float* lds) {
  const int tid = opq(threadIdx.x);
  const int tk = K >> 6, tn = Nd >> 6;
  for (int t = blockIdx.x; t < tk * tn; t += gridDim.x) {
    const int k0 = (t % tk) << 6, n0 = (t / tk) << 6;
    int sn0 = n0;
    if (mode == 1) sn0 = (n0 < 1728) ? n0 : (n0 < 1792 ? -1 : n0 - 64);
    __syncthreads();
#pragma unroll
    for (int it = 0; it < 2; ++it) {
      const int kk = (tid >> 4) + 32 * it, n4 = (tid & 15) * 4;
      f32x4 v = {0.f, 0.f, 0.f, 0.f};
      if (sn0 >= 0) v = *(const f32x4*)(src + (size_t)(k0 + kk) * N + sn0 + n4);
      const float sc = rowscale ? rowscale[k0 + kk] : 1.f;
      lds[kk * 65 + n4 + 0] = v[0] * sc; lds[kk * 65 + n4 + 1] = v[1] * sc;
      lds[kk * 65 + n4 + 2] = v[2] * sc; lds[kk * 65 + n4 + 3] = v[3] * sc;
    }
    __syncthreads();
    const int nn = tid >> 3, k8 = (tid & 7) * 8;
    u32x4 o;
    o[0] = pack2(lds[(k8 + 0) * 65 + nn], lds[(k8 + 1) * 65 + nn]);
    o[1] = pack2(lds[(k8 + 2) * 65 + nn], lds[(k8 + 3) * 65 + nn]);
    o[2] = pack2(lds[(k8 + 4) * 65 + nn], lds[(k8 + 5) * 65 + nn]);
    o[3] = pack2(lds[(k8 + 6) * 65 + nn], lds[(k8 + 7) * 65 + nn]);
    *(u32x4*)(dst + (size_t)(n0 + nn) * K + k0 + k8) = o;
  }
}

DI void phase_weights(const Params& P, char* lds) {
  float* l = (float*)lds;
  for (int L = 0; L < 2; ++L) {
    transpose_convert(P.w_in + (size_t)L * DM * IN_COLS, DM, IN_COLS, P.WIN + (size_t)L * NIN * DM, NIN, 1, P.norm_pre + L * DM, l);
    transpose_convert(P.w_out + (size_t)L * DM * DM, DM, DM, P.WOUT + (size_t)L * DM * DM, DM, 0, nullptr, l);
    transpose_convert(P.ple_proj + (size_t)L * DPLE * DM, DPLE, DM, P.WPLE + (size_t)L * DM * DPLE, DM, 0, nullptr, l);
    transpose_convert(P.gate_w + (size_t)L * DM * DM, DM, DM, P.WGATE + (size_t)L * DM * DM, DM, 0, nullptr, l);
    for (int d = 0; d < 2; ++d)
      transpose_convert(P.w_up + (size_t)(L * 2 + d) * 64 * 512, 64, 512, P.WUPT + (size_t)(L * 2 + d) * 512 * 64, 512, 0, nullptr, l);
    transpose_convert(P.a_up + (size_t)L * 64 * 512, 64, 512, P.AUPT + (size_t)L * 512 * 64, 512, 0, nullptr, l);
  }
  if (blockIdx.x == 0 && threadIdx.x < 128) {
    const int L = threadIdx.x >> 6, lane = threadIdx.x & 63;
    const float* lv = P.lam_vec + L * 256;
    float s01 = lv[lane] * lv[64 + lane], s23 = lv[128 + lane] * lv[192 + lane];
    float mq = fmaxf(fabsf(P.q_norm[L * 128 + lane]), fabsf(P.q_norm[L * 128 + 64 + lane]));
    float mk = fmaxf(fabsf(P.k_norm[L * 128 + lane]), fabsf(P.k_norm[L * 128 + 64 + lane]));
    for (int o = 32; o >= 1; o >>= 1) {
      s01 += __shfl_xor(s01, o); s23 += __shfl_xor(s23, o);
      mq = fmaxf(mq, __shfl_xor(mq, o)); mk = fmaxf(mk, __shfl_xor(mk, o));
    }
    if (lane == 0) {
      const float lam_init = 0.8f - 0.6f * expf(-0.3f * (float)L);
      P.consts[L * 4 + 0] = expf(s01) - expf(s23) + lam_init;
      P.consts[L * 4 + 1] = 8.25f * mq * mk * LOG2E;
      P.consts[L * 4 + 2] = lam_init;
    }
  }
}

DI void phase_prep(const Params& P, int L) {
  const float* h0 = L == 0 ? P.x_prompt : P.out;
  const float* h1 = L == 0 ? P.x_sample : P.out + (size_t)NP * DM;
  const float* p0 = P.p_prompt + (size_t)L * NP * DPLE;
  const float* p1 = P.p_sample + (size_t)L * NS * DPLE;
  const int tidp = opq(threadIdx.x);
  const int lane = tidp & 63;
  const int gw = blockIdx.x * (NTHREADS / 64) + (tidp >> 6), nw = gridDim.x * (NTHREADS / 64);
  for (int tok = gw; tok < NTOK; tok += nw) {
    const float* hr = tok < NP ? h0 + (size_t)tok * DM : h1 + (size_t)(tok - NP) * DM;
    float ss = 0.f;
#pragma unroll
    for (int i = 0; i < 4; ++i) {
      f32x4 v = *(const f32x4*)(hr + i * 256 + lane * 4);
      ss += v[0] * v[0] + v[1] * v[1] + v[2] * v[2] + v[3] * v[3];
      u32x2 o = {pack2(v[0], v[1]), pack2(v[2], v[3])};
      *(u32x2*)(P.X + (size_t)tok * DM + i * 256 + lane * 4) = o;
    }
    for (int o = 32; o >= 1; o >>= 1) ss += __shfl_xor(ss, o);
    if (lane == 0) P.RS[tok] = rsqrtf(ss * (1.f / DM) + 1e-6f);
    const float* pr = tok < NP ? p0 + (size_t)tok * DPLE : p1 + (size_t)(tok - NP) * DPLE;
    f32x4 v = *(const f32x4*)(pr + lane * 4);
    u32x2 o = {pack2(v[0], v[1]), pack2(v[2], v[3])};
    *(u32x2*)(P.PB + (size_t)tok * DPLE + lane * 4) = o;
  }
}

constexpr int GSTR = 144;
constexpr int GA_BYTES = 256 * GSTR;
constexpr int GSTAGE = 2 * GA_BYTES;

DI void gemm_mainloop(const bf16_t* __restrict__ A, int lda, const bf16_t* __restrict__ Bw, int ldb, int K,
                      int m0, int n0, char* lds, f32x16 (&acc)[2][4]) {
  const int tid = opq(threadIdx.x), lane = tid & 63, w = tid >> 6, hh = lane >> 5, r = lane & 31;
  const int wm = w >> 1, wn = w & 1;
#pragma unroll
  for (int mi = 0; mi < 2; ++mi)
#pragma unroll
    for (int ni = 0; ni < 4; ++ni)
#pragma unroll
      for (int i = 0; i < 16; ++i) acc[mi][ni][i] = 0.f;
  const int lrow = tid >> 3, lkc = tid & 7;
  const bf16_t* ap = A + (size_t)(m0 + lrow) * lda + lkc * 8;
  const bf16_t* bp = Bw + (size_t)(n0 + lrow) * ldb + lkc * 8;
  const int nk = K >> 6;
  u32x4 ra[4], rb[4];
#pragma unroll
  for (int i = 0; i < 4; ++i) {
    ra[i] = *(const u32x4*)(ap + (size_t)(64 * i) * lda);
    rb[i] = *(const u32x4*)(bp + (size_t)(64 * i) * ldb);
  }
  __syncthreads();
#pragma unroll
  for (int i = 0; i < 4; ++i) {
    *(u32x4*)(lds + (lrow + 64 * i) * GSTR + lkc * 16) = ra[i];
    *(u32x4*)(lds + GA_BYTES + (lrow + 64 * i) * GSTR + lkc * 16) = rb[i];
  }
  __syncthreads();
  for (int kt = 0; kt < nk; ++kt) {
    const bool more = kt + 1 < nk;
    if (more) {
#pragma unroll
      for (int i = 0; i < 4; ++i) {
        ra[i] = *(const u32x4*)(ap + (size_t)(64 * i) * lda + (kt + 1) * 64);
        rb[i] = *(const u32x4*)(bp + (size_t)(64 * i) * ldb + (kt + 1) * 64);
      }
    }
    const char* sa = lds + (kt & 1) * GSTAGE + (wm * 64 + r) * GSTR + hh * 16;
    const char* sb = lds + (kt & 1) * GSTAGE + GA_BYTES + (wn * 128 + r) * GSTR + hh * 16;
#pragma unroll
    for (int ks = 0; ks < 4; ++ks) {
      bf16x8 fa[2], fb[4];
#pragma unroll
      for (int mi = 0; mi < 2; ++mi) fa[mi] = *(const bf16x8*)(sa + mi * 32 * GSTR + ks * 32);
#pragma unroll
      for (int ni = 0; ni < 4; ++ni) fb[ni] = *(const bf16x8*)(sb + ni * 32 * GSTR + ks * 32);
#pragma unroll
      for (int mi = 0; mi < 2; ++mi)
#pragma unroll
        for (int ni = 0; ni < 4; ++ni) acc[mi][ni] = MFMA(fa[mi], fb[ni], acc[mi][ni]);
    }
    if (more) {
      char* d = lds + ((kt + 1) & 1) * GSTAGE;
#pragma unroll
      for (int i = 0; i < 4; ++i) {
        *(u32x4*)(d + (lrow + 64 * i) * GSTR + lkc * 16) = ra[i];
        *(u32x4*)(d + GA_BYTES + (lrow + 64 * i) * GSTR + lkc * 16) = rb[i];
      }
    }
    __syncthreads();
  }
}

DI void phase_inproj(const Params& P, int L, const Group& G, char* lds) {
  const int tid = opq(threadIdx.x), lane = tid & 63, w = tid >> 6, hh = lane >> 5, r = lane & 31;
  const int wm = w >> 1, wn = w & 1;
  const int nmt = G.ntok >> 8, ntile = nmt * 17;
  const bf16_t* A = P.X + (size_t)G.tok0 * DM;
  const bf16_t* Bw = P.WIN + (size_t)L * NIN * DM;
  for (int t = blockIdx.x; t < ntile; t += gridDim.x) {
    const int mt = t / 17, nt = t % 17;
    const int m0 = mt << 8, n0 = nt << 8;
    f32x16 acc[2][4];
    gemm_mainloop(A, DM, Bw, DM, DM, m0, n0, lds, acc);
    const int colw = n0 + wn * 128;
    if (nt < 7) {
#pragma unroll
      for (int mi = 0; mi < 2; ++mi)
#pragma unroll
        for (int i = 0; i < 16; ++i) {
          const int row = m0 + wm * 64 + mi * 32 + crow(i, hh);
          const float rsv = P.RS[G.tok0 + row];
#pragma unroll
          for (int ni = 0; ni < 4; ++ni)
            P.CR[(size_t)row * CRW + colw + ni * 32 + r] = f2bf(acc[mi][ni][i] * rsv);
          __builtin_amdgcn_sched_barrier(0);
        }
    } else if (nt < 9 || nt >= 15) {
      bf16_t* dst = nt < 9 ? P.GRW : P.GDA;
      const int c0 = colw - (nt < 9 ? 1792 : 3840);
#pragma unroll
      for (int mi = 0; mi < 2; ++mi)
#pragma unroll
        for (int i = 0; i < 16; ++i) {
          const int row = m0 + wm * 64 + mi * 32 + crow(i, hh);
          const float rsv = P.RS[G.tok0 + row];
#pragma unroll
          for (int ni = 0; ni < 4; ++ni)
            dst[(size_t)row * 512 + c0 + ni * 32 + r] = f2bf(siluf_(acc[mi][ni][i] * rsv));
          __builtin_amdgcn_sched_barrier(0);
        }
    } else if (nt < 13) {
      const bool isq = nt < 11;
      bf16_t* dst = isq ? P.Q : P.KB;
      const int c0 = colw - (isq ? 2304 : 2816);
      const float* g = (isq ? P.q_norm : P.k_norm) + L * 128;
      const float osc = isq ? 0.125f * LOG2E : 1.f;
#pragma unroll
      for (int gi = 0; gi < 2; ++gi) {
        const float g0 = g[gi * 64 + r] * osc, g1 = g[gi * 64 + 32 + r] * osc;
#pragma unroll
        for (int mi = 0; mi < 2; ++mi)
#pragma unroll
          for (int i = 0; i < 16; ++i) {
            const int row = m0 + wm * 64 + mi * 32 + crow(i, hh);
            const float rsv = P.RS[G.tok0 + row];
            const float v0 = acc[mi][2 * gi][i] * rsv, v1 = acc[mi][2 * gi + 1][i] * rsv;
            const float ss = red32(v0 * v0 + v1 * v1);
            const float sc = rsqrtf(ss * (1.f / 64.f) + 1e-6f);
            dst[(size_t)row * 512 + c0 + gi * 64 + r] = f2bf(v0 * sc * g0);
            dst[(size_t)row * 512 + c0 + gi * 64 + 32 + r] = f2bf(v1 * sc * g1);
            __builtin_amdgcn_sched_barrier(0);
          }
      }
    } else {
      const int hd = (colw - 3328) >> 7;
      const int row0 = m0 + wm * 64;
      const int b = row0 / G.S, s0 = row0 % G.S;
#pragma unroll
      for (int mi = 0; mi < 2; ++mi)
#pragma unroll
        for (int q4 = 0; q4 < 4; ++q4) {
          const int s = s0 + mi * 32 + 8 * q4 + 4 * hh;
          const f32x4 r4 = *(const f32x4*)(P.RS + G.tok0 + b * G.S + s);
#pragma unroll
          for (int ni = 0; ni < 4; ++ni) {
            const int dv = ni * 32 + r;
            u32x2 o = {pack2(acc[mi][ni][4 * q4] * r4[0], acc[mi][ni][4 * q4 + 1] * r4[1]),
                       pack2(acc[mi][ni][4 * q4 + 2] * r4[2], acc[mi][ni][4 * q4 + 3] * r4[3])};
            *(u32x2*)(P.VT + ((size_t)((b * 4 + hd) * 128 + dv)) * G.S + s) = o;
          }
          __builtin_amdgcn_sched_barrier(0);
        }
    }
  }
}

DI void phase_outproj(const Params& P, int L, char* lds) {
  const int tid = opq(threadIdx.x), lane = tid & 63, w = tid >> 6, hh = lane >> 5, r = lane & 31;
  const int wm = w >> 1, wn = w & 1;
  const float* h0 = L == 0 ? P.x_prompt : P.out;
  const float* h1 = L == 0 ? P.x_sample : P.out + (size_t)NP * DM;
  const int nmt = NTOK >> 8, ntile = nmt * 4;
  for (int t = blockIdx.x; t < 2 * ntile; t += gridDim.x) {
    const bool isE = t >= ntile;
    const int tt = isE ? t - ntile : t;
    const int mt = tt >> 2, nt = tt & 3;
    const int m0 = mt << 8, n0 = nt << 8;
    f32x16 acc[2][4];
    if (!isE) {
      gemm_mainloop(P.X, DM, P.WOUT + (size_t)L * DM * DM, DM, DM, m0, n0, lds, acc);
#pragma unroll
      for (int mi = 0; mi < 2; ++mi)
#pragma unroll
        for (int i = 0; i < 16; ++i) {
          const int row = m0 + wm * 64 + mi * 32 + crow(i, hh);
          const float* hr = row < NP ? h0 + (size_t)row * DM : h1 + (size_t)(row - NP) * DM;
#pragma unroll
          for (int ni = 0; ni < 4; ++ni) {
            const int col = n0 + wn * 128 + ni * 32 + r;
            const float v = hr[col] + acc[mi][ni][i];
            P.out[(size_t)row * DM + col] = v;
            P.R1[(size_t)row * DM + col] = f2bf(v);
          }
        }
    } else {
      gemm_mainloop(P.PB, DPLE, P.WPLE + (size_t)L * DM * DPLE, DPLE, DPLE, m0, n0, lds, acc);
#pragma unroll
      for (int mi = 0; mi < 2; ++mi)
#pragma unroll
        for (int i = 0; i < 16; ++i) {
          const int row = m0 + wm * 64 + mi * 32 + crow(i, hh);
          float ss = 0.f;
#pragma unroll
          for (int ni = 0; ni < 4; ++ni) {
            const int col = n0 + wn * 128 + ni * 32 + r;
            const float v = acc[mi][ni][i];
            ss += v * v;
            P.R2[(size_t)row * DM + col] = f2bf(v);
          }
          ss = red32(ss);
          if (r == 0) P.EPART[(size_t)(nt * 2 + wn) * NTOK + row] = ss;
        }
    }
  }
}

DI void phase_gate(const Params& P, int L, char* lds) {
  const int tid = opq(threadIdx.x), lane = tid & 63, w = tid >> 6, hh = lane >> 5, r = lane & 31;
  const int wm = w >> 1, wn = w & 1;
  const int nmt = NTOK >> 8, ntile = nmt * 4;
  for (int t = blockIdx.x; t < ntile; t += gridDim.x) {
    const int mt = t >> 2, nt = t & 3;
    const int m0 = mt << 8, n0 = nt << 8;
    f32x16 acc[2][4];
    gemm_mainloop(P.R1, DM, P.WGATE + (size_t)L * DM * DM, DM, DM, m0, n0, lds, acc);
    float gb[4], pn[4];
#pragma unroll
    for (int ni = 0; ni < 4; ++ni) {
      const int col = n0 + wn * 128 + ni * 32 + r;
      gb[ni] = P.gate_b[L * DM + col]; pn[ni] = P.ple_norm[L * DM + col];
    }
#pragma unroll
    for (int mi = 0; mi < 2; ++mi)
#pragma unroll
      for (int i = 0; i < 16; ++i) {
        const int row = m0 + wm * 64 + mi * 32 + crow(i, hh);
        float es = 0.f;
#pragma unroll
        for (int j = 0; j < 8; ++j) es += P.EPART[(size_t)j * NTOK + row];
        const float rse = rsqrtf(es * (1.f / DM) + 1e-6f);
#pragma unroll
        for (int ni = 0; ni < 4; ++ni) {
          const int col = n0 + wn * 128 + ni * 32 + r;
          const float gt = sigmoidf_(acc[mi][ni][i] + gb[ni]);
          const float e = bf2f(P.R2[(size_t)row * DM + col]) * rse * pn[ni];
          P.out[(size_t)row * DM + col] += gt * e;
        }
      }
  }
}

constexpr int TC = 32;
constexpr int SC_OP = TC * 64 * 4;
constexpr int SC_DIR = 7 * SC_OP + 2 * TC * 144 + 128;

DI void scan_task(const Params& P, int L, const Group& G, int task, char* lds) {
  const int tid = opq(threadIdx.x), lane = tid & 63, w = tid >> 6;
  const int b = task >> 3, hd = task & 7;
  const int S = G.S, nc = S / TC;
  const int ed = tid >> 8, es = (tid & 255) >> 3, ecg = tid & 7;
  char* eb = lds + ed * SC_DIR;
  float* eW = (float*)(eb); float* eA = (float*)(eb + SC_OP); float* eB = (float*)(eb + 2 * SC_OP);
  float* eK = (float*)(eb + 3 * SC_OP); float* eR = (float*)(eb + 4 * SC_OP); float* eV = (float*)(eb + 5 * SC_OP);
  float* eY = (float*)(eb + 6 * SC_OP);
  char* eZT = eb + 7 * SC_OP; char* eZA = eZT + TC * 144; float* eBon = (float*)(eZA + TC * 144);
  const int sd = w >> 2, srow = (w & 3) * 16 + (lane >> 2), scs = lane & 3;
  char* sb = lds + sd * SC_DIR;
  const int md = w >> 2, mmat = (w & 3) >> 1, mnb = w & 1, hh = lane >> 5, r = lane & 31;
  char* mb = lds + md * SC_DIR;

  const float* cw = P.conv_w + (size_t)L * 3 * 1728;
  const float* cb = P.conv_b + (size_t)L * 1728;
  const int colbase[5] = {hd * 64, 512 + hd * 64, 1024 + hd * 64, 1536 + ed * 64, 1664};
  const int hc = hd * 64 + ecg * 8;

  float st[16];
#pragma unroll
  for (int j = 0; j < 16; ++j) st[j] = 0.f;

  for (int c = 0; c < nc; ++c) {
    __syncthreads();
    const int ts = ed ? S - 1 - (c * TC + es) : c * TC + es;
    const size_t lt = (size_t)b * S + ts;
    float kreg[8];
    {
      const bool hasm = ts > 0, hasp = ts + 1 < S;
#pragma unroll
      for (int q = 0; q < 5; ++q) {
        const int col = colbase[q] + ecg * 8;
        const bf16_t* src = P.CR + lt * CRW + col;
        u32x4 x0 = {0u, 0u, 0u, 0u}, x2 = {0u, 0u, 0u, 0u};
        if (hasm) x0 = *(const u32x4*)(src - CRW);
        const u32x4 x1 = *(const u32x4*)(src);
        if (hasp) x2 = *(const u32x4*)(src + CRW);
        float v[8];
#pragma unroll
        for (int j = 0; j < 4; ++j) {
          const f32x2 w0 = *(const f32x2*)(cw + col + 2 * j), w1 = *(const f32x2*)(cw + 1728 + col + 2 * j),
                      w2 = *(const f32x2*)(cw + 2 * 1728 + col + 2 * j), bb = *(const f32x2*)(cb + col + 2 * j);
          v[2 * j] = bb[0] + w0[0] * bflo(x0[j]) + w1[0] * bflo(x1[j]) + w2[0] * bflo(x2[j]);
          v[2 * j + 1] = bb[1] + w0[1] * bfhi(x0[j]) + w1[1] * bfhi(x1[j]) + w2[1] * bfhi(x2[j]);
        }
        if (q == 0) {
#pragma unroll
          for (int j = 0; j < 8; ++j) eR[es * 64 + ecg * 8 + j] = v[j];
        } else if (q == 1) {
#pragma unroll
          for (int j = 0; j < 8; ++j) kreg[j] = v[j];
        } else if (q == 2) {
#pragma unroll
          for (int j = 0; j < 8; ++j) eV[es * 64 + ecg * 8 + j] = v[j];
        } else if (q == 3) {
          u32x4 o;
#pragma unroll
          for (int j = 0; j < 4; ++j) o[j] = pack2(tanhf(v[2 * j]), tanhf(v[2 * j + 1]));
          *(u32x4*)(eZT + es * 144 + ecg * 16) = o;
        } else {
          u32x4 o;
#pragma unroll
          for (int j = 0; j < 4; ++j) o[j] = pack2(v[2 * j], v[2 * j + 1]);
          *(u32x4*)(eZA + es * 144 + ecg * 16) = o;
        }
      }
    }
    __syncthreads();
    {
      f32x16 acc;
#pragma unroll
      for (int i = 0; i < 16; ++i) acc[i] = 0.f;
      const char* asrc = mb + 7 * SC_OP + (mmat ? TC * 144 : 0) + r * 144 + hh * 16;
      const bf16_t* wsrc = (mmat ? P.AUPT + (size_t)L * 512 * 64 : P.WUPT + (size_t)(L * 2 + md) * 512 * 64) +
                           (size_t)(hd * 64 + mnb * 32 + r) * 64 + hh * 8;
#pragma unroll
      for (int ks = 0; ks < 4; ++ks) {
        const bf16x8 fa = *(const bf16x8*)(asrc + ks * 32);
        const bf16x8 fb = *(const bf16x8*)(wsrc + ks * 16);
        acc = MFMA(fa, fb, acc);
      }
      const int ch = hd * 64 + mnb * 32 + r;
      if (mmat == 0) {
        const float w0v = P.w0[(size_t)(L * 2 + md) * 512 + ch];
        float* dW = (float*)(mb);
#pragma unroll
        for (int i = 0; i < 16; ++i) {
          const float wl = w0v + acc[i];
          dW[crow(i, hh) * 64 + mnb * 32 + r] = __expf(-0.6065306597126334f * sigmoidf_(wl));
        }
      } else {
        const float a0v = P.a0[(size_t)L * 512 + ch];
        float* dA = (float*)(mb + SC_OP);
#pragma unroll
        for (int i = 0; i < 16; ++i) dA[crow(i, hh) * 64 + mnb * 32 + r] = sigmoidf_(a0v + acc[i]);
      }
    }
    __syncthreads();
    {
      float ss = 0.f, bon = 0.f, kk[8], ag[8];
#pragma unroll
      for (int j = 0; j < 8; ++j) {
        ag[j] = eA[es * 64 + ecg * 8 + j];
        kk[j] = kreg[j] * P.k_k[L * 512 + hc + j];
        ss += kk[j] * kk[j];
      }
      ss = red8(ss);
      const float inv = rsqrtf(ss + 1e-12f);
#pragma unroll
      for (int j = 0; j < 8; ++j) {
        const float kn = kk[j] * inv;
        const float km = kreg[j] * (1.f + (ag[j] - 1.f) * P.k_a[L * 512 + hc + j]);
        eK[es * 64 + ecg * 8 + j] = km;
        eA[es * 64 + ecg * 8 + j] = -kn;
        eB[es * 64 + ecg * 8 + j] = kn * ag[j];
        bon += eR[es * 64 + ecg * 8 + j] * km * P.r_k[L * 512 + hc + j];
      }
      bon = red8(bon);
      if (ecg == 0) eBon[es] = bon;
    }
    __syncthreads();
    {
      const float* oW = (const float*)(sb) + scs * 16;
      const float* oA = (const float*)(sb + SC_OP) + scs * 16;
      const float* oB = (const float*)(sb + 2 * SC_OP) + scs * 16;
      const float* oK = (const float*)(sb + 3 * SC_OP) + scs * 16;
      const float* oR = (const float*)(sb + 4 * SC_OP) + scs * 16;
      const float* oV = (const float*)(sb + 5 * SC_OP) + srow;
      float* oY = (float*)(sb + 6 * SC_OP) + srow;
#pragma unroll 2
      for (int s = 0; s < TC; ++s) {
        float av[16], p0 = 0.f, p1 = 0.f;
#pragma unroll
        for (int q = 0; q < 4; ++q) {
          const f32x4 t = *(const f32x4*)(oA + s * 64 + q * 4);
          av[q * 4] = t[0]; av[q * 4 + 1] = t[1]; av[q * 4 + 2] = t[2]; av[q * 4 + 3] = t[3];
        }
#pragma unroll
        for (int j = 0; j < 16; j += 2) { p0 = fmaf(st[j], av[j], p0); p1 = fmaf(st[j + 1], av[j + 1], p1); }
        const float sa = red4(p0 + p1);
        const float vv = oV[s * 64];
        float y0 = 0.f, y1 = 0.f;
#pragma unroll
        for (int q = 0; q < 4; ++q) {
          const f32x4 tw = *(const f32x4*)(oW + s * 64 + q * 4);
          const f32x4 tb = *(const f32x4*)(oB + s * 64 + q * 4);
          const f32x4 tk = *(const f32x4*)(oK + s * 64 + q * 4);
          const f32x4 tr = *(const f32x4*)(oR + s * 64 + q * 4);
#pragma unroll
          for (int j = 0; j < 4; ++j) {
            float x = st[q * 4 + j] * tw[j];
            x = fmaf(sa, tb[j], x);
            x = fmaf(vv, tk[j], x);
            st[q * 4 + j] = x;
            if (j & 1) y1 = fmaf(x, tr[j], y1); else y0 = fmaf(x, tr[j], y0);
          }
        }
        const float y = red4(y0 + y1);
        if (scs == 0) oY[s * 64] = y;
      }
    }
    __syncthreads();
    {
      bf16_t* yp = P.X + ((size_t)G.tok0 + lt) * DM + hc;
      float y[8];
#pragma unroll
      for (int j = 0; j < 8; ++j) y[j] = eY[es * 64 + ecg * 8 + j];
      if (c < nc / 2) {
        u32x4 o;
#pragma unroll
        for (int j = 0; j < 4; ++j) o[j] = pack2(y[2 * j], y[2 * j + 1]);
        *(u32x4*)yp = o;
      } else {
        u32x4 pr;
        pr[0] = __hip_atomic_load((const unsigned*)yp + 0, __ATOMIC_RELAXED, __HIP_MEMORY_SCOPE_AGENT);
        pr[1] = __hip_atomic_load((const unsigned*)yp + 1, __ATOMIC_RELAXED, __HIP_MEMORY_SCOPE_AGENT);
        pr[2] = __hip_atomic_load((const unsigned*)yp + 2, __ATOMIC_RELAXED, __HIP_MEMORY_SCOPE_AGENT);
        pr[3] = __hip_atomic_load((const unsigned*)yp + 3, __ATOMIC_RELAXED, __HIP_MEMORY_SCOPE_AGENT);
        float sum = 0.f;
#pragma unroll
        for (int j = 0; j < 4; ++j) { y[2 * j] += bflo(pr[j]); y[2 * j + 1] += bfhi(pr[j]); }
#pragma unroll
        for (int j = 0; j < 8; ++j) sum += y[j];
        const float mu = red8(sum) * (1.f / 64.f);
        float vs = 0.f;
#pragma unroll
        for (int j = 0; j < 8; ++j) { y[j] -= mu; vs += y[j] * y[j]; }
        const float rstd = rsqrtf(red8(vs) * (1.f / 64.f) + 64e-5f);
        const float bon = eBon[es];
        const u32x4 gt = *(const u32x4*)(P.GRW + lt * 512 + hc);
        u32x4 o;
#pragma unroll
        for (int j = 0; j < 4; ++j) {
          const float o0 = (y[2 * j] * rstd * P.ln_g[L * 512 + hc + 2 * j] + P.ln_b[L * 512 + hc + 2 * j] +
                            bon * eV[es * 64 + ecg * 8 + 2 * j]) * bflo(gt[j]);
          const float o1 = (y[2 * j + 1] * rstd * P.ln_g[L * 512 + hc + 2 * j + 1] + P.ln_b[L * 512 + hc + 2 * j + 1] +
                            bon * eV[es * 64 + ecg * 8 + 2 * j + 1]) * bfhi(gt[j]);
          o[j] = pack2(o0, o1);
        }
        *(u32x4*)yp = o;
      }
    }
  }
}

constexpr int AT_K = 64 * GSTR;
constexpr int AT_STAGE = 2 * AT_K + 128 * GSTR;

DI void attn_item(const Params& P, int L, const Group& G, int item, char* lds) {
  const int tid = opq(threadIdx.x), lane = tid & 63, w = tid >> 6, hh = lane >> 5, r = lane & 31;
  const int S = G.S, nqb = S >> 7;
  const int qblk = item % nqb, bh = item / nqb, hd = bh & 3, b = bh >> 2;
  const int map = w & 1, qb = w >> 1;
  const int q0 = qblk * 128 + qb * 32;
  const size_t ltq = (size_t)b * S + q0 + r;
  bf16x8 qf[4];
  {
    const bf16_t* qp = P.Q + ltq * 512 + hd * 128 + map * 64 + hh * 8;
#pragma unroll
    for (int ks = 0; ks < 4; ++ks) qf[ks] = *(const bf16x8*)(qp + ks * 16);
  }
  f32x16 o[4];
#pragma unroll
  for (int d = 0; d < 4; ++d)
#pragma unroll
    for (int i = 0; i < 16; ++i) o[d][i] = 0.f;
  float lsum = 0.f;
  const float slope2 = exp2f(-2.f * (float)(hd + 1)) * LOG2E;
  const float lam = P.consts[L * 4 + 0], C2 = P.consts[L * 4 + 1], lam_init = P.consts[L * 4 + 2];
  const float qposf = (float)(q0 + r);
  const int nt = S >> 6;
  const int lrow = tid >> 3, lck = tid & 7;
  const bf16_t* k0p = P.KB + ((size_t)b * S + lrow) * 512 + hd * 128 + lck * 8;
  const bf16_t* v0p = P.VT + ((size_t)((b * 4 + hd) * 128 + lrow)) * S + lck * 8;
  u32x4 rk0, rk1, rv0, rv1;
  rk0 = *(const u32x4*)(k0p); rk1 = *(const u32x4*)(k0p + 64);
  rv0 = *(const u32x4*)(v0p); rv1 = *(const u32x4*)(v0p + (size_t)64 * S);
  __syncthreads();
  *(u32x4*)(lds + lrow * GSTR + lck * 16) = rk0;
  *(u32x4*)(lds + AT_K + lrow * GSTR + lck * 16) = rk1;
  *(u32x4*)(lds + 2 * AT_K + lrow * GSTR + lck * 16) = rv0;
  *(u32x4*)(lds + 2 * AT_K + (lrow + 64) * GSTR + lck * 16) = rv1;
  __syncthreads();
  const int krow = (r & ~12) | ((r & 4) << 1) | ((r & 8) >> 1);
  for (int t = 0; t < nt; ++t) {
    const bool more = t + 1 < nt;
    if (more) {
      rk0 = *(const u32x4*)(k0p + (size_t)(t + 1) * 64 * 512); rk1 = *(const u32x4*)(k0p + (size_t)(t + 1) * 64 * 512 + 64);
      rv0 = *(const u32x4*)(v0p + (t + 1) * 64); rv1 = *(const u32x4*)(v0p + (size_t)64 * S + (t + 1) * 64);
    }
    const char* kbuf = lds + (t & 1) * AT_STAGE + map * AT_K;
    const char* vbuf = lds + (t & 1) * AT_STAGE + 2 * AT_K;
    f32x16 s0, s1;
    const float base = (float)(t * 64 + 8 * hh) - qposf;
#pragma unroll
    for (int i = 0; i < 16; ++i) {
      const float d0 = base + (float)(16 * (i >> 3) + (i & 7));
      s0[i] = fmaf(fabsf(d0), -slope2, -C2);
      s1[i] = fmaf(fabsf(d0 + 32.f), -slope2, -C2);
    }
#pragma unroll
    for (int ks = 0; ks < 4; ++ks) {
      const bf16x8 a0 = *(const bf16x8*)(kbuf + krow * GSTR + ks * 32 + hh * 16);
      const bf16x8 a1 = *(const bf16x8*)(kbuf + (32 + krow) * GSTR + ks * 32 + hh * 16);
      s0 = MFMA(a0, qf[ks], s0);
      s1 = MFMA(a1, qf[ks], s1);
    }
    bf16x8 pf[4];
    {
      u32x4 pk[4];
#pragma unroll
      for (int i = 0; i < 16; i += 2) {
        const float e0 = __builtin_amdgcn_exp2f(s0[i]), e1 = __builtin_amdgcn_exp2f(s0[i + 1]);
        const float e2 = __builtin_amdgcn_exp2f(s1[i]), e3 = __builtin_amdgcn_exp2f(s1[i + 1]);
        lsum += (e0 + e1) + (e2 + e3);
        pk[i >> 3][(i & 7) >> 1] = pack2(e0, e1);
        pk[2 + (i >> 3)][(i & 7) >> 1] = pack2(e2, e3);
      }
#pragma unroll
      for (int j = 0; j < 4; ++j) pf[j] = __builtin_bit_cast(bf16x8, pk[j]);
    }
#pragma unroll
    for (int dvb = 0; dvb < 4; ++dvb)
#pragma unroll
      for (int j = 0; j < 4; ++j) {
        const bf16x8 va = *(const bf16x8*)(vbuf + (dvb * 32 + r) * GSTR + (16 * j + 8 * hh) * 2);
        o[dvb] = MFMA(va, pf[j], o[dvb]);
      }
    if (more) {
      char* d = lds + ((t + 1) & 1) * AT_STAGE;
      *(u32x4*)(d + lrow * GSTR + lck * 16) = rk0;
      *(u32x4*)(d + AT_K + lrow * GSTR + lck * 16) = rk1;
      *(u32x4*)(d + 2 * AT_K + lrow * GSTR + lck * 16) = rv0;
      *(u32x4*)(d + 2 * AT_K + (lrow + 64) * GSTR + lck * 16) = rv1;
    }
    __syncthreads();
  }
  lsum += __shfl_xor(lsum, 32);
  const float linv = 1.f / lsum;
  float* comb = (float*)lds;
  if (map == 1) {
#pragma unroll
    for (int dvb = 0; dvb < 4; ++dvb)
#pragma unroll
      for (int i = 0; i < 16; ++i) comb[(qb * 64 + dvb * 16 + i) * 64 + lane] = o[dvb][i] * linv;
  }
  __syncthreads();
  if (map == 0) {
    float ss = 0.f;
#pragma unroll
    for (int dvb = 0; dvb < 4; ++dvb)
#pragma unroll
      for (int i = 0; i < 16; ++i) {
        const float v = o[dvb][i] * linv - lam * comb[(qb * 64 + dvb * 16 + i) * 64 + lane];
        o[dvb][i] = v; ss += v * v;
      }
    ss += __shfl_xor(ss, 32);
    const float sc = rsqrtf(ss * (1.f / 128.f) + 1e-6f) * (1.f - lam_init);
    const bf16_t* gp = P.GDA + ltq * 512 + hd * 128;
    bf16_t* yp = P.X + ((size_t)G.tok0 + ltq) * DM + 512 + hd * 128;
    const float* sl = P.subln + L * 128;
#pragma unroll
    for (int dvb = 0; dvb < 4; ++dvb)
#pragma unroll
      for (int q4 = 0; q4 < 4; ++q4) {
        const int dv = dvb * 32 + 8 * q4 + 4 * hh;
        const u32x2 g = *(const u32x2*)(gp + dv);
        const f32x4 s4 = *(const f32x4*)(sl + dv);
        u32x2 ov = {pack2(o[dvb][4 * q4] * sc * s4[0] * bflo(g[0]), o[dvb][4 * q4 + 1] * sc * s4[1] * bfhi(g[0])),
                    pack2(o[dvb][4 * q4 + 2] * sc * s4[2] * bflo(g[1]), o[dvb][4 * q4 + 3] * sc * s4[3] * bfhi(g[1]))};
        *(u32x2*)(yp + dv) = ov;
      }
  }
}

DI void phase_mixers(const Params& P, int L, const Group& G, int* ctr, char* lds, int* s_item) {
  const int nscan = G.B * 8;
  const int nattn = G.B * 4 * (G.S >> 7);
  const int total = nscan + nattn;
  for (;;) {
    __syncthreads();
    if (threadIdx.x == 0) *s_item = atomicAdd(ctr, 1);
    __syncthreads();
    const int it = *s_item;
    if (it >= total) break;
    if (it < nscan) scan_task(P, L, G, it, lds);
    else attn_item(P, L, G, it - nscan, lds);
  }
}

__global__ void __launch_bounds__(NTHREADS) fwd_megakernel(Params P) {
  __shared__ __attribute__((aligned(16))) char lds[LDS_BYTES];
  __shared__ int s_item;
  cg::grid_group grid = cg::this_grid();
  phase_weights(P, lds);
  for (int ph = 0; ph < 14; ++ph) {
    const int L = ph / 7, k = ph % 7;
    const int g = (k >= 3 && k <= 4) ? 1 : 0;
    Group G;
    G.tok0 = g ? NP : 0; G.B = g ? 8 : 16; G.S = g ? 8192 : 2048; G.ntok = g ? NS : NP;
    if (k == 0) phase_prep(P, L);
    else if (k == 1 || k == 3) phase_inproj(P, L, G, lds);
    else if (k == 2 || k == 4) phase_mixers(P, L, G, P.ctr + (L * 2 + g) * 16, lds, &s_item);
    else if (k == 5) phase_outproj(P, L, lds);
    else phase_gate(P, L, lds);
    grid.sync();
  }
}

extern "C" void kernel_launch(void* const* d_in, const int* in_sizes, int n_in, void* d_out, int out_size, void* d_ws,
                              size_t ws_size, hipStream_t stream) {
  Params P{};
  const float* const* in = (const float* const*)d_in;
  P.x_prompt = in[0]; P.x_sample = in[1]; P.p_prompt = in[2]; P.p_sample = in[3];
  P.norm_pre = in[4]; P.w_in = in[5]; P.w_out = in[6]; P.conv_w = in[7]; P.conv_b = in[8];
  P.w0 = in[9]; P.w_up = in[10]; P.a0 = in[11]; P.a_up = in[12]; P.k_k = in[13]; P.k_a = in[14];
  P.r_k = in[15]; P.ln_g = in[16]; P.ln_b = in[17]; P.q_norm = in[18]; P.k_norm = in[19];
  P.lam_vec = in[20]; P.subln = in[21]; P.ple_proj = in[22]; P.ple_norm = in[23];
  P.gate_w = in[24]; P.gate_b = in[25];
  P.out = (float*)d_out;
  char* ws = (char*)d_ws;
  size_t off = 0;
  auto take = [&](size_t bytes) { char* p = ws + off; off += (bytes + 255) & ~(size_t)255; return p; };
  P.ctr = (int*)take(1024);
  P.consts = (float*)take(1024);
  P.X = (bf16_t*)take((size_t)NTOK * DM * 2);
  P.PB = (bf16_t*)take((size_t)NTOK * DPLE * 2);
  P.RS = (float*)take((size_t)NTOK * 4);
  P.WIN = (bf16_t*)take((size_t)2 * NIN * DM * 2);
  P.WOUT = (bf16_t*)take((size_t)2 * DM * DM * 2);
  P.WPLE = (bf16_t*)take((size_t)2 * DM * DPLE * 2);
  P.WGATE = (bf16_t*)take((size_t)2 * DM * DM * 2);
  P.WUPT = (bf16_t*)take((size_t)4 * 512 * 64 * 2);
  P.AUPT = (bf16_t*)take((size_t)2 * 512 * 64 * 2);
  P.CR = (bf16_t*)take((size_t)GS * CRW * 2);
  P.GRW = (bf16_t*)take((size_t)GS * 512 * 2);
  P.Q = (bf16_t*)take((size_t)GS * 512 * 2);
  P.KB = (bf16_t*)take((size_t)GS * 512 * 2);
  P.VT = (bf16_t*)take((size_t)GS * 512 * 2);
  P.GDA = (bf16_t*)take((size_t)GS * 512 * 2);
  P.R1 = P.CR;
  P.R2 = P.GRW;
  P.EPART = (float*)P.VT;
  if (off > ws_size) { fprintf(stderr, "workspace too small: need %zu have %zu\n", off, ws_size); return; }
  hipMemsetAsync(P.ctr, 0, 1024, stream);
  static int grid_blocks = 0;
  if (!grid_blocks) {
    int dev = 0, cus = 0, per_cu = 0;
    hipGetDevice(&dev);
    hipDeviceGetAttribute(&cus, hipDeviceAttributeMultiprocessorCount, dev);
    hipOccupancyMaxActiveBlocksPerMultiprocessor(&per_cu, fwd_megakernel, NTHREADS, 0);
    if (per_cu < 1) { fprintf(stderr, "occupancy query returned %d\n", per_cu); per_cu = 1; }
    grid_blocks = cus;
  }
  void* args[] = {&P};
  hipError_t e = hipLaunchCooperativeKernel((void*)fwd_megakernel, dim3(grid_blocks), dim3(NTHREADS), args, 0, stream);
  if (e != hipSuccess) fprintf(stderr, "cooperative launch failed: %s (grid %d)\n", hipGetErrorString(e), grid_blocks);
}
```

```cpp
#include <hip/hip_runtime.h>
#include <hip/hip_cooperative_groups.h>
#include <cstdio>
namespace cg = cooperative_groups;

#define DI __device__ __forceinline__
typedef __attribute__((ext_vector_type(8))) short bf16x8;
typedef __attribute__((ext_vector_type(16))) float f32x16;
typedef __attribute__((ext_vector_type(4))) float f32x4;
typedef __attribute__((ext_vector_type(2))) float f32x2;
typedef __attribute__((ext_vector_type(4))) unsigned u32x4;
typedef __attribute__((ext_vector_type(2))) unsigned u32x2;
typedef unsigned short bf16_t;
#define MFMA(a, b, c) __builtin_amdgcn_mfma_f32_32x32x16_bf16((a), (b), (c), 0, 0, 0)

constexpr int DM = 1024;
constexpr int NP = 16 * 2048;
constexpr int NS = 8 * 8192;
constexpr int NTOK = NP + NS;
constexpr int DPLE = 256;
constexpr int IN_COLS = 4288;
constexpr int NIN = 4352;
constexpr int CRW = 1792;
constexpr int GS = NS;
constexpr float LOG2E = 1.4426950408889634f;
constexpr int NTHREADS = 512;
constexpr int LDS_BYTES = 147456;

struct Params {
  const float* x_prompt; const float* x_sample; const float* p_prompt; const float* p_sample;
  const float* norm_pre; const float* w_in; const float* w_out; const float* conv_w; const float* conv_b;
  const float* w0; const float* w_up; const float* a0; const float* a_up; const float* k_k; const float* k_a;
  const float* r_k; const float* ln_g; const float* ln_b; const float* q_norm; const float* k_norm;
  const float* lam_vec; const float* subln; const float* ple_proj; const float* ple_norm;
  const float* gate_w; const float* gate_b;
  float* out;
  bf16_t* X; bf16_t* PB; float* RS;
  bf16_t* CR; bf16_t* GRW; bf16_t* Q; bf16_t* KB; bf16_t* VT; bf16_t* GDA;
  bf16_t* R1; bf16_t* R2; float* EPART; bf16_t* YB; bf16_t* BV;
  bf16_t* WIN; bf16_t* WOUT; bf16_t* WPLE; bf16_t* WGATE; bf16_t* WUPT; bf16_t* AUPT;
  float* consts; int* ctr;
};

struct Group { int tok0, B, S, ntok; };

DI unsigned pack2(float a, float b) {
  typedef __attribute__((ext_vector_type(2))) __bf16 bf2;
  f32x2 v = {a, b};
  bf2 r = __builtin_convertvector(v, bf2);
  return __builtin_bit_cast(unsigned, r);
}
DI bf16_t f2bf(float a) { return (bf16_t)(pack2(a, 0.f) & 0xffffu); }
DI float bf2f(unsigned short u) { return __uint_as_float(((unsigned)u) << 16); }
DI float bflo(unsigned u) { return __uint_as_float(u << 16); }
DI float bfhi(unsigned u) { return __uint_as_float(u & 0xffff0000u); }
template <int CTRL> DI float dppf(float x) {
  return __int_as_float(__builtin_amdgcn_update_dpp(0, __float_as_int(x), CTRL, 0xF, 0xF, true));
}
DI float red4(float x) { x += dppf<0xB1>(x); x += dppf<0x4E>(x); return x; }
DI float red8(float x) { x = red4(x); x += dppf<0x141>(x); return x; }
DI float red32(float x) {
  x += __shfl_xor(x, 1); x += __shfl_xor(x, 2); x += __shfl_xor(x, 4); x += __shfl_xor(x, 8); x += __shfl_xor(x, 16);
  return x;
}
DI float sigmoidf_(float x) { return __builtin_amdgcn_rcpf(1.f + __expf(-x)); }
DI float siluf_(float x) { return x * __builtin_amdgcn_rcpf(1.f + __expf(-x)); }
DI float tanhf_(float x) { return 1.f - 2.f * __builtin_amdgcn_rcpf(1.f + __expf(2.f * x)); }
DI int opq(int x) { asm volatile("" : "+v"(x)); return x; }
DI int opqs(int x) { asm volatile("" : "+s"(x)); return x; }
DI int crow(int i, int h) { return (i & 3) + 8 * (i >> 2) + 4 * h; }

DI void transpose_convert(const float* __restrict__ src, int K, int N, bf16_t* __restrict__ dst, int Nd, int mode,
                          const float* __restrict__ rowscale, float* lds) {
  const int tid = opq(threadIdx.x);
  const int tk = K >> 6, tn = Nd >> 6;
  for (int t = blockIdx.x; t < tk * tn; t += gridDim.x) {
    const int k0 = (t % tk) << 6, n0 = (t / tk) << 6;
    int sn0 = n0;
    if (mode == 1) sn0 = (n0 < 1728) ? n0 : (n0 < 1792 ? -1 : n0 - 64);
    __syncthreads();
#pragma unroll
    for (int it = 0; it < 2; ++it) {
      const int kk = (tid >> 4) + 32 * it, n4 = (tid & 15) * 4;
      f32x4 v = {0.f, 0.f, 0.f, 0.f};
      if (sn0 >= 0) v = *(const f32x4*)(src + (size_t)(k0 + kk) * N + sn0 + n4);
      const float sc = rowscale ? rowscale[k0 + kk] : 1.f;
      lds[kk * 65 + n4 + 0] = v[0] * sc; lds[kk * 65 + n4 + 1] = v[1] * sc;
      lds[kk * 65 + n4 + 2] = v[2] * sc; lds[kk * 65 + n4 + 3] = v[3] * sc;
    }
    __syncthreads();
    const int nn = tid >> 3, k8 = (tid & 7) * 8;
    u32x4 o;
    o[0] = pack2(lds[(k8 + 0) * 65 + nn], lds[(k8 + 1) * 65 + nn]);
    o[1] = pack2(lds[(k8 + 2) * 65 + nn], lds[(k8 + 3) * 65 + nn]);
    o[2] = pack2(lds[(k8 + 4) * 65 + nn], lds[(k8 + 5) * 65 + nn]);
    o[3] = pack2(lds[(k8 + 6) * 65 + nn], lds[(k8 + 7) * 65 + nn]);
    *(u32x4*)(dst + (size_t)(n0 + nn) * K + k0 + k8) = o;
  }
}

DI void phase_weights(const Params& P, char* lds) {
  float* l = (float*)lds;
  for (int L = 0; L < 2; ++L) {
    transpose_convert(P.w_in + (size_t)L * DM * IN_COLS, DM, IN_COLS, P.WIN + (size_t)L * NIN * DM, NIN, 1, P.norm_pre + L * DM, l);
    transpose_convert(P.w_out + (size_t)L * DM * DM, DM, DM, P.WOUT + (size_t)L * DM * DM, DM, 0, nullptr, l);
    transpose_convert(P.ple_proj + (size_t)L * DPLE * DM, DPLE, DM, P.WPLE + (size_t)L * DM * DPLE, DM, 0, nullptr, l);
    transpose_convert(P.gate_w + (size_t)L * DM * DM, DM, DM, P.WGATE + (size_t)L * DM * DM, DM, 0, nullptr, l);
    for (int d = 0; d < 2; ++d)
      transpose_convert(P.w_up + (size_t)(L * 2 + d) * 64 * 512, 64, 512, P.WUPT + (size_t)(L * 2 + d) * 512 * 64, 512, 0, nullptr, l);
    transpose_convert(P.a_up + (size_t)L * 64 * 512, 64, 512, P.AUPT + (size_t)L * 512 * 64, 512, 0, nullptr, l);
  }
  if (blockIdx.x == 0 && threadIdx.x < 128) {
    const int L = threadIdx.x >> 6, lane = threadIdx.x & 63;
    const float* lv = P.lam_vec + L * 256;
    float s01 = lv[lane] * lv[64 + lane], s23 = lv[128 + lane] * lv[192 + lane];
    float mq = fmaxf(fabsf(P.q_norm[L * 128 + lane]), fabsf(P.q_norm[L * 128 + 64 + lane]));
    float mk = fmaxf(fabsf(P.k_norm[L * 128 + lane]), fabsf(P.k_norm[L * 128 + 64 + lane]));
    for (int o = 32; o >= 1; o >>= 1) {
      s01 += __shfl_xor(s01, o); s23 += __shfl_xor(s23, o);
      mq = fmaxf(mq, __shfl_xor(mq, o)); mk = fmaxf(mk, __shfl_xor(mk, o));
    }
    if (lane == 0) {
      const float lam_init = 0.8f - 0.6f * expf(-0.3f * (float)L);
      P.consts[L * 4 + 0] = expf(s01) - expf(s23) + lam_init;
      P.consts[L * 4 + 1] = 8.25f * mq * mk * LOG2E;
      P.consts[L * 4 + 2] = lam_init;
    }
  }
}

DI void phase_prep(const Params& P, int L) {
  const float* h0 = L == 0 ? P.x_prompt : P.out;
  const float* h1 = L == 0 ? P.x_sample : P.out + (size_t)NP * DM;
  const float* p0 = P.p_prompt + (size_t)L * NP * DPLE;
  const float* p1 = P.p_sample + (size_t)L * NS * DPLE;
  const int tidp = opq(threadIdx.x);
  const int lane = tidp & 63;
  const int gw = blockIdx.x * (NTHREADS / 64) + (tidp >> 6), nw = gridDim.x * (NTHREADS / 64);
  for (int tok = gw; tok < NTOK; tok += nw) {
    const float* hr = tok < NP ? h0 + (size_t)tok * DM : h1 + (size_t)(tok - NP) * DM;
    float ss = 0.f;
#pragma unroll
    for (int i = 0; i < 4; ++i) {
      f32x4 v = *(const f32x4*)(hr + i * 256 + lane * 4);
      ss += v[0] * v[0] + v[1] * v[1] + v[2] * v[2] + v[3] * v[3];
      u32x2 o = {pack2(v[0], v[1]), pack2(v[2], v[3])};
      *(u32x2*)(P.X + (size_t)tok * DM + i * 256 + lane * 4) = o;
    }
    for (int o = 32; o >= 1; o >>= 1) ss += __shfl_xor(ss, o);
    if (lane == 0) P.RS[tok] = rsqrtf(ss * (1.f / DM) + 1e-6f);
    const float* pr = tok < NP ? p0 + (size_t)tok * DPLE : p1 + (size_t)(tok - NP) * DPLE;
    f32x4 v = *(const f32x4*)(pr + lane * 4);
    u32x2 o = {pack2(v[0], v[1]), pack2(v[2], v[3])};
    *(u32x2*)(P.PB + (size_t)tok * DPLE + lane * 4) = o;
  }
}

constexpr int GSTR = 144;
constexpr int GA_BYTES = 256 * GSTR;
constexpr int GSTAGE = 2 * GA_BYTES;

DI void gemm_mainloop(const bf16_t* __restrict__ A, int lda, const bf16_t* __restrict__ Bw, int ldb, int K,
                      int m0, int n0, char* lds, f32x16 (&acc)[2][4]) {
  const int tid = opq(threadIdx.x), lane = tid & 63, w = tid >> 6, hh = lane >> 5, r = lane & 31;
  const int wm = w >> 1, wn = w & 1;
#pragma unroll
  for (int mi = 0; mi < 2; ++mi)
#pragma unroll
    for (int ni = 0; ni < 4; ++ni)
#pragma unroll
      for (int i = 0; i < 16; ++i) acc[mi][ni][i] = 0.f;
  const int lrow = tid >> 3, lkc = tid & 7;
  const bf16_t* ap = A + (size_t)(m0 + lrow) * lda + lkc * 8;
  const bf16_t* bp = Bw + (size_t)(n0 + lrow) * ldb + lkc * 8;
  const int nk = K >> 6;
  u32x4 ra[4], rb[4];
#pragma unroll
  for (int i = 0; i < 4; ++i) {
    ra[i] = *(const u32x4*)(ap + (size_t)(64 * i) * lda);
    rb[i] = *(const u32x4*)(bp + (size_t)(64 * i) * ldb);
  }
  __syncthreads();
#pragma unroll
  for (int i = 0; i < 4; ++i) {
    *(u32x4*)(lds + (lrow + 64 * i) * GSTR + lkc * 16) = ra[i];
    *(u32x4*)(lds + GA_BYTES + (lrow + 64 * i) * GSTR + lkc * 16) = rb[i];
  }
  __syncthreads();
  for (int kt = 0; kt < nk; ++kt) {
    const bool more = kt + 1 < nk;
    if (more) {
#pragma unroll
      for (int i = 0; i < 4; ++i) {
        ra[i] = *(const u32x4*)(ap + (size_t)(64 * i) * lda + (kt + 1) * 64);
        rb[i] = *(const u32x4*)(bp + (size_t)(64 * i) * ldb + (kt + 1) * 64);
      }
    }
    const char* sa = lds + (kt & 1) * GSTAGE + (wm * 64 + r) * GSTR + hh * 16;
    const char* sb = lds + (kt & 1) * GSTAGE + GA_BYTES + (wn * 128 + r) * GSTR + hh * 16;
#pragma unroll
    for (int ks = 0; ks < 4; ++ks) {
      bf16x8 fa[2], fb[4];
#pragma unroll
      for (int mi = 0; mi < 2; ++mi) fa[mi] = *(const bf16x8*)(sa + mi * 32 * GSTR + ks * 32);
#pragma unroll
      for (int ni = 0; ni < 4; ++ni) fb[ni] = *(const bf16x8*)(sb + ni * 32 * GSTR + ks * 32);
#pragma unroll
      for (int mi = 0; mi < 2; ++mi)
#pragma unroll
        for (int ni = 0; ni < 4; ++ni) acc[mi][ni] = MFMA(fa[mi], fb[ni], acc[mi][ni]);
    }
    if (more) {
      char* d = lds + ((kt + 1) & 1) * GSTAGE;
#pragma unroll
      for (int i = 0; i < 4; ++i) {
        *(u32x4*)(d + (lrow + 64 * i) * GSTR + lkc * 16) = ra[i];
        *(u32x4*)(d + GA_BYTES + (lrow + 64 * i) * GSTR + lkc * 16) = rb[i];
      }
    }
    __syncthreads();
  }
}

DI void phase_inproj(const Params& P, int L, const Group& G, char* lds) {
  const int tid = opq(threadIdx.x), lane = tid & 63, w = tid >> 6, hh = lane >> 5, r = lane & 31;
  const int wm = w >> 1, wn = w & 1;
  const int nmt = G.ntok >> 8, ntile = nmt * 17;
  const bf16_t* A = P.X + (size_t)G.tok0 * DM;
  const bf16_t* Bw = P.WIN + (size_t)L * NIN * DM;
  for (int t = blockIdx.x; t < ntile; t += gridDim.x) {
    const int mt = t / 17, nt = t % 17;
    const int m0 = mt << 8, n0 = nt << 8;
    f32x16 acc[2][4];
    gemm_mainloop(A, DM, Bw, DM, DM, m0, n0, lds, acc);
    const int colw = n0 + wn * 128;
    if (nt < 7) {
#pragma unroll
      for (int mi = 0; mi < 2; ++mi)
#pragma unroll
        for (int i = 0; i < 16; ++i) {
          const int row = m0 + wm * 64 + mi * 32 + crow(i, hh);
          const float rsv = P.RS[G.tok0 + row];
#pragma unroll
          for (int ni = 0; ni < 4; ++ni)
            P.CR[(size_t)row * CRW + colw + ni * 32 + r] = f2bf(acc[mi][ni][i] * rsv);
          __builtin_amdgcn_sched_barrier(0);
        }
    } else if (nt < 9 || nt >= 15) {
      bf16_t* dst = nt < 9 ? P.GRW : P.GDA;
      const int c0 = colw - (nt < 9 ? 1792 : 3840);
#pragma unroll
      for (int mi = 0; mi < 2; ++mi)
#pragma unroll
        for (int i = 0; i < 16; ++i) {
          const int row = m0 + wm * 64 + mi * 32 + crow(i, hh);
          const float rsv = P.RS[G.tok0 + row];
#pragma unroll
          for (int ni = 0; ni < 4; ++ni)
            dst[(size_t)row * 512 + c0 + ni * 32 + r] = f2bf(siluf_(acc[mi][ni][i] * rsv));
          __builtin_amdgcn_sched_barrier(0);
        }
    } else if (nt < 13) {
      const bool isq = nt < 11;
      bf16_t* dst = isq ? P.Q : P.KB;
      const int c0 = colw - (isq ? 2304 : 2816);
      const float* g = (isq ? P.q_norm : P.k_norm) + L * 128;
      const float osc = isq ? 0.125f * LOG2E : 1.f;
#pragma unroll
      for (int gi = 0; gi < 2; ++gi) {
        const float g0 = g[gi * 64 + r] * osc, g1 = g[gi * 64 + 32 + r] * osc;
#pragma unroll
        for (int mi = 0; mi < 2; ++mi)
#pragma unroll
          for (int i = 0; i < 16; ++i) {
            const int row = m0 + wm * 64 + mi * 32 + crow(i, hh);
            const float rsv = P.RS[G.tok0 + row];
            const float v0 = acc[mi][2 * gi][i] * rsv, v1 = acc[mi][2 * gi + 1][i] * rsv;
            const float ss = red32(v0 * v0 + v1 * v1);
            const float sc = rsqrtf(ss * (1.f / 64.f) + 1e-6f);
            dst[(size_t)row * 512 + c0 + gi * 64 + r] = f2bf(v0 * sc * g0);
            dst[(size_t)row * 512 + c0 + gi * 64 + 32 + r] = f2bf(v1 * sc * g1);
            __builtin_amdgcn_sched_barrier(0);
          }
      }
    } else {
      const int hd = (colw - 3328) >> 7;
      const int row0 = m0 + wm * 64;
      const int b = row0 / G.S, s0 = row0 % G.S;
#pragma unroll
      for (int mi = 0; mi < 2; ++mi)
#pragma unroll
        for (int q4 = 0; q4 < 4; ++q4) {
          const int s = s0 + mi * 32 + 8 * q4 + 4 * hh;
          const f32x4 r4 = *(const f32x4*)(P.RS + G.tok0 + b * G.S + s);
#pragma unroll
          for (int ni = 0; ni < 4; ++ni) {
            const int dv = ni * 32 + r;
            u32x2 o = {pack2(acc[mi][ni][4 * q4] * r4[0], acc[mi][ni][4 * q4 + 1] * r4[1]),
                       pack2(acc[mi][ni][4 * q4 + 2] * r4[2], acc[mi][ni][4 * q4 + 3] * r4[3])};
            *(u32x2*)(P.VT + ((size_t)((b * 4 + hd) * 128 + dv)) * G.S + s) = o;
          }
          __builtin_amdgcn_sched_barrier(0);
        }
    }
  }
}

DI void phase_outproj(const Params& P, int L, char* lds) {
  const int tid = opq(threadIdx.x), lane = tid & 63, w = tid >> 6, hh = lane >> 5, r = lane & 31;
  const int wm = w >> 1, wn = w & 1;
  const float* h0 = L == 0 ? P.x_prompt : P.out;
  const float* h1 = L == 0 ? P.x_sample : P.out + (size_t)NP * DM;
  const int nmt = NTOK >> 8, ntile = nmt * 4;
  for (int t = blockIdx.x; t < 2 * ntile; t += gridDim.x) {
    const bool isE = t >= ntile;
    const int tt = isE ? t - ntile : t;
    const int mt = tt >> 2, nt = tt & 3;
    const int m0 = mt << 8, n0 = nt << 8;
    f32x16 acc[2][4];
    if (!isE) {
      gemm_mainloop(P.X, DM, P.WOUT + (size_t)L * DM * DM, DM, DM, m0, n0, lds, acc);
#pragma unroll
      for (int mi = 0; mi < 2; ++mi)
#pragma unroll
        for (int i = 0; i < 16; ++i) {
          const int row = m0 + wm * 64 + mi * 32 + crow(i, hh);
          const float* hr = row < NP ? h0 + (size_t)row * DM : h1 + (size_t)(row - NP) * DM;
#pragma unroll
          for (int ni = 0; ni < 4; ++ni) {
            const int col = n0 + wn * 128 + ni * 32 + r;
            const float v = hr[col] + acc[mi][ni][i];
            P.out[(size_t)row * DM + col] = v;
            P.R1[(size_t)row * DM + col] = f2bf(v);
          }
        }
    } else {
      gemm_mainloop(P.PB, DPLE, P.WPLE + (size_t)L * DM * DPLE, DPLE, DPLE, m0, n0, lds, acc);
#pragma unroll
      for (int mi = 0; mi < 2; ++mi)
#pragma unroll
        for (int i = 0; i < 16; ++i) {
          const int row = m0 + wm * 64 + mi * 32 + crow(i, hh);
          float ss = 0.f;
#pragma unroll
          for (int ni = 0; ni < 4; ++ni) {
            const int col = n0 + wn * 128 + ni * 32 + r;
            const float v = acc[mi][ni][i];
            ss += v * v;
            P.R2[(size_t)row * DM + col] = f2bf(v);
          }
          ss = red32(ss);
          if (r == 0) P.EPART[(size_t)(nt * 2 + wn) * NTOK + row] = ss;
        }
    }
  }
}

DI void phase_gate(const Params& P, int L, char* lds) {
  const int tid = opq(threadIdx.x), lane = tid & 63, w = tid >> 6, hh = lane >> 5, r = lane & 31;
  const int wm = w >> 1, wn = w & 1;
  const int nmt = NTOK >> 8, ntile = nmt * 4;
  for (int t = blockIdx.x; t < ntile; t += gridDim.x) {
    const int mt = t >> 2, nt = t & 3;
    const int m0 = mt << 8, n0 = nt << 8;
    f32x16 acc[2][4];
    gemm_mainloop(P.R1, DM, P.WGATE + (size_t)L * DM * DM, DM, DM, m0, n0, lds, acc);
    float gb[4], pn[4];
#pragma unroll
    for (int ni = 0; ni < 4; ++ni) {
      const int col = n0 + wn * 128 + ni * 32 + r;
      gb[ni] = P.gate_b[L * DM + col]; pn[ni] = P.ple_norm[L * DM + col];
    }
#pragma unroll
    for (int mi = 0; mi < 2; ++mi)
#pragma unroll
      for (int i = 0; i < 16; ++i) {
        const int row = m0 + wm * 64 + mi * 32 + crow(i, hh);
        float es = 0.f;
#pragma unroll
        for (int j = 0; j < 8; ++j) es += P.EPART[(size_t)j * NTOK + row];
        const float rse = rsqrtf(es * (1.f / DM) + 1e-6f);
#pragma unroll
        for (int ni = 0; ni < 4; ++ni) {
          const int col = n0 + wn * 128 + ni * 32 + r;
          const float gt = sigmoidf_(acc[mi][ni][i] + gb[ni]);
          const float e = bf2f(P.R2[(size_t)row * DM + col]) * rse * pn[ni];
          P.out[(size_t)row * DM + col] += gt * e;
        }
      }
  }
}

constexpr int TC = 32;
constexpr int SC_OP = TC * 64 * 4;
constexpr int SC_BUF = 7 * SC_OP + 2 * TC * 144 + 128;

template <int N> DI void red64v(float (&x)[N]) {
#pragma unroll
  for (int i = 0; i < N; ++i) x[i] += dppf<0xB1>(x[i]);
#pragma unroll
  for (int i = 0; i < N; ++i) x[i] += dppf<0x4E>(x[i]);
#pragma unroll
  for (int i = 0; i < N; ++i) x[i] += dppf<0x141>(x[i]);
#pragma unroll
  for (int i = 0; i < N; ++i) x[i] += dppf<0x140>(x[i]);
#pragma unroll
  for (int i = 0; i < N; ++i) x[i] += __shfl_xor(x[i], 16);
#pragma unroll
  for (int i = 0; i < N; ++i) x[i] += __shfl_xor(x[i], 32);
}

struct ScanOps { f32x4 w0, w1, a0, a1, b0, b1, k0, k1, r0, r1; float v; };

DI ScanOps scan_load(const float* __restrict__ ob, int s, int coff, int row) {
  ScanOps o;
  const float* p = ob + s * 64 + coff;
  o.w0 = *(const f32x4*)(p);                 o.w1 = *(const f32x4*)(p + 4);
  o.a0 = *(const f32x4*)(p + TC * 64);       o.a1 = *(const f32x4*)(p + TC * 64 + 4);
  o.b0 = *(const f32x4*)(p + 2 * TC * 64);   o.b1 = *(const f32x4*)(p + 2 * TC * 64 + 4);
  o.k0 = *(const f32x4*)(p + 3 * TC * 64);   o.k1 = *(const f32x4*)(p + 3 * TC * 64 + 4);
  o.r0 = *(const f32x4*)(p + 4 * TC * 64);   o.r1 = *(const f32x4*)(p + 4 * TC * 64 + 4);
  o.v = ob[5 * TC * 64 + s * 64 + row];
  return o;
}

DI f32x2 lo2(f32x4 x) { return f32x2{x[0], x[1]}; }
DI f32x2 hi2(f32x4 x) { return f32x2{x[2], x[3]}; }

DI float scan_step(f32x2 (&st)[4], const ScanOps& o) {
  const f32x2 a[4] = {lo2(o.a0), hi2(o.a0), lo2(o.a1), hi2(o.a1)};
  const f32x2 wv[4] = {lo2(o.w0), hi2(o.w0), lo2(o.w1), hi2(o.w1)};
  const f32x2 bv[4] = {lo2(o.b0), hi2(o.b0), lo2(o.b1), hi2(o.b1)};
  const f32x2 kv[4] = {lo2(o.k0), hi2(o.k0), lo2(o.k1), hi2(o.k1)};
  const f32x2 rv[4] = {lo2(o.r0), hi2(o.r0), lo2(o.r1), hi2(o.r1)};
  f32x2 p = st[0] * a[0];
  p = st[1] * a[1] + p; p = st[2] * a[2] + p; p = st[3] * a[3] + p;
  const float sa = red8(p[0] + p[1]);
  const f32x2 sa2 = {sa, sa};
  const f32x2 v2 = {o.v, o.v};
  f32x2 q = {0.f, 0.f};
#pragma unroll
  for (int j = 0; j < 4; ++j) {
    f32x2 x = st[j] * wv[j];
    x = sa2 * bv[j] + x;
    x = v2 * kv[j] + x;
    st[j] = x;
    q = x * rv[j] + q;
  }
  return red8(q[0] + q[1]);
}

DI void scan_task(const Params& P, int L_, const Group& G, int task, char* lds) {
  const int L = opqs(__builtin_amdgcn_readfirstlane(L_));
  const int tid = opq(threadIdx.x), lane = tid & 63, w = tid >> 6;
  const int dir = task & 1, b = task >> 4, hd = (task >> 1) & 7;
  const int S = G.S, nc = S / TC;
  const int sg = dir ? -1 : 1;
  const int etg = tid >> 6, ec = tid & 63;
  const int srow = w * 8 + (lane >> 3), scs = lane & 7;
  const int mmat = (w >> 1) & 1, mnb = w & 1, hh = lane >> 5, r = lane & 31;

  const float* cw = P.conv_w + (size_t)L * 3 * 1728;
  const float* cb = P.conv_b + (size_t)L * 1728;
  const int cq[5] = {hd * 64 + ec, 512 + hd * 64 + ec, 1024 + hd * 64 + ec, 1536 + dir * 64 + ec, 1664 + ec};
  const int ch = hd * 64 + ec;
  const float c_kk = P.k_k[L * 512 + ch], c_ka = P.k_a[L * 512 + ch], c_rk = P.r_k[L * 512 + ch];
  const bf16_t* wsrc = (mmat ? P.AUPT + (size_t)L * 512 * 64 : P.WUPT + (size_t)(L * 2 + dir) * 512 * 64) +
                       (size_t)(hd * 64 + mnb * 32 + r) * 64 + hh * 8;
  const float c_lora0 = mmat ? P.a0[(size_t)L * 512 + hd * 64 + mnb * 32 + r]
                             : P.w0[(size_t)(L * 2 + dir) * 512 + hd * 64 + mnb * 32 + r];
  const bf16_t* crb = P.CR + (size_t)b * S * CRW;

  f32x2 st[4];
#pragma unroll
  for (int j = 0; j < 4; ++j) st[j] = f32x2{0.f, 0.f};

  u32x4 rv[3];
  auto stage_load = [&](int cc) {
    const int tlo = (dir ? S - (cc + 1) * TC : cc * TC) - 1;
    const int t = opq(tid);
#pragma unroll
    for (int it = 0; it < 3; ++it) {
      int id = t + it * 512;
      id = id < 34 * 40 ? id : 34 * 40 - 1;
      const int rr = id / 40, cc8 = id % 40, q = cc8 >> 3, c8 = (cc8 & 7) * 8;
      const int tok = tlo + rr;
      const bool ok = tok >= 0 && tok < S;
      const int tokc = tok < 0 ? 0 : (tok >= S ? S - 1 : tok);
      const int col = (q == 0 ? hd * 64 : q == 1 ? 512 + hd * 64 : q == 2 ? 1024 + hd * 64 : q == 3 ? 1536 + dir * 64 : 1664) + c8;
      const u32x4 v = *(const u32x4*)(crb + (size_t)tokc * CRW + col);
      const u32x4 z = {0u, 0u, 0u, 0u};
      rv[it] = ok ? v : z;
    }
  };
  auto stage_store = [&](char* dst) {
    const int t = opq(tid);
#pragma unroll
    for (int it = 0; it < 3; ++it) {
      int id = t + it * 512;
      id = id < 34 * 40 ? id : 34 * 40 - 1;
      *(u32x4*)(dst + (id / 40) * 640 + (id % 40) * 16) = rv[it];
    }
  };
  __syncthreads();
  stage_load(0);
  stage_store(lds);

  for (int c = 0; c < nc; ++c) {
    char* eb = lds + (c & 1) * SC_BUF;
    float* eA = (float*)(eb + SC_OP); float* eB = (float*)(eb + 2 * SC_OP);
    float* eK = (float*)(eb + 3 * SC_OP); float* eR = (float*)(eb + 4 * SC_OP); float* eV = (float*)(eb + 5 * SC_OP);
    float* eY = (float*)(eb + 6 * SC_OP);
    bf16_t* eZT = (bf16_t*)(eb + 7 * SC_OP); bf16_t* eZA = (bf16_t*)(eb + 7 * SC_OP + TC * 144);
    float* eBon = (float*)(eb + 7 * SC_OP + 2 * TC * 144);
    float cwp[5], cwc[5], cwn[5], cbb[5];
    {
      const int eco = opq(ec);
#pragma unroll
      for (int q = 0; q < 5; ++q) {
        const int cqq = cq[q] - ec + eco;
        const float w0 = cw[cqq], w1 = cw[1728 + cqq], w2 = cw[2 * 1728 + cqq];
        cwp[q] = dir ? w2 : w0; cwc[q] = w1; cwn[q] = dir ? w0 : w2; cbb[q] = cb[cqq];
      }
    }
    __syncthreads();
    float kreg[4];
    {
      const bf16_t* raw = (const bf16_t*)eb;
      const int rr0 = dir ? TC - etg * 4 : etg * 4 + 1;
      float xr[6][5];
#pragma unroll
      for (int j = 0; j < 6; ++j)
#pragma unroll
        for (int q = 0; q < 5; ++q) xr[j][q] = bf2f(raw[(rr0 + sg * (j - 1)) * 320 + q * 64 + ec]);
#pragma unroll
      for (int i = 0; i < 4; ++i) {
        float v[5];
#pragma unroll
        for (int q = 0; q < 5; ++q) v[q] = cbb[q] + cwp[q] * xr[i][q] + cwc[q] * xr[i + 1][q] + cwn[q] * xr[i + 2][q];
        const int s = etg * 4 + i;
        eR[s * 64 + ec] = v[0];
        kreg[i] = v[1];
        eV[s * 64 + ec] = v[2];
        eZT[s * 72 + ec] = f2bf(tanhf_(v[3]));
        eZA[s * 72 + ec] = f2bf(v[4]);
      }
    }
    if (c + 1 < nc) stage_load(c + 1);
    bf16x8 lfb[4];
    if (w < 4) {
#pragma unroll
      for (int ks = 0; ks < 4; ++ks) lfb[ks] = *(const bf16x8*)(wsrc + ks * 16);
    }
    __syncthreads();
    if (w < 4) {
      f32x16 acc;
#pragma unroll
      for (int i = 0; i < 16; ++i) acc[i] = 0.f;
      const char* asrc = eb + 7 * SC_OP + (mmat ? TC * 144 : 0) + r * 144 + hh * 16;
#pragma unroll
      for (int ks = 0; ks < 4; ++ks) {
        const bf16x8 fa = *(const bf16x8*)(asrc + ks * 32);
        acc = MFMA(fa, lfb[ks], acc);
      }
      if (mmat == 0) {
        float* dW = (float*)(eb);
#pragma unroll
        for (int i = 0; i < 16; ++i)
          dW[crow(i, hh) * 64 + mnb * 32 + r] = __expf(-0.6065306597126334f * sigmoidf_(c_lora0 + acc[i]));
      } else {
#pragma unroll
        for (int i = 0; i < 16; ++i) eA[crow(i, hh) * 64 + mnb * 32 + r] = sigmoidf_(c_lora0 + acc[i]);
      }
    }
    __syncthreads();
    {
      float ag[4], kk[4], ss[4], km[4], bn[4];
#pragma unroll
      for (int i = 0; i < 4; ++i) {
        const int s = etg * 4 + i;
        ag[i] = eA[s * 64 + ec];
        kk[i] = kreg[i] * c_kk;
        ss[i] = kk[i] * kk[i];
        km[i] = kreg[i] * (1.f + (ag[i] - 1.f) * c_ka);
        bn[i] = eR[s * 64 + ec] * km[i] * c_rk;
      }
      red64v<4>(ss);
      red64v<4>(bn);
#pragma unroll
      for (int i = 0; i < 4; ++i) {
        const int s = etg * 4 + i;
        const float kn = kk[i] * rsqrtf(ss[i] + 1e-12f);
        eK[s * 64 + ec] = km[i];
        eA[s * 64 + ec] = -kn;
        eB[s * 64 + ec] = kn * ag[i];
        if (ec == 0) eBon[s] = bn[i];
      }
    }
    __syncthreads();
    {
      const float* sb = (const float*)eb;
      ScanOps cur = scan_load(sb, 0, scs * 8, srow);
#pragma unroll 1
      for (int s8 = 0; s8 < TC; s8 += 8) {
        float ykeep = 0.f;
#pragma unroll
        for (int u = 0; u < 8; ++u) {
          const int s = s8 + u;
          const ScanOps nxt = scan_load(sb, s + 1 < TC ? s + 1 : s, scs * 8, srow);
          const float y = scan_step(st, cur);
          if (u == scs) ykeep = y;
          cur = nxt;
        }
        eY[(s8 + scs) * 64 + srow] = ykeep;
      }
    }
    if (c + 1 < nc) stage_store(lds + ((c + 1) & 1) * SC_BUF);
    __syncthreads();
    {
      const int t0 = dir ? S - 1 - (c * TC + etg * 4) : c * TC + etg * 4;
#pragma unroll
      for (int i = 0; i < 4; ++i) {
        const int s = etg * 4 + i;
        const size_t lt = (size_t)b * S + t0 + sg * i;
        const float y = eY[s * 64 + ec];
        if (dir == 0) {
          P.X[((size_t)G.tok0 + lt) * DM + ch] = f2bf(y);
          P.BV[lt * 512 + ch] = f2bf(eBon[s] * eV[s * 64 + ec]);
        } else {
          P.YB[lt * 512 + ch] = f2bf(y);
        }
      }
    }
  }
}

DI void phase_rwkv_final(const Params& P, int L, const Group& G) {
  const int tidp = opq(threadIdx.x);
  const int lane = tidp & 63;
  const int gw = blockIdx.x * (NTHREADS / 64) + (tidp >> 6), nw = gridDim.x * (NTHREADS / 64);
  const f32x4 g0 = *(const f32x4*)(P.ln_g + L * 512 + lane * 8), g1 = *(const f32x4*)(P.ln_g + L * 512 + lane * 8 + 4);
  const f32x4 b0 = *(const f32x4*)(P.ln_b + L * 512 + lane * 8), b1 = *(const f32x4*)(P.ln_b + L * 512 + lane * 8 + 4);
  const float lg[8] = {g0[0], g0[1], g0[2], g0[3], g1[0], g1[1], g1[2], g1[3]};
  const float lb[8] = {b0[0], b0[1], b0[2], b0[3], b1[0], b1[1], b1[2], b1[3]};
  for (int lt = gw; lt < G.ntok; lt += nw) {
    bf16_t* xp = P.X + ((size_t)G.tok0 + lt) * DM + lane * 8;
    const u32x4 yf = *(const u32x4*)xp;
    const u32x4 yb = *(const u32x4*)(P.YB + (size_t)lt * 512 + lane * 8);
    const u32x4 bv = *(const u32x4*)(P.BV + (size_t)lt * 512 + lane * 8);
    const u32x4 gt = *(const u32x4*)(P.GRW + (size_t)lt * 512 + lane * 8);
    float y[8];
    float sum = 0.f;
#pragma unroll
    for (int j = 0; j < 4; ++j) {
      y[2 * j] = bflo(yf[j]) + bflo(yb[j]); y[2 * j + 1] = bfhi(yf[j]) + bfhi(yb[j]);
      sum += y[2 * j] + y[2 * j + 1];
    }
    const float mu = red8(sum) * (1.f / 64.f);
    float vs = 0.f;
#pragma unroll
    for (int j = 0; j < 8; ++j) { y[j] -= mu; vs += y[j] * y[j]; }
    const float rstd = rsqrtf(red8(vs) * (1.f / 64.f) + 64e-5f);
    u32x4 o;
#pragma unroll
    for (int j = 0; j < 4; ++j) {
      const float o0 = (y[2 * j] * rstd * lg[2 * j] + lb[2 * j] + bflo(bv[j])) * bflo(gt[j]);
      const float o1 = (y[2 * j + 1] * rstd * lg[2 * j + 1] + lb[2 * j + 1] + bfhi(bv[j])) * bfhi(gt[j]);
      o[j] = pack2(o0, o1);
    }
    *(u32x4*)xp = o;
  }
}

constexpr int AT_K = 64 * GSTR;
constexpr int AT_STAGE = 2 * AT_K + 128 * GSTR;

DI void attn_item(const Params& P, int L_, const Group& G, int item, char* lds) {
  const int L = opqs(__builtin_amdgcn_readfirstlane(L_));
  const int tid = opq(threadIdx.x), lane = tid & 63, w = tid >> 6, hh = lane >> 5, r = lane & 31;
  const int S = G.S, nqb = S >> 7;
  const int qblk = item % nqb, bh = item / nqb, hd = bh & 3, b = bh >> 2;
  const int map = w & 1, qb = w >> 1;
  const int q0 = qblk * 128 + qb * 32;
  const size_t ltq = (size_t)b * S + q0 + r;
  bf16x8 qf[4];
  {
    const bf16_t* qp = P.Q + ltq * 512 + hd * 128 + map * 64 + hh * 8;
#pragma unroll
    for (int ks = 0; ks < 4; ++ks) qf[ks] = *(const bf16x8*)(qp + ks * 16);
  }
  f32x16 o[4];
#pragma unroll
  for (int d = 0; d < 4; ++d)
#pragma unroll
    for (int i = 0; i < 16; ++i) o[d][i] = 0.f;
  float lsum = 0.f;
  const float slope2 = exp2f(-2.f * (float)(hd + 1)) * LOG2E;
  const float lam = P.consts[L * 4 + 0], C2 = P.consts[L * 4 + 1], lam_init = P.consts[L * 4 + 2];
  const float qposf = (float)(q0 + r);
  const int nt = S >> 6;
  const int lrow = tid >> 3, lck = tid & 7;
  const bf16_t* k0p = P.KB + ((size_t)b * S + lrow) * 512 + hd * 128 + lck * 8;
  const bf16_t* v0p = P.VT + ((size_t)((b * 4 + hd) * 128 + lrow)) * S + lck * 8;
  u32x4 rk0, rk1, rv0, rv1;
  rk0 = *(const u32x4*)(k0p); rk1 = *(const u32x4*)(k0p + 64);
  rv0 = *(const u32x4*)(v0p); rv1 = *(const u32x4*)(v0p + (size_t)64 * S);
  __syncthreads();
  *(u32x4*)(lds + lrow * GSTR + lck * 16) = rk0;
  *(u32x4*)(lds + AT_K + lrow * GSTR + lck * 16) = rk1;
  *(u32x4*)(lds + 2 * AT_K + lrow * GSTR + lck * 16) = rv0;
  *(u32x4*)(lds + 2 * AT_K + (lrow + 64) * GSTR + lck * 16) = rv1;
  __syncthreads();
  const int krow = (r & ~12) | ((r & 4) << 1) | ((r & 8) >> 1);
  for (int t = 0; t < nt; ++t) {
    const bool more = t + 1 < nt;
    if (more) {
      rk0 = *(const u32x4*)(k0p + (size_t)(t + 1) * 64 * 512); rk1 = *(const u32x4*)(k0p + (size_t)(t + 1) * 64 * 512 + 64);
      rv0 = *(const u32x4*)(v0p + (t + 1) * 64); rv1 = *(const u32x4*)(v0p + (size_t)64 * S + (t + 1) * 64);
    }
    const char* kbuf = lds + (t & 1) * AT_STAGE + map * AT_K;
    const char* vbuf = lds + (t & 1) * AT_STAGE + 2 * AT_K;
    f32x16 s0, s1;
    const float base = (float)(t * 64 + 8 * hh) - qposf;
#pragma unroll
    for (int i = 0; i < 16; ++i) {
      const float d0 = base + (float)(16 * (i >> 3) + (i & 7));
      s0[i] = fmaf(fabsf(d0), -slope2, -C2);
      s1[i] = fmaf(fabsf(d0 + 32.f), -slope2, -C2);
    }
#pragma unroll
    for (int ks = 0; ks < 4; ++ks) {
      const bf16x8 a0 = *(const bf16x8*)(kbuf + krow * GSTR + ks * 32 + hh * 16);
      const bf16x8 a1 = *(const bf16x8*)(kbuf + (32 + krow) * GSTR + ks * 32 + hh * 16);
      s0 = MFMA(a0, qf[ks], s0);
      s1 = MFMA(a1, qf[ks], s1);
    }
    bf16x8 pf[4];
    {
      u32x4 pk[4];
#pragma unroll
      for (int i = 0; i < 16; i += 2) {
        const float e0 = __builtin_amdgcn_exp2f(s0[i]), e1 = __builtin_amdgcn_exp2f(s0[i + 1]);
        const float e2 = __builtin_amdgcn_exp2f(s1[i]), e3 = __builtin_amdgcn_exp2f(s1[i + 1]);
        lsum += (e0 + e1) + (e2 + e3);
        pk[i >> 3][(i & 7) >> 1] = pack2(e0, e1);
        pk[2 + (i >> 3)][(i & 7) >> 1] = pack2(e2, e3);
      }
#pragma unroll
      for (int j = 0; j < 4; ++j) pf[j] = __builtin_bit_cast(bf16x8, pk[j]);
    }
#pragma unroll
    for (int dvb = 0; dvb < 4; ++dvb)
#pragma unroll
      for (int j = 0; j < 4; ++j) {
        const bf16x8 va = *(const bf16x8*)(vbuf + (dvb * 32 + r) * GSTR + (16 * j + 8 * hh) * 2);
        o[dvb] = MFMA(va, pf[j], o[dvb]);
      }
    if (more) {
      char* d = lds + ((t + 1) & 1) * AT_STAGE;
      *(u32x4*)(d + lrow * GSTR + lck * 16) = rk0;
      *(u32x4*)(d + AT_K + lrow * GSTR + lck * 16) = rk1;
      *(u32x4*)(d + 2 * AT_K + lrow * GSTR + lck * 16) = rv0;
      *(u32x4*)(d + 2 * AT_K + (lrow + 64) * GSTR + lck * 16) = rv1;
    }
    __syncthreads();
  }
  lsum += __shfl_xor(lsum, 32);
  const float linv = 1.f / lsum;
  float* comb = (float*)lds;
  if (map == 1) {
#pragma unroll
    for (int dvb = 0; dvb < 4; ++dvb)
#pragma unroll
      for (int i = 0; i < 16; ++i) comb[(qb * 64 + dvb * 16 + i) * 64 + lane] = o[dvb][i] * linv;
  }
  __syncthreads();
  if (map == 0) {
    float ss = 0.f;
#pragma unroll
    for (int dvb = 0; dvb < 4; ++dvb)
#pragma unroll
      for (int i = 0; i < 16; ++i) {
        const float v = o[dvb][i] * linv - lam * comb[(qb * 64 + dvb * 16 + i) * 64 + lane];
        o[dvb][i] = v; ss += v * v;
      }
    ss += __shfl_xor(ss, 32);
    const float sc = rsqrtf(ss * (1.f / 128.f) + 1e-6f) * (1.f - lam_init);
    const bf16_t* gp = P.GDA + ltq * 512 + hd * 128;
    bf16_t* yp = P.X + ((size_t)G.tok0 + ltq) * DM + 512 + hd * 128;
    const float* sl = P.subln + L * 128;
#pragma unroll
    for (int dvb = 0; dvb < 4; ++dvb)
#pragma unroll
      for (int q4 = 0; q4 < 4; ++q4) {
        const int dv = dvb * 32 + 8 * q4 + 4 * hh;
        const u32x2 g = *(const u32x2*)(gp + dv);
        const f32x4 s4 = *(const f32x4*)(sl + dv);
        u32x2 ov = {pack2(o[dvb][4 * q4] * sc * s4[0] * bflo(g[0]), o[dvb][4 * q4 + 1] * sc * s4[1] * bfhi(g[0])),
                    pack2(o[dvb][4 * q4 + 2] * sc * s4[2] * bflo(g[1]), o[dvb][4 * q4 + 3] * sc * s4[3] * bfhi(g[1]))};
        *(u32x2*)(yp + dv) = ov;
      }
  }
}

DI void phase_mixers(const Params& P, int L, const Group& G, int* ctr, char* lds, int* s_item, int mode = 0) {
  const int nscan = mode == 2 ? 0 : G.B * 16;
  const int nattn = mode == 1 ? 0 : G.B * 4 * (G.S >> 7);
  const int total = nscan + nattn;
  for (;;) {
    __syncthreads();
    if (threadIdx.x == 0) *s_item = atomicAdd(ctr, 1);
    __syncthreads();
    const int it = *s_item;
    if (it >= total) break;
    if (it < nscan) scan_task(P, L, G, it, lds);
    else attn_item(P, L, G, it - nscan, lds);
  }
}

__global__ void __launch_bounds__(NTHREADS) fwd_megakernel(Params P) {
  __shared__ __attribute__((aligned(16))) char lds[LDS_BYTES];
  __shared__ int s_item;
  cg::grid_group grid = cg::this_grid();
  phase_weights(P, lds);
  for (int ph = 0; ph < 18; ++ph) {
    const int L = ph / 9, k = ph % 9;
    const int g = (k >= 4 && k <= 6) ? 1 : 0;
    Group G;
    G.tok0 = g ? NP : 0; G.B = g ? 8 : 16; G.S = g ? 8192 : 2048; G.ntok = g ? NS : NP;
    if (k == 0) phase_prep(P, L);
    else if (k == 1 || k == 4) phase_inproj(P, L, G, lds);
    else if (k == 2 || k == 5) phase_mixers(P, L, G, P.ctr + (L * 2 + g) * 16, lds, &s_item);
    else if (k == 3 || k == 6) phase_rwkv_final(P, L, G);
    else if (k == 7) phase_outproj(P, L, lds);
    else phase_gate(P, L, lds);
    grid.sync();
  }
}

extern "C" void kernel_launch(void* const* d_in, const int* in_sizes, int n_in, void* d_out, int out_size, void* d_ws,
                              size_t ws_size, hipStream_t stream) {
  Params P{};
  const float* const* in = (const float* const*)d_in;
  P.x_prompt = in[0]; P.x_sample = in[1]; P.p_prompt = in[2]; P.p_sample = in[3];
  P.norm_pre = in[4]; P.w_in = in[5]; P.w_out = in[6]; P.conv_w = in[7]; P.conv_b = in[8];
  P.w0 = in[9]; P.w_up = in[10]; P.a0 = in[11]; P.a_up = in[12]; P.k_k = in[13]; P.k_a = in[14];
  P.r_k = in[15]; P.ln_g = in[16]; P.ln_b = in[17]; P.q_norm = in[18]; P.k_norm = in[19];
  P.lam_vec = in[20]; P.subln = in[21]; P.ple_proj = in[22]; P.ple_norm = in[23];
  P.gate_w = in[24]; P.gate_b = in[25];
  P.out = (float*)d_out;
  char* ws = (char*)d_ws;
  size_t off = 0;
  auto take = [&](size_t bytes) { char* p = ws + off; off += (bytes + 255) & ~(size_t)255; return p; };
  P.ctr = (int*)take(1024);
  P.consts = (float*)take(1024);
  P.X = (bf16_t*)take((size_t)NTOK * DM * 2);
  P.PB = (bf16_t*)take((size_t)NTOK * DPLE * 2);
  P.RS = (float*)take((size_t)NTOK * 4);
  P.WIN = (bf16_t*)take((size_t)2 * NIN * DM * 2);
  P.WOUT = (bf16_t*)take((size_t)2 * DM * DM * 2);
  P.WPLE = (bf16_t*)take((size_t)2 * DM * DPLE * 2);
  P.WGATE = (bf16_t*)take((size_t)2 * DM * DM * 2);
  P.WUPT = (bf16_t*)take((size_t)4 * 512 * 64 * 2);
  P.AUPT = (bf16_t*)take((size_t)2 * 512 * 64 * 2);
  P.CR = (bf16_t*)take((size_t)GS * CRW * 2);
  P.GRW = (bf16_t*)take((size_t)GS * 512 * 2);
  P.Q = (bf16_t*)take((size_t)GS * 512 * 2);
  P.KB = (bf16_t*)take((size_t)GS * 512 * 2);
  P.VT = (bf16_t*)take((size_t)GS * 512 * 2);
  P.GDA = (bf16_t*)take((size_t)GS * 512 * 2);
  P.YB = (bf16_t*)take((size_t)GS * 512 * 2);
  P.BV = (bf16_t*)take((size_t)GS * 512 * 2);
  P.R1 = P.CR;
  P.R2 = P.GRW;
  P.EPART = (float*)P.VT;
  if (off > ws_size) { fprintf(stderr, "workspace too small: need %zu have %zu\n", off, ws_size); return; }
  hipMemsetAsync(P.ctr, 0, 1024, stream);
  static int grid_blocks = 0;
  if (!grid_blocks) {
    int dev = 0, cus = 0, per_cu = 0;
    hipGetDevice(&dev);
    hipDeviceGetAttribute(&cus, hipDeviceAttributeMultiprocessorCount, dev);
    hipOccupancyMaxActiveBlocksPerMultiprocessor(&per_cu, fwd_megakernel, NTHREADS, 0);
    if (per_cu < 1) { fprintf(stderr, "occupancy query returned %d\n", per_cu); per_cu = 1; }
    grid_blocks = cus;
  }
  void* args[] = {&P};
  hipError_t e = hipLaunchCooperativeKernel((void*)fwd_megakernel, dim3(grid_blocks), dim3(NTHREADS), args, 0, stream);
  if (e != hipSuccess) fprintf(stderr, "cooperative launch failed: %s (grid %d)\n", hipGetErrorString(e), grid_blocks);
}
```

```cpp
#include <hip/hip_runtime.h>
#include <hip/hip_cooperative_groups.h>
#include <cstdio>
namespace cg = cooperative_groups;

#define DI __device__ __forceinline__
typedef __attribute__((ext_vector_type(8))) short bf16x8;
typedef __attribute__((ext_vector_type(16))) float f32x16;
typedef __attribute__((ext_vector_type(4))) float f32x4;
typedef __attribute__((ext_vector_type(2))) float f32x2;
typedef __attribute__((ext_vector_type(4))) unsigned u32x4;
typedef __attribute__((ext_vector_type(2))) unsigned u32x2;
typedef unsigned short bf16_t;
#define MFMA(a, b, c) __builtin_amdgcn_mfma_f32_32x32x16_bf16((a), (b), (c), 0, 0, 0)

constexpr int DM = 1024;
constexpr int NP = 16 * 2048;
constexpr int NS = 8 * 8192;
constexpr int NTOK = NP + NS;
constexpr int DPLE = 256;
constexpr int IN_COLS = 4288;
constexpr int NIN = 4352;
constexpr int CRW = 1792;
constexpr int GS = NS;
constexpr float LOG2E = 1.4426950408889634f;
constexpr int NTHREADS = 512;
constexpr int LDS_BYTES = 147456;

struct Params {
  const float* x_prompt; const float* x_sample; const float* p_prompt; const float* p_sample;
  const float* norm_pre; const float* w_in; const float* w_out; const float* conv_w; const float* conv_b;
  const float* w0; const float* w_up; const float* a0; const float* a_up; const float* k_k; const float* k_a;
  const float* r_k; const float* ln_g; const float* ln_b; const float* q_norm; const float* k_norm;
  const float* lam_vec; const float* subln; const float* ple_proj; const float* ple_norm;
  const float* gate_w; const float* gate_b;
  float* out;
  bf16_t* X; bf16_t* PB; float* RS;
  bf16_t* CR; bf16_t* GRW; bf16_t* Q; bf16_t* KB; bf16_t* VT; bf16_t* GDA;
  bf16_t* R1; bf16_t* R2; float* EPART; bf16_t* YB; bf16_t* BV;
  bf16_t* WIN; bf16_t* WOUT; bf16_t* WPLE; bf16_t* WGATE; bf16_t* WUPT; bf16_t* AUPT;
  float* consts; int* ctr;
};

struct Group { int tok0, B, S, ntok; };

DI unsigned pack2(float a, float b) {
  typedef __attribute__((ext_vector_type(2))) __bf16 bf2;
  f32x2 v = {a, b};
  bf2 r = __builtin_convertvector(v, bf2);
  return __builtin_bit_cast(unsigned, r);
}
DI bf16_t f2bf(float a) { return (bf16_t)(pack2(a, 0.f) & 0xffffu); }
DI float bf2f(unsigned short u) { return __uint_as_float(((unsigned)u) << 16); }
DI float bflo(unsigned u) { return __uint_as_float(u << 16); }
DI float bfhi(unsigned u) { return __uint_as_float(u & 0xffff0000u); }
template <int CTRL> DI float dppf(float x) {
  return __int_as_float(__builtin_amdgcn_update_dpp(0, __float_as_int(x), CTRL, 0xF, 0xF, true));
}
DI float red4(float x) { x += dppf<0xB1>(x); x += dppf<0x4E>(x); return x; }
DI float red8(float x) { x = red4(x); x += dppf<0x141>(x); return x; }
DI float red32(float x) {
  x += __shfl_xor(x, 1); x += __shfl_xor(x, 2); x += __shfl_xor(x, 4); x += __shfl_xor(x, 8); x += __shfl_xor(x, 16);
  return x;
}
DI float sigmoidf_(float x) { return __builtin_amdgcn_rcpf(1.f + __expf(-x)); }
DI float siluf_(float x) { return x * __builtin_amdgcn_rcpf(1.f + __expf(-x)); }
DI float tanhf_(float x) { return 1.f - 2.f * __builtin_amdgcn_rcpf(1.f + __expf(2.f * x)); }
DI int opq(int x) { asm volatile("" : "+v"(x)); return x; }
DI int opqs(int x) { asm volatile("" : "+s"(x)); return x; }
DI int crow(int i, int h) { return (i & 3) + 8 * (i >> 2) + 4 * h; }

DI void transpose_convert(const float* __restrict__ src, int K, int N, bf16_t* __restrict__ dst, int Nd, int mode,
                          const float* __restrict__ rowscale, float* lds) {
  const int tid = opq(threadIdx.x);
  const int tk = K >> 6, tn = Nd >> 6;
  for (int t = blockIdx.x; t < tk * tn; t += gridDim.x) {
    const int k0 = (t % tk) << 6, n0 = (t / tk) << 6;
    int sn0 = n0;
    if (mode == 1) sn0 = (n0 < 1728) ? n0 : (n0 < 1792 ? -1 : n0 - 64);
    __syncthreads();
#pragma unroll
    for (int it = 0; it < 2; ++it) {
      const int kk = (tid >> 4) + 32 * it, n4 = (tid & 15) * 4;
      f32x4 v = {0.f, 0.f, 0.f, 0.f};
      if (sn0 >= 0) v = *(const f32x4*)(src + (size_t)(k0 + kk) * N + sn0 + n4);
      const float sc = rowscale ? rowscale[k0 + kk] : 1.f;
      lds[kk * 65 + n4 + 0] = v[0] * sc; lds[kk * 65 + n4 + 1] = v[1] * sc;
      lds[kk * 65 + n4 + 2] = v[2] * sc; lds[kk * 65 + n4 + 3] = v[3] * sc;
    }
    __syncthreads();
    const int nn = tid >> 3, k8 = (tid & 7) * 8;
    u32x4 o;
    o[0] = pack2(lds[(k8 + 0) * 65 + nn], lds[(k8 + 1) * 65 + nn]);
    o[1] = pack2(lds[(k8 + 2) * 65 + nn], lds[(k8 + 3) * 65 + nn]);
    o[2] = pack2(lds[(k8 + 4) * 65 + nn], lds[(k8 + 5) * 65 + nn]);
    o[3] = pack2(lds[(k8 + 6) * 65 + nn], lds[(k8 + 7) * 65 + nn]);
    *(u32x4*)(dst + (size_t)(n0 + nn) * K + k0 + k8) = o;
  }
}

DI void phase_weights(const Params& P, char* lds) {
  float* l = (float*)lds;
  for (int L = 0; L < 2; ++L) {
    transpose_convert(P.w_in + (size_t)L * DM * IN_COLS, DM, IN_COLS, P.WIN + (size_t)L * NIN * DM, NIN, 1, P.norm_pre + L * DM, l);
    transpose_convert(P.w_out + (size_t)L * DM * DM, DM, DM, P.WOUT + (size_t)L * DM * DM, DM, 0, nullptr, l);
    transpose_convert(P.ple_proj + (size_t)L * DPLE * DM, DPLE, DM, P.WPLE + (size_t)L * DM * DPLE, DM, 0, nullptr, l);
    transpose_convert(P.gate_w + (size_t)L * DM * DM, DM, DM, P.WGATE + (size_t)L * DM * DM, DM, 0, nullptr, l);
    for (int d = 0; d < 2; ++d)
      transpose_convert(P.w_up + (size_t)(L * 2 + d) * 64 * 512, 64, 512, P.WUPT + (size_t)(L * 2 + d) * 512 * 64, 512, 0, nullptr, l);
    transpose_convert(P.a_up + (size_t)L * 64 * 512, 64, 512, P.AUPT + (size_t)L * 512 * 64, 512, 0, nullptr, l);
  }
  if (blockIdx.x == 0 && threadIdx.x < 128) {
    const int L = threadIdx.x >> 6, lane = threadIdx.x & 63;
    const float* lv = P.lam_vec + L * 256;
    float s01 = lv[lane] * lv[64 + lane], s23 = lv[128 + lane] * lv[192 + lane];
    float mq = fmaxf(fabsf(P.q_norm[L * 128 + lane]), fabsf(P.q_norm[L * 128 + 64 + lane]));
    float mk = fmaxf(fabsf(P.k_norm[L * 128 + lane]), fabsf(P.k_norm[L * 128 + 64 + lane]));
    for (int o = 32; o >= 1; o >>= 1) {
      s01 += __shfl_xor(s01, o); s23 += __shfl_xor(s23, o);
      mq = fmaxf(mq, __shfl_xor(mq, o)); mk = fmaxf(mk, __shfl_xor(mk, o));
    }
    if (lane == 0) {
      const float lam_init = 0.8f - 0.6f * expf(-0.3f * (float)L);
      P.consts[L * 4 + 0] = expf(s01) - expf(s23) + lam_init;
      P.consts[L * 4 + 1] = 8.25f * mq * mk * LOG2E;
      P.consts[L * 4 + 2] = lam_init;
    }
  }
}

DI void phase_prep(const Params& P, int L) {
  const float* h0 = L == 0 ? P.x_prompt : P.out;
  const float* h1 = L == 0 ? P.x_sample : P.out + (size_t)NP * DM;
  const float* p0 = P.p_prompt + (size_t)L * NP * DPLE;
  const float* p1 = P.p_sample + (size_t)L * NS * DPLE;
  const int tidp = opq(threadIdx.x);
  const int lane = tidp & 63;
  const int gw = blockIdx.x * (NTHREADS / 64) + (tidp >> 6), nw = gridDim.x * (NTHREADS / 64);
  for (int tok = gw; tok < NTOK; tok += nw) {
    const float* hr = tok < NP ? h0 + (size_t)tok * DM : h1 + (size_t)(tok - NP) * DM;
    float ss = 0.f;
#pragma unroll
    for (int i = 0; i < 4; ++i) {
      f32x4 v = *(const f32x4*)(hr + i * 256 + lane * 4);
      ss += v[0] * v[0] + v[1] * v[1] + v[2] * v[2] + v[3] * v[3];
      u32x2 o = {pack2(v[0], v[1]), pack2(v[2], v[3])};
      *(u32x2*)(P.X + (size_t)tok * DM + i * 256 + lane * 4) = o;
    }
    for (int o = 32; o >= 1; o >>= 1) ss += __shfl_xor(ss, o);
    if (lane == 0) P.RS[tok] = rsqrtf(ss * (1.f / DM) + 1e-6f);
    const float* pr = tok < NP ? p0 + (size_t)tok * DPLE : p1 + (size_t)(tok - NP) * DPLE;
    f32x4 v = *(const f32x4*)(pr + lane * 4);
    u32x2 o = {pack2(v[0], v[1]), pack2(v[2], v[3])};
    *(u32x2*)(P.PB + (size_t)tok * DPLE + lane * 4) = o;
  }
}

constexpr int GSTR = 144;
constexpr int GA_BYTES = 256 * GSTR;
constexpr int GSTAGE = 2 * GA_BYTES;

DI void gemm_mainloop(const bf16_t* __restrict__ A, int lda, const bf16_t* __restrict__ Bw, int ldb, int K,
                      int m0, int n0, char* lds, f32x16 (&acc)[2][4]) {
  const int tid = opq(threadIdx.x), lane = tid & 63, w = tid >> 6, hh = lane >> 5, r = lane & 31;
  const int wm = w >> 1, wn = w & 1;
#pragma unroll
  for (int mi = 0; mi < 2; ++mi)
#pragma unroll
    for (int ni = 0; ni < 4; ++ni)
#pragma unroll
      for (int i = 0; i < 16; ++i) acc[mi][ni][i] = 0.f;
  const int lrow = tid >> 3, lkc = tid & 7;
  const bf16_t* ap = A + (size_t)(m0 + lrow) * lda + lkc * 8;
  const bf16_t* bp = Bw + (size_t)(n0 + lrow) * ldb + lkc * 8;
  const int nk = K >> 6;
  u32x4 ra[4], rb[4];
#pragma unroll
  for (int i = 0; i < 4; ++i) {
    ra[i] = *(const u32x4*)(ap + (size_t)(64 * i) * lda);
    rb[i] = *(const u32x4*)(bp + (size_t)(64 * i) * ldb);
  }
  __syncthreads();
#pragma unroll
  for (int i = 0; i < 4; ++i) {
    *(u32x4*)(lds + (lrow + 64 * i) * GSTR + lkc * 16) = ra[i];
    *(u32x4*)(lds + GA_BYTES + (lrow + 64 * i) * GSTR + lkc * 16) = rb[i];
  }
  __syncthreads();
  for (int kt = 0; kt < nk; ++kt) {
    const bool more = kt + 1 < nk;
    if (more) {
#pragma unroll
      for (int i = 0; i < 4; ++i) {
        ra[i] = *(const u32x4*)(ap + (size_t)(64 * i) * lda + (kt + 1) * 64);
        rb[i] = *(const u32x4*)(bp + (size_t)(64 * i) * ldb + (kt + 1) * 64);
      }
    }
    const char* sa = lds + (kt & 1) * GSTAGE + (wm * 64 + r) * GSTR + hh * 16;
    const char* sb = lds + (kt & 1) * GSTAGE + GA_BYTES + (wn * 128 + r) * GSTR + hh * 16;
#pragma unroll
    for (int ks = 0; ks < 4; ++ks) {
      bf16x8 fa[2], fb[4];
#pragma unroll
      for (int mi = 0; mi < 2; ++mi) fa[mi] = *(const bf16x8*)(sa + mi * 32 * GSTR + ks * 32);
#pragma unroll
      for (int ni = 0; ni < 4; ++ni) fb[ni] = *(const bf16x8*)(sb + ni * 32 * GSTR + ks * 32);
#pragma unroll
      for (int mi = 0; mi < 2; ++mi)
#pragma unroll
        for (int ni = 0; ni < 4; ++ni) acc[mi][ni] = MFMA(fb[ni], fa[mi], acc[mi][ni]);
    }
    if (more) {
      char* d = lds + ((kt + 1) & 1) * GSTAGE;
#pragma unroll
      for (int i = 0; i < 4; ++i) {
        *(u32x4*)(d + (lrow + 64 * i) * GSTR + lkc * 16) = ra[i];
        *(u32x4*)(d + GA_BYTES + (lrow + 64 * i) * GSTR + lkc * 16) = rb[i];
      }
    }
    __syncthreads();
  }
}

DI void phase_inproj(const Params& P, int L, const Group& G, char* lds) {
  const int tid = opq(threadIdx.x), lane = tid & 63, w = tid >> 6, hh = lane >> 5, r = lane & 31;
  const int wm = w >> 1, wn = w & 1;
  const int nmt = G.ntok >> 8, ntile = nmt * 17;
  const bf16_t* A = P.X + (size_t)G.tok0 * DM;
  const bf16_t* Bw = P.WIN + (size_t)L * NIN * DM;
  for (int t = blockIdx.x; t < ntile; t += gridDim.x) {
    const int mt = t / 17, nt = t % 17;
    const int m0 = mt << 8, n0 = nt << 8;
    f32x16 acc[2][4];
    gemm_mainloop(A, DM, Bw, DM, DM, m0, n0, lds, acc);
    const int colw = n0 + wn * 128 + 4 * hh;
    if (nt < 7) {
#pragma unroll
      for (int mi = 0; mi < 2; ++mi) {
        const int row = m0 + wm * 64 + mi * 32 + r;
        const float rsv = P.RS[G.tok0 + row];
        bf16_t* dst = P.CR + (size_t)row * CRW + colw;
#pragma unroll
        for (int ni = 0; ni < 4; ++ni)
#pragma unroll
          for (int q4 = 0; q4 < 4; ++q4) {
            u32x2 o = {pack2(acc[mi][ni][4 * q4] * rsv, acc[mi][ni][4 * q4 + 1] * rsv),
                       pack2(acc[mi][ni][4 * q4 + 2] * rsv, acc[mi][ni][4 * q4 + 3] * rsv)};
            *(u32x2*)(dst + ni * 32 + q4 * 8) = o;
          }
      }
    } else if (nt < 9 || nt >= 15) {
      bf16_t* dbase = nt < 9 ? P.GRW : P.GDA;
      const int c0 = colw - (nt < 9 ? 1792 : 3840);
#pragma unroll
      for (int mi = 0; mi < 2; ++mi) {
        const int row = m0 + wm * 64 + mi * 32 + r;
        const float rsv = P.RS[G.tok0 + row];
        bf16_t* dst = dbase + (size_t)row * 512 + c0;
#pragma unroll
        for (int ni = 0; ni < 4; ++ni)
#pragma unroll
          for (int q4 = 0; q4 < 4; ++q4) {
            u32x2 o = {pack2(siluf_(acc[mi][ni][4 * q4] * rsv), siluf_(acc[mi][ni][4 * q4 + 1] * rsv)),
                       pack2(siluf_(acc[mi][ni][4 * q4 + 2] * rsv), siluf_(acc[mi][ni][4 * q4 + 3] * rsv))};
            *(u32x2*)(dst + ni * 32 + q4 * 8) = o;
          }
      }
    } else if (nt < 13) {
      const bool isq = nt < 11;
      bf16_t* dbase = isq ? P.Q : P.KB;
      const int c0 = colw - (isq ? 2304 : 2816);
      const float* g = (isq ? P.q_norm : P.k_norm) + L * 128 + 4 * hh;
      const float osc = isq ? 0.125f * LOG2E : 1.f;
#pragma unroll
      for (int mi = 0; mi < 2; ++mi) {
        const int row = m0 + wm * 64 + mi * 32 + r;
        const float rsv = P.RS[G.tok0 + row];
        bf16_t* dst = dbase + (size_t)row * 512 + c0;
#pragma unroll
        for (int gi = 0; gi < 2; ++gi) {
          float ss = 0.f;
#pragma unroll
          for (int t2 = 0; t2 < 2; ++t2)
#pragma unroll
            for (int i = 0; i < 16; ++i) { const float v = acc[mi][2 * gi + t2][i] * rsv; ss += v * v; }
          ss += __shfl_xor(ss, 32);
          const float sc = rsqrtf(ss * (1.f / 64.f) + 1e-6f) * rsv * osc;
#pragma unroll
          for (int t2 = 0; t2 < 2; ++t2)
#pragma unroll
            for (int q4 = 0; q4 < 4; ++q4) {
              const f32x4 gv = *(const f32x4*)(g + gi * 64 + t2 * 32 + q4 * 8);
              u32x2 o = {pack2(acc[mi][2 * gi + t2][4 * q4] * sc * gv[0], acc[mi][2 * gi + t2][4 * q4 + 1] * sc * gv[1]),
                         pack2(acc[mi][2 * gi + t2][4 * q4 + 2] * sc * gv[2], acc[mi][2 * gi + t2][4 * q4 + 3] * sc * gv[3])};
              *(u32x2*)(dst + (2 * gi + t2) * 32 + q4 * 8) = o;
            }
        }
      }
    } else {
      const int hd = (n0 + wn * 128 - 3328) >> 7;
      const int row0 = m0 + wm * 64;
      const int b = row0 / G.S, s0 = row0 % G.S;
#pragma unroll
      for (int mi = 0; mi < 2; ++mi) {
        const int s = s0 + mi * 32 + r;
        const float rsv = P.RS[G.tok0 + b * G.S + s];
        bf16_t* dst = P.VT + ((size_t)((b * 4 + hd) * 128 + 4 * hh)) * G.S + s;
        const size_t Sz = (size_t)G.S;
#pragma unroll
        for (int ni = 0; ni < 4; ++ni)
#pragma unroll
          for (int q4 = 0; q4 < 4; ++q4) {
            bf16_t* pq = dst + (size_t)(ni * 32 + 8 * q4) * Sz;
            pq[0] = f2bf(acc[mi][ni][4 * q4] * rsv);
            pq[Sz] = f2bf(acc[mi][ni][4 * q4 + 1] * rsv);
            pq[2 * Sz] = f2bf(acc[mi][ni][4 * q4 + 2] * rsv);
            pq[3 * Sz] = f2bf(acc[mi][ni][4 * q4 + 3] * rsv);
            __builtin_amdgcn_sched_barrier(0);
          }
      }
    }
  }
}

DI void phase_outproj(const Params& P, int L, char* lds) {
  const int tid = opq(threadIdx.x), lane = tid & 63, w = tid >> 6, hh = lane >> 5, r = lane & 31;
  const int wm = w >> 1, wn = w & 1;
  const float* h0 = L == 0 ? P.x_prompt : P.out;
  const float* h1 = L == 0 ? P.x_sample : P.out + (size_t)NP * DM;
  const int nmt = NTOK >> 8, ntile = nmt * 4;
  for (int t = blockIdx.x; t < 2 * ntile; t += gridDim.x) {
    const bool isE = t >= ntile;
    const int tt = isE ? t - ntile : t;
    const int mt = tt >> 2, nt = tt & 3;
    const int m0 = mt << 8, n0 = nt << 8;
    const int colw = n0 + wn * 128 + 4 * hh;
    f32x16 acc[2][4];
    if (!isE) {
      gemm_mainloop(P.X, DM, P.WOUT + (size_t)L * DM * DM, DM, DM, m0, n0, lds, acc);
#pragma unroll
      for (int mi = 0; mi < 2; ++mi) {
        const int row = m0 + wm * 64 + mi * 32 + r;
        const float* hr = (row < NP ? h0 + (size_t)row * DM : h1 + (size_t)(row - NP) * DM) + colw;
        float* op = P.out + (size_t)row * DM + colw;
        bf16_t* rp = P.R1 + (size_t)row * DM + colw;
#pragma unroll
        for (int ni = 0; ni < 4; ++ni)
#pragma unroll
          for (int q4 = 0; q4 < 4; ++q4) {
            f32x4 hv = *(const f32x4*)(hr + ni * 32 + q4 * 8);
            hv[0] += acc[mi][ni][4 * q4]; hv[1] += acc[mi][ni][4 * q4 + 1];
            hv[2] += acc[mi][ni][4 * q4 + 2]; hv[3] += acc[mi][ni][4 * q4 + 3];
            *(f32x4*)(op + ni * 32 + q4 * 8) = hv;
            u32x2 o = {pack2(hv[0], hv[1]), pack2(hv[2], hv[3])};
            *(u32x2*)(rp + ni * 32 + q4 * 8) = o;
          }
      }
    } else {
      gemm_mainloop(P.PB, DPLE, P.WPLE + (size_t)L * DM * DPLE, DPLE, DPLE, m0, n0, lds, acc);
#pragma unroll
      for (int mi = 0; mi < 2; ++mi) {
        const int row = m0 + wm * 64 + mi * 32 + r;
        bf16_t* rp = P.R2 + (size_t)row * DM + colw;
        float ss = 0.f;
#pragma unroll
        for (int ni = 0; ni < 4; ++ni)
#pragma unroll
          for (int q4 = 0; q4 < 4; ++q4) {
            const float v0 = acc[mi][ni][4 * q4], v1 = acc[mi][ni][4 * q4 + 1], v2 = acc[mi][ni][4 * q4 + 2], v3 = acc[mi][ni][4 * q4 + 3];
            ss += v0 * v0 + v1 * v1 + v2 * v2 + v3 * v3;
            u32x2 o = {pack2(v0, v1), pack2(v2, v3)};
            *(u32x2*)(rp + ni * 32 + q4 * 8) = o;
          }
        ss += __shfl_xor(ss, 32);
        if (hh == 0) P.EPART[(size_t)(nt * 2 + wn) * NTOK + row] = ss;
      }
    }
  }
}

DI void phase_gate(const Params& P, int L, char* lds) {
  const int tid = opq(threadIdx.x), lane = tid & 63, w = tid >> 6, hh = lane >> 5, r = lane & 31;
  const int wm = w >> 1, wn = w & 1;
  const int nmt = NTOK >> 8, ntile = nmt * 4;
  for (int t = blockIdx.x; t < ntile; t += gridDim.x) {
    const int mt = t >> 2, nt = t & 3;
    const int m0 = mt << 8, n0 = nt << 8;
    const int colw = n0 + wn * 128 + 4 * hh;
    f32x16 acc[2][4];
    gemm_mainloop(P.R1, DM, P.WGATE + (size_t)L * DM * DM, DM, DM, m0, n0, lds, acc);
    const float* gbp = P.gate_b + L * DM + colw;
    const float* pnp = P.ple_norm + L * DM + colw;
#pragma unroll
    for (int mi = 0; mi < 2; ++mi) {
      const int row = m0 + wm * 64 + mi * 32 + r;
      float es = 0.f;
#pragma unroll
      for (int j = 0; j < 8; ++j) es += P.EPART[(size_t)j * NTOK + row];
      const float rse = rsqrtf(es * (1.f / DM) + 1e-6f);
      float* op = P.out + (size_t)row * DM + colw;
      const bf16_t* ep = P.R2 + (size_t)row * DM + colw;
#pragma unroll
      for (int ni = 0; ni < 4; ++ni)
#pragma unroll
        for (int q4 = 0; q4 < 4; ++q4) {
          const int co = ni * 32 + q4 * 8;
          const f32x4 gb = *(const f32x4*)(gbp + co), pn = *(const f32x4*)(pnp + co);
          const u32x2 ev = *(const u32x2*)(ep + co);
          f32x4 hv = *(const f32x4*)(op + co);
          hv[0] += sigmoidf_(acc[mi][ni][4 * q4] + gb[0]) * (bflo(ev[0]) * rse * pn[0]);
          hv[1] += sigmoidf_(acc[mi][ni][4 * q4 + 1] + gb[1]) * (bfhi(ev[0]) * rse * pn[1]);
          hv[2] += sigmoidf_(acc[mi][ni][4 * q4 + 2] + gb[2]) * (bflo(ev[1]) * rse * pn[2]);
          hv[3] += sigmoidf_(acc[mi][ni][4 * q4 + 3] + gb[3]) * (bfhi(ev[1]) * rse * pn[3]);
          *(f32x4*)(op + co) = hv;
        }
    }
  }
}

constexpr int TC = 32;
constexpr int SC_OP = TC * 64 * 4;
constexpr int SC_BUF = 7 * SC_OP + 2 * TC * 144 + 128;

template <int N> DI void red64v(float (&x)[N]) {
#pragma unroll
  for (int i = 0; i < N; ++i) x[i] += dppf<0xB1>(x[i]);
#pragma unroll
  for (int i = 0; i < N; ++i) x[i] += dppf<0x4E>(x[i]);
#pragma unroll
  for (int i = 0; i < N; ++i) x[i] += dppf<0x141>(x[i]);
#pragma unroll
  for (int i = 0; i < N; ++i) x[i] += dppf<0x140>(x[i]);
#pragma unroll
  for (int i = 0; i < N; ++i) x[i] += __shfl_xor(x[i], 16);
#pragma unroll
  for (int i = 0; i < N; ++i) x[i] += __shfl_xor(x[i], 32);
}

struct ScanOps { f32x4 w0, w1, a0, a1, b0, b1, k0, k1, r0, r1; float v; };

DI ScanOps scan_load(const float* __restrict__ ob, int s, int coff, int row) {
  ScanOps o;
  const float* p = ob + s * 64 + coff;
  o.w0 = *(const f32x4*)(p);                 o.w1 = *(const f32x4*)(p + 4);
  o.a0 = *(const f32x4*)(p + TC * 64);       o.a1 = *(const f32x4*)(p + TC * 64 + 4);
  o.b0 = *(const f32x4*)(p + 2 * TC * 64);   o.b1 = *(const f32x4*)(p + 2 * TC * 64 + 4);
  o.k0 = *(const f32x4*)(p + 3 * TC * 64);   o.k1 = *(const f32x4*)(p + 3 * TC * 64 + 4);
  o.r0 = *(const f32x4*)(p + 4 * TC * 64);   o.r1 = *(const f32x4*)(p + 4 * TC * 64 + 4);
  o.v = ob[5 * TC * 64 + s * 64 + row];
  return o;
}

DI f32x2 lo2(f32x4 x) { return f32x2{x[0], x[1]}; }
DI f32x2 hi2(f32x4 x) { return f32x2{x[2], x[3]}; }

DI float scan_step(f32x2 (&st)[4], const ScanOps& o) {
  const f32x2 a[4] = {lo2(o.a0), hi2(o.a0), lo2(o.a1), hi2(o.a1)};
  const f32x2 wv[4] = {lo2(o.w0), hi2(o.w0), lo2(o.w1), hi2(o.w1)};
  const f32x2 bv[4] = {lo2(o.b0), hi2(o.b0), lo2(o.b1), hi2(o.b1)};
  const f32x2 kv[4] = {lo2(o.k0), hi2(o.k0), lo2(o.k1), hi2(o.k1)};
  const f32x2 rv[4] = {lo2(o.r0), hi2(o.r0), lo2(o.r1), hi2(o.r1)};
  f32x2 p = st[0] * a[0];
  p = st[1] * a[1] + p; p = st[2] * a[2] + p; p = st[3] * a[3] + p;
  const float sa = red8(p[0] + p[1]);
  const f32x2 sa2 = {sa, sa};
  const f32x2 v2 = {o.v, o.v};
  f32x2 q = {0.f, 0.f};
#pragma unroll
  for (int j = 0; j < 4; ++j) {
    f32x2 x = st[j] * wv[j];
    x = sa2 * bv[j] + x;
    x = v2 * kv[j] + x;
    st[j] = x;
    q = x * rv[j] + q;
  }
  return red8(q[0] + q[1]);
}

DI void scan_task(const Params& P, int L_, const Group& G, int task, char* lds) {
  const int L = opqs(__builtin_amdgcn_readfirstlane(L_));
  const int tid = opq(threadIdx.x), lane = tid & 63, w = tid >> 6;
  const int dir = task & 1, b = task >> 4, hd = (task >> 1) & 7;
  const int S = G.S, nc = S / TC;
  const int sg = dir ? -1 : 1;
  const int etg = tid >> 6, ec = tid & 63;
  const int srow = w * 8 + (lane >> 3), scs = lane & 7;
  const int mmat = (w >> 1) & 1, mnb = w & 1, hh = lane >> 5, r = lane & 31;

  const float* cw = P.conv_w + (size_t)L * 3 * 1728;
  const float* cb = P.conv_b + (size_t)L * 1728;
  const int cq[5] = {hd * 64 + ec, 512 + hd * 64 + ec, 1024 + hd * 64 + ec, 1536 + dir * 64 + ec, 1664 + ec};
  const int ch = hd * 64 + ec;
  const float c_kk = P.k_k[L * 512 + ch], c_ka = P.k_a[L * 512 + ch], c_rk = P.r_k[L * 512 + ch];
  const bf16_t* wsrc = (mmat ? P.AUPT + (size_t)L * 512 * 64 : P.WUPT + (size_t)(L * 2 + dir) * 512 * 64) +
                       (size_t)(hd * 64 + mnb * 32 + r) * 64 + hh * 8;
  const float c_lora0 = mmat ? P.a0[(size_t)L * 512 + hd * 64 + mnb * 32 + r]
                             : P.w0[(size_t)(L * 2 + dir) * 512 + hd * 64 + mnb * 32 + r];
  const bf16_t* crb = P.CR + (size_t)b * S * CRW;

  f32x2 st[4];
#pragma unroll
  for (int j = 0; j < 4; ++j) st[j] = f32x2{0.f, 0.f};

  u32x4 rv[3];
  auto stage_load = [&](int cc) {
    const int tlo = (dir ? S - (cc + 1) * TC : cc * TC) - 1;
    const int t = opq(tid);
#pragma unroll
    for (int it = 0; it < 3; ++it) {
      int id = t + it * 512;
      id = id < 34 * 40 ? id : 34 * 40 - 1;
      const int rr = id / 40, cc8 = id % 40, q = cc8 >> 3, c8 = (cc8 & 7) * 8;
      const int tok = tlo + rr;
      const bool ok = tok >= 0 && tok < S;
      const int tokc = tok < 0 ? 0 : (tok >= S ? S - 1 : tok);
      const int col = (q == 0 ? hd * 64 : q == 1 ? 512 + hd * 64 : q == 2 ? 1024 + hd * 64 : q == 3 ? 1536 + dir * 64 : 1664) + c8;
      const u32x4 v = *(const u32x4*)(crb + (size_t)tokc * CRW + col);
      const u32x4 z = {0u, 0u, 0u, 0u};
      rv[it] = ok ? v : z;
    }
  };
  auto stage_store = [&](char* dst) {
    const int t = opq(tid);
#pragma unroll
    for (int it = 0; it < 3; ++it) {
      int id = t + it * 512;
      id = id < 34 * 40 ? id : 34 * 40 - 1;
      *(u32x4*)(dst + (id / 40) * 640 + (id % 40) * 16) = rv[it];
    }
  };
  __syncthreads();
  stage_load(0);
  stage_store(lds);

  for (int c = 0; c < nc; ++c) {
    char* eb = lds + (c & 1) * SC_BUF;
    float* eA = (float*)(eb + SC_OP); float* eB = (float*)(eb + 2 * SC_OP);
    float* eK = (float*)(eb + 3 * SC_OP); float* eR = (float*)(eb + 4 * SC_OP); float* eV = (float*)(eb + 5 * SC_OP);
    float* eY = (float*)(eb + 6 * SC_OP);
    bf16_t* eZT = (bf16_t*)(eb + 7 * SC_OP); bf16_t* eZA = (bf16_t*)(eb + 7 * SC_OP + TC * 144);
    float* eBon = (float*)(eb + 7 * SC_OP + 2 * TC * 144);
    float cwp[5], cwc[5], cwn[5], cbb[5];
    {
      const int eco = opq(ec);
#pragma unroll
      for (int q = 0; q < 5; ++q) {
        const int cqq = cq[q] - ec + eco;
        const float w0 = cw[cqq], w1 = cw[1728 + cqq], w2 = cw[2 * 1728 + cqq];
        cwp[q] = dir ? w2 : w0; cwc[q] = w1; cwn[q] = dir ? w0 : w2; cbb[q] = cb[cqq];
      }
    }
    __syncthreads();
    float kreg[4];
    {
      const bf16_t* raw = (const bf16_t*)eb;
      const int rr0 = dir ? TC - etg * 4 : etg * 4 + 1;
      float xr[6][5];
#pragma unroll
      for (int j = 0; j < 6; ++j)
#pragma unroll
        for (int q = 0; q < 5; ++q) xr[j][q] = bf2f(raw[(rr0 + sg * (j - 1)) * 320 + q * 64 + ec]);
#pragma unroll
      for (int i = 0; i < 4; ++i) {
        float v[5];
#pragma unroll
        for (int q = 0; q < 5; ++q) v[q] = cbb[q] + cwp[q] * xr[i][q] + cwc[q] * xr[i + 1][q] + cwn[q] * xr[i + 2][q];
        const int s = etg * 4 + i;
        eR[s * 64 + ec] = v[0];
        kreg[i] = v[1];
        eV[s * 64 + ec] = v[2];
        eZT[s * 72 + ec] = f2bf(tanhf_(v[3]));
        eZA[s * 72 + ec] = f2bf(v[4]);
      }
    }
    if (c + 1 < nc) stage_load(c + 1);
    bf16x8 lfb[4];
    if (w < 4) {
#pragma unroll
      for (int ks = 0; ks < 4; ++ks) lfb[ks] = *(const bf16x8*)(wsrc + ks * 16);
    }
    __syncthreads();
    if (w < 4) {
      f32x16 acc;
#pragma unroll
      for (int i = 0; i < 16; ++i) acc[i] = 0.f;
      const char* asrc = eb + 7 * SC_OP + (mmat ? TC * 144 : 0) + r * 144 + hh * 16;
#pragma unroll
      for (int ks = 0; ks < 4; ++ks) {
        const bf16x8 fa = *(const bf16x8*)(asrc + ks * 32);
        acc = MFMA(fa, lfb[ks], acc);
      }
      if (mmat == 0) {
        float* dW = (float*)(eb);
#pragma unroll
        for (int i = 0; i < 16; ++i)
          dW[crow(i, hh) * 64 + mnb * 32 + r] = __expf(-0.6065306597126334f * sigmoidf_(c_lora0 + acc[i]));
      } else {
#pragma unroll
        for (int i = 0; i < 16; ++i) eA[crow(i, hh) * 64 + mnb * 32 + r] = sigmoidf_(c_lora0 + acc[i]);
      }
    }
    __syncthreads();
    {
      float ag[4], kk[4], ss[4], km[4], bn[4];
#pragma unroll
      for (int i = 0; i < 4; ++i) {
        const int s = etg * 4 + i;
        ag[i] = eA[s * 64 + ec];
        kk[i] = kreg[i] * c_kk;
        ss[i] = kk[i] * kk[i];
        km[i] = kreg[i] * (1.f + (ag[i] - 1.f) * c_ka);
        bn[i] = eR[s * 64 + ec] * km[i] * c_rk;
      }
      red64v<4>(ss);
      red64v<4>(bn);
#pragma unroll
      for (int i = 0; i < 4; ++i) {
        const int s = etg * 4 + i;
        const float kn = kk[i] * rsqrtf(ss[i] + 1e-12f);
        eK[s * 64 + ec] = km[i];
        eA[s * 64 + ec] = -kn;
        eB[s * 64 + ec] = kn * ag[i];
        if (ec == 0) eBon[s] = bn[i];
      }
    }
    __syncthreads();
    {
      const float* sb = (const float*)eb;
      ScanOps cur = scan_load(sb, 0, scs * 8, srow);
#pragma unroll 1
      for (int s8 = 0; s8 < TC; s8 += 8) {
        float ykeep = 0.f;
#pragma unroll
        for (int u = 0; u < 8; ++u) {
          const int s = s8 + u;
          const ScanOps nxt = scan_load(sb, s + 1 < TC ? s + 1 : s, scs * 8, srow);
          const float y = scan_step(st, cur);
          if (u == scs) ykeep = y;
          cur = nxt;
        }
        eY[(s8 + scs) * 64 + srow] = ykeep;
      }
    }
    if (c + 1 < nc) stage_store(lds + ((c + 1) & 1) * SC_BUF);
    __syncthreads();
    {
      const int t0 = dir ? S - 1 - (c * TC + etg * 4) : c * TC + etg * 4;
#pragma unroll
      for (int i = 0; i < 4; ++i) {
        const int s = etg * 4 + i;
        const size_t lt = (size_t)b * S + t0 + sg * i;
        const float y = eY[s * 64 + ec];
        if (dir == 0) {
          P.X[((size_t)G.tok0 + lt) * DM + ch] = f2bf(y);
          P.BV[lt * 512 + ch] = f2bf(eBon[s] * eV[s * 64 + ec]);
        } else {
          P.YB[lt * 512 + ch] = f2bf(y);
        }
      }
    }
  }
}

DI void phase_rwkv_final(const Params& P, int L, const Group& G) {
  const int tidp = opq(threadIdx.x);
  const int lane = tidp & 63;
  const int gw = blockIdx.x * (NTHREADS / 64) + (tidp >> 6), nw = gridDim.x * (NTHREADS / 64);
  const f32x4 g0 = *(const f32x4*)(P.ln_g + L * 512 + lane * 8), g1 = *(const f32x4*)(P.ln_g + L * 512 + lane * 8 + 4);
  const f32x4 b0 = *(const f32x4*)(P.ln_b + L * 512 + lane * 8), b1 = *(const f32x4*)(P.ln_b + L * 512 + lane * 8 + 4);
  const float lg[8] = {g0[0], g0[1], g0[2], g0[3], g1[0], g1[1], g1[2], g1[3]};
  const float lb[8] = {b0[0], b0[1], b0[2], b0[3], b1[0], b1[1], b1[2], b1[3]};
  for (int lt = gw; lt < G.ntok; lt += nw) {
    bf16_t* xp = P.X + ((size_t)G.tok0 + lt) * DM + lane * 8;
    const u32x4 yf = *(const u32x4*)xp;
    const u32x4 yb = *(const u32x4*)(P.YB + (size_t)lt * 512 + lane * 8);
    const u32x4 bv = *(const u32x4*)(P.BV + (size_t)lt * 512 + lane * 8);
    const u32x4 gt = *(const u32x4*)(P.GRW + (size_t)lt * 512 + lane * 8);
    float y[8];
    float sum = 0.f;
#pragma unroll
    for (int j = 0; j < 4; ++j) {
      y[2 * j] = bflo(yf[j]) + bflo(yb[j]); y[2 * j + 1] = bfhi(yf[j]) + bfhi(yb[j]);
      sum += y[2 * j] + y[2 * j + 1];
    }
    const float mu = red8(sum) * (1.f / 64.f);
    float vs = 0.f;
#pragma unroll
    for (int j = 0; j < 8; ++j) { y[j] -= mu; vs += y[j] * y[j]; }
    const float rstd = rsqrtf(red8(vs) * (1.f / 64.f) + 64e-5f);
    u32x4 o;
#pragma unroll
    for (int j = 0; j < 4; ++j) {
      const float o0 = (y[2 * j] * rstd * lg[2 * j] + lb[2 * j] + bflo(bv[j])) * bflo(gt[j]);
      const float o1 = (y[2 * j + 1] * rstd * lg[2 * j + 1] + lb[2 * j + 1] + bfhi(bv[j])) * bfhi(gt[j]);
      o[j] = pack2(o0, o1);
    }
    *(u32x4*)xp = o;
  }
}

constexpr int AT_K = 64 * GSTR;
constexpr int AT_STAGE = 2 * AT_K + 128 * GSTR;

DI void attn_item(const Params& P, int L_, const Group& G, int item, char* lds) {
  const int L = opqs(__builtin_amdgcn_readfirstlane(L_));
  const int tid = opq(threadIdx.x), lane = tid & 63, w = tid >> 6, hh = lane >> 5, r = lane & 31;
  const int S = G.S, nqb = S >> 7;
  const int qblk = item % nqb, bh = item / nqb, hd = bh & 3, b = bh >> 2;
  const int map = w & 1, qb = w >> 1;
  const int q0 = qblk * 128 + qb * 32;
  const size_t ltq = (size_t)b * S + q0 + r;
  bf16x8 qf[4];
  {
    const bf16_t* qp = P.Q + ltq * 512 + hd * 128 + map * 64 + hh * 8;
#pragma unroll
    for (int ks = 0; ks < 4; ++ks) qf[ks] = *(const bf16x8*)(qp + ks * 16);
  }
  f32x16 o[4];
#pragma unroll
  for (int d = 0; d < 4; ++d)
#pragma unroll
    for (int i = 0; i < 16; ++i) o[d][i] = 0.f;
  float lsum = 0.f;
  const float slope2 = exp2f(-2.f * (float)(hd + 1)) * LOG2E;
  const float lam = P.consts[L * 4 + 0], C2 = P.consts[L * 4 + 1], lam_init = P.consts[L * 4 + 2];
  const float qposf = (float)(q0 + r);
  const int nt = S >> 6;
  const int lrow = tid >> 3, lck = tid & 7;
  const bf16_t* k0p = P.KB + ((size_t)b * S + lrow) * 512 + hd * 128 + lck * 8;
  const bf16_t* v0p = P.VT + ((size_t)((b * 4 + hd) * 128 + lrow)) * S + lck * 8;
  u32x4 rk0, rk1, rv0, rv1;
  rk0 = *(const u32x4*)(k0p); rk1 = *(const u32x4*)(k0p + 64);
  rv0 = *(const u32x4*)(v0p); rv1 = *(const u32x4*)(v0p + (size_t)64 * S);
  __syncthreads();
  *(u32x4*)(lds + lrow * GSTR + lck * 16) = rk0;
  *(u32x4*)(lds + AT_K + lrow * GSTR + lck * 16) = rk1;
  *(u32x4*)(lds + 2 * AT_K + lrow * GSTR + lck * 16) = rv0;
  *(u32x4*)(lds + 2 * AT_K + (lrow + 64) * GSTR + lck * 16) = rv1;
  __syncthreads();
  const int krow = (r & ~12) | ((r & 4) << 1) | ((r & 8) >> 1);
  for (int t = 0; t < nt; ++t) {
    const bool more = t + 1 < nt;
    if (more) {
      rk0 = *(const u32x4*)(k0p + (size_t)(t + 1) * 64 * 512); rk1 = *(const u32x4*)(k0p + (size_t)(t + 1) * 64 * 512 + 64);
      rv0 = *(const u32x4*)(v0p + (t + 1) * 64); rv1 = *(const u32x4*)(v0p + (size_t)64 * S + (t + 1) * 64);
    }
    const char* kbuf = lds + (t & 1) * AT_STAGE + map * AT_K;
    const char* vbuf = lds + (t & 1) * AT_STAGE + 2 * AT_K;
    f32x16 s0, s1;
    const float base = (float)(t * 64 + 8 * hh) - qposf;
#pragma unroll
    for (int i = 0; i < 16; ++i) {
      const float d0 = base + (float)(16 * (i >> 3) + (i & 7));
      s0[i] = fmaf(fabsf(d0), -slope2, -C2);
      s1[i] = fmaf(fabsf(d0 + 32.f), -slope2, -C2);
    }
#pragma unroll
    for (int ks = 0; ks < 4; ++ks) {
      const bf16x8 a0 = *(const bf16x8*)(kbuf + krow * GSTR + ks * 32 + hh * 16);
      const bf16x8 a1 = *(const bf16x8*)(kbuf + (32 + krow) * GSTR + ks * 32 + hh * 16);
      s0 = MFMA(a0, qf[ks], s0);
      s1 = MFMA(a1, qf[ks], s1);
    }
    bf16x8 pf[4];
    {
      u32x4 pk[4];
#pragma unroll
      for (int i = 0; i < 16; i += 2) {
        const float e0 = __builtin_amdgcn_exp2f(s0[i]), e1 = __builtin_amdgcn_exp2f(s0[i + 1]);
        const float e2 = __builtin_amdgcn_exp2f(s1[i]), e3 = __builtin_amdgcn_exp2f(s1[i + 1]);
        lsum += (e0 + e1) + (e2 + e3);
        pk[i >> 3][(i & 7) >> 1] = pack2(e0, e1);
        pk[2 + (i >> 3)][(i & 7) >> 1] = pack2(e2, e3);
      }
#pragma unroll
      for (int j = 0; j < 4; ++j) pf[j] = __builtin_bit_cast(bf16x8, pk[j]);
    }
#pragma unroll
    for (int dvb = 0; dvb < 4; ++dvb)
#pragma unroll
      for (int j = 0; j < 4; ++j) {
        const bf16x8 va = *(const bf16x8*)(vbuf + (dvb * 32 + r) * GSTR + (16 * j + 8 * hh) * 2);
        o[dvb] = MFMA(va, pf[j], o[dvb]);
      }
    if (more) {
      char* d = lds + ((t + 1) & 1) * AT_STAGE;
      *(u32x4*)(d + lrow * GSTR + lck * 16) = rk0;
      *(u32x4*)(d + AT_K + lrow * GSTR + lck * 16) = rk1;
      *(u32x4*)(d + 2 * AT_K + lrow * GSTR + lck * 16) = rv0;
      *(u32x4*)(d + 2 * AT_K + (lrow + 64) * GSTR + lck * 16) = rv1;
    }
    __syncthreads();
  }
  lsum += __shfl_xor(lsum, 32);
  const float linv = 1.f / lsum;
  float* comb = (float*)lds;
  if (map == 1) {
#pragma unroll
    for (int dvb = 0; dvb < 4; ++dvb)
#pragma unroll
      for (int i = 0; i < 16; ++i) comb[(qb * 64 + dvb * 16 + i) * 64 + lane] = o[dvb][i] * linv;
  }
  __syncthreads();
  if (map == 0) {
    float ss = 0.f;
#pragma unroll
    for (int dvb = 0; dvb < 4; ++dvb)
#pragma unroll
      for (int i = 0; i < 16; ++i) {
        const float v = o[dvb][i] * linv - lam * comb[(qb * 64 + dvb * 16 + i) * 64 + lane];
        o[dvb][i] = v; ss += v * v;
      }
    ss += __shfl_xor(ss, 32);
    const float sc = rsqrtf(ss * (1.f / 128.f) + 1e-6f) * (1.f - lam_init);
    const bf16_t* gp = P.GDA + ltq * 512 + hd * 128;
    bf16_t* yp = P.X + ((size_t)G.tok0 + ltq) * DM + 512 + hd * 128;
    const float* sl = P.subln + L * 128;
#pragma unroll
    for (int dvb = 0; dvb < 4; ++dvb)
#pragma unroll
      for (int q4 = 0; q4 < 4; ++q4) {
        const int dv = dvb * 32 + 8 * q4 + 4 * hh;
        const u32x2 g = *(const u32x2*)(gp + dv);
        const f32x4 s4 = *(const f32x4*)(sl + dv);
        u32x2 ov = {pack2(o[dvb][4 * q4] * sc * s4[0] * bflo(g[0]), o[dvb][4 * q4 + 1] * sc * s4[1] * bfhi(g[0])),
                    pack2(o[dvb][4 * q4 + 2] * sc * s4[2] * bflo(g[1]), o[dvb][4 * q4 + 3] * sc * s4[3] * bfhi(g[1]))};
        *(u32x2*)(yp + dv) = ov;
      }
  }
}

DI void phase_mixers(const Params& P, int L, const Group& G, int* ctr, char* lds, int* s_item, int mode = 0) {
  const int nscan = mode == 2 ? 0 : G.B * 16;
  const int nattn = mode == 1 ? 0 : G.B * 4 * (G.S >> 7);
  const int total = nscan + nattn;
  for (;;) {
    __syncthreads();
    if (threadIdx.x == 0) *s_item = atomicAdd(ctr, 1);
    __syncthreads();
    const int it = *s_item;
    if (it >= total) break;
    if (it < nscan) scan_task(P, L, G, it, lds);
    else attn_item(P, L, G, it - nscan, lds);
  }
}

__global__ void __launch_bounds__(NTHREADS) fwd_megakernel(Params P) {
  __shared__ __attribute__((aligned(16))) char lds[LDS_BYTES];
  __shared__ int s_item;
  cg::grid_group grid = cg::this_grid();
  phase_weights(P, lds);
  for (int ph = 0; ph < 18; ++ph) {
    const int L = ph / 9, k = ph % 9;
    const int g = (k >= 4 && k <= 6) ? 1 : 0;
    Group G;
    G.tok0 = g ? NP : 0; G.B = g ? 8 : 16; G.S = g ? 8192 : 2048; G.ntok = g ? NS : NP;
#ifdef PROBE_SCAN
    if (k == 2 || k == 5) { phase_mixers(P, L, G, P.ctr + 64 + (L * 2 + g) * 16, lds, &s_item, 1); grid.sync(); }
#endif
#ifdef PROBE_ATTN
    if (k == 2 || k == 5) { phase_mixers(P, L, G, P.ctr + 128 + (L * 2 + g) * 16, lds, &s_item, 2); grid.sync(); }
#endif
#ifdef PROBE_INPROJ
    if (k == 1 || k == 4) { phase_inproj(P, L, G, lds); grid.sync(); }
#endif
    if (k == 0) phase_prep(P, L);
    else if (k == 1 || k == 4) phase_inproj(P, L, G, lds);
    else if (k == 2 || k == 5) phase_mixers(P, L, G, P.ctr + (L * 2 + g) * 16, lds, &s_item);
    else if (k == 3 || k == 6) phase_rwkv_final(P, L, G);
    else if (k == 7) phase_outproj(P, L, lds);
    else phase_gate(P, L, lds);
    grid.sync();
  }
}

extern "C" void kernel_launch(void* const* d_in, const int* in_sizes, int n_in, void* d_out, int out_size, void* d_ws,
                              size_t ws_size, hipStream_t stream) {
  Params P{};
  const float* const* in = (const float* const*)d_in;
  P.x_prompt = in[0]; P.x_sample = in[1]; P.p_prompt = in[2]; P.p_sample = in[3];
  P.norm_pre = in[4]; P.w_in = in[5]; P.w_out = in[6]; P.conv_w = in[7]; P.conv_b = in[8];
  P.w0 = in[9]; P.w_up = in[10]; P.a0 = in[11]; P.a_up = in[12]; P.k_k = in[13]; P.k_a = in[14];
  P.r_k = in[15]; P.ln_g = in[16]; P.ln_b = in[17]; P.q_norm = in[18]; P.k_norm = in[19];
  P.lam_vec = in[20]; P.subln = in[21]; P.ple_proj = in[22]; P.ple_norm = in[23];
  P.gate_w = in[24]; P.gate_b = in[25];
  P.out = (float*)d_out;
  char* ws = (char*)d_ws;
  size_t off = 0;
  auto take = [&](size_t bytes) { char* p = ws + off; off += (bytes + 255) & ~(size_t)255; return p; };
  P.ctr = (int*)take(1024);
  P.consts = (float*)take(1024);
  P.X = (bf16_t*)take((size_t)NTOK * DM * 2);
  P.PB = (bf16_t*)take((size_t)NTOK * DPLE * 2);
  P.RS = (float*)take((size_t)NTOK * 4);
  P.WIN = (bf16_t*)take((size_t)2 * NIN * DM * 2);
  P.WOUT = (bf16_t*)take((size_t)2 * DM * DM * 2);
  P.WPLE = (bf16_t*)take((size_t)2 * DM * DPLE * 2);
  P.WGATE = (bf16_t*)take((size_t)2 * DM * DM * 2);
  P.WUPT = (bf16_t*)take((size_t)4 * 512 * 64 * 2);
  P.AUPT = (bf16_t*)take((size_t)2 * 512 * 64 * 2);
  P.CR = (bf16_t*)take((size_t)GS * CRW * 2);
  P.GRW = (bf16_t*)take((size_t)GS * 512 * 2);
  P.Q = (bf16_t*)take((size_t)GS * 512 * 2);
  P.KB = (bf16_t*)take((size_t)GS * 512 * 2);
  P.VT = (bf16_t*)take((size_t)GS * 512 * 2);
  P.GDA = (bf16_t*)take((size_t)GS * 512 * 2);
  P.YB = (bf16_t*)take((size_t)GS * 512 * 2);
  P.BV = (bf16_t*)take((size_t)GS * 512 * 2);
  P.R1 = P.CR;
  P.R2 = P.GRW;
  P.EPART = (float*)P.VT;
  if (off > ws_size) { fprintf(stderr, "workspace too small: need %zu have %zu\n", off, ws_size); return; }
  hipMemsetAsync(P.ctr, 0, 1024, stream);
  static int grid_blocks = 0;
  if (!grid_blocks) {
    int dev = 0, cus = 0, per_cu = 0;
    hipGetDevice(&dev);
    hipDeviceGetAttribute(&cus, hipDeviceAttributeMultiprocessorCount, dev);
    hipOccupancyMaxActiveBlocksPerMultiprocessor(&per_cu, fwd_megakernel, NTHREADS, 0);
    if (per_cu < 1) { fprintf(stderr, "occupancy query returned %d\n", per_cu); per_cu = 1; }
    grid_blocks = cus;
  }
  void* args[] = {&P};
  hipError_t e = hipLaunchCooperativeKernel((void*)fwd_megakernel, dim3(grid_blocks), dim3(NTHREADS), args, 0, stream);
  if (e != hipSuccess) fprintf(stderr, "cooperative launch failed: %s (grid %d)\n", hipGetErrorString(e), grid_blocks);
}
```

```cpp
#include <hip/hip_runtime.h>
#include <hip/hip_cooperative_groups.h>
#include <cstdio>
namespace cg = cooperative_groups;

#define DI __device__ __forceinline__
typedef __attribute__((ext_vector_type(8))) short bf16x8;
typedef __attribute__((ext_vector_type(16))) float f32x16;
typedef __attribute__((ext_vector_type(4))) float f32x4;
typedef __attribute__((ext_vector_type(2))) float f32x2;
typedef __attribute__((ext_vector_type(4))) unsigned u32x4;
typedef __attribute__((ext_vector_type(2))) unsigned u32x2;
typedef unsigned short bf16_t;
#define MFMA(a, b, c) __builtin_amdgcn_mfma_f32_32x32x16_bf16((a), (b), (c), 0, 0, 0)

constexpr int DM = 1024;
constexpr int NP = 16 * 2048;
constexpr int NS = 8 * 8192;
constexpr int NTOK = NP + NS;
constexpr int DPLE = 256;
constexpr int IN_COLS = 4288;
constexpr int NIN = 4352;
constexpr int CRW = 1792;
constexpr int GS = NS;
constexpr float LOG2E = 1.4426950408889634f;
constexpr int NTHREADS = 512;
constexpr int LDS_BYTES = 147456;

struct Params {
  const float* x_prompt; const float* x_sample; const float* p_prompt; const float* p_sample;
  const float* norm_pre; const float* w_in; const float* w_out; const float* conv_w; const float* conv_b;
  const float* w0; const float* w_up; const float* a0; const float* a_up; const float* k_k; const float* k_a;
  const float* r_k; const float* ln_g; const float* ln_b; const float* q_norm; const float* k_norm;
  const float* lam_vec; const float* subln; const float* ple_proj; const float* ple_norm;
  const float* gate_w; const float* gate_b;
  float* out;
  bf16_t* X; bf16_t* PB; float* RS;
  bf16_t* CR; bf16_t* GRW; bf16_t* Q; bf16_t* KB; bf16_t* VT; bf16_t* GDA;
  bf16_t* R1; bf16_t* R2; float* EPART; bf16_t* YB; bf16_t* BV;
  bf16_t* WIN; bf16_t* WOUT; bf16_t* WPLE; bf16_t* WGATE; bf16_t* WUPT; bf16_t* AUPT;
  float* consts; int* ctr;
};

struct Group { int tok0, B, S, ntok; };

DI unsigned pack2(float a, float b) {
  typedef __attribute__((ext_vector_type(2))) __bf16 bf2;
  f32x2 v = {a, b};
  bf2 r = __builtin_convertvector(v, bf2);
  return __builtin_bit_cast(unsigned, r);
}
DI bf16_t f2bf(float a) { return (bf16_t)(pack2(a, 0.f) & 0xffffu); }
DI float bf2f(unsigned short u) { return __uint_as_float(((unsigned)u) << 16); }
DI float bflo(unsigned u) { return __uint_as_float(u << 16); }
DI float bfhi(unsigned u) { return __uint_as_float(u & 0xffff0000u); }
template <int CTRL> DI float dppf(float x) {
  return __int_as_float(__builtin_amdgcn_update_dpp(0, __float_as_int(x), CTRL, 0xF, 0xF, true));
}
DI float red4(float x) { x += dppf<0xB1>(x); x += dppf<0x4E>(x); return x; }
DI float red8(float x) { x = red4(x); x += dppf<0x141>(x); return x; }
DI float red32(float x) {
  x += __shfl_xor(x, 1); x += __shfl_xor(x, 2); x += __shfl_xor(x, 4); x += __shfl_xor(x, 8); x += __shfl_xor(x, 16);
  return x;
}
DI float sigmoidf_(float x) { return __builtin_amdgcn_rcpf(1.f + __expf(-x)); }
DI float siluf_(float x) { return x * __builtin_amdgcn_rcpf(1.f + __expf(-x)); }
DI float tanhf_(float x) { return 1.f - 2.f * __builtin_amdgcn_rcpf(1.f + __expf(2.f * x)); }
DI int opq(int x) { asm volatile("" : "+v"(x)); return x; }
DI int opqs(int x) { asm volatile("" : "+s"(x)); return x; }
DI int crow(int i, int h) { return (i & 3) + 8 * (i >> 2) + 4 * h; }

DI void transpose_convert(const float* __restrict__ src, int K, int N, bf16_t* __restrict__ dst, int Nd, int mode,
                          const float* __restrict__ rowscale, float* lds) {
  const int tid = opq(threadIdx.x);
  const int tk = K >> 6, tn = Nd >> 6;
  for (int t = blockIdx.x; t < tk * tn; t += gridDim.x) {
    const int k0 = (t % tk) << 6, n0 = (t / tk) << 6;
    int sn0 = n0;
    if (mode == 1) sn0 = (n0 < 1728) ? n0 : (n0 < 1792 ? -1 : n0 - 64);
    __syncthreads();
#pragma unroll
    for (int it = 0; it < 2; ++it) {
      const int kk = (tid >> 4) + 32 * it, n4 = (tid & 15) * 4;
      f32x4 v = {0.f, 0.f, 0.f, 0.f};
      if (sn0 >= 0) v = *(const f32x4*)(src + (size_t)(k0 + kk) * N + sn0 + n4);
      const float sc = rowscale ? rowscale[k0 + kk] : 1.f;
      lds[kk * 65 + n4 + 0] = v[0] * sc; lds[kk * 65 + n4 + 1] = v[1] * sc;
      lds[kk * 65 + n4 + 2] = v[2] * sc; lds[kk * 65 + n4 + 3] = v[3] * sc;
    }
    __syncthreads();
    const int nn = tid >> 3, k8 = (tid & 7) * 8;
    u32x4 o;
    o[0] = pack2(lds[(k8 + 0) * 65 + nn], lds[(k8 + 1) * 65 + nn]);
    o[1] = pack2(lds[(k8 + 2) * 65 + nn], lds[(k8 + 3) * 65 + nn]);
    o[2] = pack2(lds[(k8 + 4) * 65 + nn], lds[(k8 + 5) * 65 + nn]);
    o[3] = pack2(lds[(k8 + 6) * 65 + nn], lds[(k8 + 7) * 65 + nn]);
    *(u32x4*)(dst + (size_t)(n0 + nn) * K + k0 + k8) = o;
  }
}

DI void phase_weights(const Params& P, char* lds) {
  float* l = (float*)lds;
  for (int L = 0; L < 2; ++L) {
    transpose_convert(P.w_in + (size_t)L * DM * IN_COLS, DM, IN_COLS, P.WIN + (size_t)L * NIN * DM, NIN, 1, P.norm_pre + L * DM, l);
    transpose_convert(P.w_out + (size_t)L * DM * DM, DM, DM, P.WOUT + (size_t)L * DM * DM, DM, 0, nullptr, l);
    transpose_convert(P.ple_proj + (size_t)L * DPLE * DM, DPLE, DM, P.WPLE + (size_t)L * DM * DPLE, DM, 0, nullptr, l);
    transpose_convert(P.gate_w + (size_t)L * DM * DM, DM, DM, P.WGATE + (size_t)L * DM * DM, DM, 0, nullptr, l);
    for (int d = 0; d < 2; ++d)
      transpose_convert(P.w_up + (size_t)(L * 2 + d) * 64 * 512, 64, 512, P.WUPT + (size_t)(L * 2 + d) * 512 * 64, 512, 0, nullptr, l);
    transpose_convert(P.a_up + (size_t)L * 64 * 512, 64, 512, P.AUPT + (size_t)L * 512 * 64, 512, 0, nullptr, l);
  }
  if (blockIdx.x == 0 && threadIdx.x < 128) {
    const int L = threadIdx.x >> 6, lane = threadIdx.x & 63;
    const float* lv = P.lam_vec + L * 256;
    float s01 = lv[lane] * lv[64 + lane], s23 = lv[128 + lane] * lv[192 + lane];
    float mq = fmaxf(fabsf(P.q_norm[L * 128 + lane]), fabsf(P.q_norm[L * 128 + 64 + lane]));
    float mk = fmaxf(fabsf(P.k_norm[L * 128 + lane]), fabsf(P.k_norm[L * 128 + 64 + lane]));
    for (int o = 32; o >= 1; o >>= 1) {
      s01 += __shfl_xor(s01, o); s23 += __shfl_xor(s23, o);
      mq = fmaxf(mq, __shfl_xor(mq, o)); mk = fmaxf(mk, __shfl_xor(mk, o));
    }
    if (lane == 0) {
      const float lam_init = 0.8f - 0.6f * expf(-0.3f * (float)L);
      P.consts[L * 4 + 0] = expf(s01) - expf(s23) + lam_init;
      P.consts[L * 4 + 1] = 8.25f * mq * mk * LOG2E;
      P.consts[L * 4 + 2] = lam_init;
    }
  }
}

DI void phase_prep(const Params& P, int L) {
  const float* h0 = L == 0 ? P.x_prompt : P.out;
  const float* h1 = L == 0 ? P.x_sample : P.out + (size_t)NP * DM;
  const float* p0 = P.p_prompt + (size_t)L * NP * DPLE;
  const float* p1 = P.p_sample + (size_t)L * NS * DPLE;
  const int tidp = opq(threadIdx.x);
  const int lane = tidp & 63;
  const int gw = blockIdx.x * (NTHREADS / 64) + (tidp >> 6), nw = gridDim.x * (NTHREADS / 64);
  for (int tok = gw; tok < NTOK; tok += nw) {
    const float* hr = tok < NP ? h0 + (size_t)tok * DM : h1 + (size_t)(tok - NP) * DM;
    float ss = 0.f;
#pragma unroll
    for (int i = 0; i < 4; ++i) {
      f32x4 v = *(const f32x4*)(hr + i * 256 + lane * 4);
      ss += v[0] * v[0] + v[1] * v[1] + v[2] * v[2] + v[3] * v[3];
      u32x2 o = {pack2(v[0], v[1]), pack2(v[2], v[3])};
      *(u32x2*)(P.X + (size_t)tok * DM + i * 256 + lane * 4) = o;
    }
    for (int o = 32; o >= 1; o >>= 1) ss += __shfl_xor(ss, o);
    if (lane == 0) P.RS[tok] = rsqrtf(ss * (1.f / DM) + 1e-6f);
    const float* pr = tok < NP ? p0 + (size_t)tok * DPLE : p1 + (size_t)(tok - NP) * DPLE;
    f32x4 v = *(const f32x4*)(pr + lane * 4);
    u32x2 o = {pack2(v[0], v[1]), pack2(v[2], v[3])};
    *(u32x2*)(P.PB + (size_t)tok * DPLE + lane * 4) = o;
  }
}

constexpr int GSTR = 144;
constexpr int GA_BYTES = 256 * GSTR;
constexpr int GSTAGE = 2 * GA_BYTES;

DI void gemm_mainloop(const bf16_t* __restrict__ A, int lda, const bf16_t* __restrict__ Bw, int ldb, int K,
                      int m0, int n0, char* lds, f32x16 (&acc)[2][4]) {
  const int tid = opq(threadIdx.x), lane = tid & 63, w = tid >> 6, hh = lane >> 5, r = lane & 31;
  const int wm = w >> 1, wn = w & 1;
#pragma unroll
  for (int mi = 0; mi < 2; ++mi)
#pragma unroll
    for (int ni = 0; ni < 4; ++ni)
#pragma unroll
      for (int i = 0; i < 16; ++i) acc[mi][ni][i] = 0.f;
  const int lrow = tid >> 3, lkc = tid & 7;
  const bf16_t* ap = A + (size_t)(m0 + lrow) * lda + lkc * 8;
  const bf16_t* bp = Bw + (size_t)(n0 + lrow) * ldb + lkc * 8;
  const int nk = K >> 6;
  u32x4 ra[4], rb[4];
#pragma unroll
  for (int i = 0; i < 4; ++i) {
    ra[i] = *(const u32x4*)(ap + (size_t)(64 * i) * lda);
    rb[i] = *(const u32x4*)(bp + (size_t)(64 * i) * ldb);
  }
  __syncthreads();
#pragma unroll
  for (int i = 0; i < 4; ++i) {
    *(u32x4*)(lds + (lrow + 64 * i) * GSTR + lkc * 16) = ra[i];
    *(u32x4*)(lds + GA_BYTES + (lrow + 64 * i) * GSTR + lkc * 16) = rb[i];
  }
  __syncthreads();
  for (int kt = 0; kt < nk; ++kt) {
    const bool more = kt + 1 < nk;
    if (more) {
#pragma unroll
      for (int i = 0; i < 4; ++i) {
        ra[i] = *(const u32x4*)(ap + (size_t)(64 * i) * lda + (kt + 1) * 64);
        rb[i] = *(const u32x4*)(bp + (size_t)(64 * i) * ldb + (kt + 1) * 64);
      }
    }
    __builtin_amdgcn_sched_barrier(0);
    const char* sa = lds + (kt & 1) * GSTAGE + (wm * 64 + r) * GSTR + hh * 16;
    const char* sb = lds + (kt & 1) * GSTAGE + GA_BYTES + (wn * 128 + r) * GSTR + hh * 16;
#pragma unroll
    for (int ks = 0; ks < 4; ++ks) {
      bf16x8 fa[2], fb[4];
#pragma unroll
      for (int mi = 0; mi < 2; ++mi) fa[mi] = *(const bf16x8*)(sa + mi * 32 * GSTR + ks * 32);
#pragma unroll
      for (int ni = 0; ni < 4; ++ni) fb[ni] = *(const bf16x8*)(sb + ni * 32 * GSTR + ks * 32);
#pragma unroll
      for (int mi = 0; mi < 2; ++mi)
#pragma unroll
        for (int ni = 0; ni < 4; ++ni) acc[mi][ni] = MFMA(fb[ni], fa[mi], acc[mi][ni]);
    }
    if (more) {
      char* d = lds + ((kt + 1) & 1) * GSTAGE;
#pragma unroll
      for (int i = 0; i < 4; ++i) {
        *(u32x4*)(d + (lrow + 64 * i) * GSTR + lkc * 16) = ra[i];
        *(u32x4*)(d + GA_BYTES + (lrow + 64 * i) * GSTR + lkc * 16) = rb[i];
      }
    }
    __syncthreads();
  }
}

DI bool xcd_tile(int rd, int nM, int nN, int& mt, int& nt) {
  const int xcd = blockIdx.x & 7, j = blockIdx.x >> 3;
  const int u = (rd * 8 + xcd) * 32 + j;
  if (u >= nM * nN) return false;
  const int band = u / (8 * nN), rem = u % (8 * nN);
  nt = rem >> 3; mt = band * 8 + (rem & 7);
  return true;
}

DI void phase_inproj(const Params& P, int L, const Group& G, char* lds) {
  const int tid = opq(threadIdx.x), lane = tid & 63, w = tid >> 6, hh = lane >> 5, r = lane & 31;
  const int wm = w >> 1, wn = w & 1;
  const int nmt = G.ntok >> 8, ntile = nmt * 17;
  const bf16_t* A = P.X + (size_t)G.tok0 * DM;
  const bf16_t* Bw = P.WIN + (size_t)L * NIN * DM;
  for (int rd = 0; rd * 256 < ntile; ++rd) {
    int mt, nt;
    if (!xcd_tile(rd, nmt, 17, mt, nt)) continue;
    const int m0 = mt << 8, n0 = nt << 8;
    f32x16 acc[2][4];
    gemm_mainloop(A, DM, Bw, DM, DM, m0, n0, lds, acc);
    const int colw = n0 + wn * 128 + 4 * hh;
    if (nt < 7) {
#pragma unroll
      for (int mi = 0; mi < 2; ++mi) {
        const int row = m0 + wm * 64 + mi * 32 + r;
        const float rsv = P.RS[G.tok0 + row];
        bf16_t* dst = P.CR + (size_t)row * CRW + colw;
#pragma unroll
        for (int ni = 0; ni < 4; ++ni)
#pragma unroll
          for (int q4 = 0; q4 < 4; ++q4) {
            u32x2 o = {pack2(acc[mi][ni][4 * q4] * rsv, acc[mi][ni][4 * q4 + 1] * rsv),
                       pack2(acc[mi][ni][4 * q4 + 2] * rsv, acc[mi][ni][4 * q4 + 3] * rsv)};
            *(u32x2*)(dst + ni * 32 + q4 * 8) = o;
          }
      }
    } else if (nt < 9 || nt >= 15) {
      bf16_t* dbase = nt < 9 ? P.GRW : P.GDA;
      const int c0 = colw - (nt < 9 ? 1792 : 3840);
#pragma unroll
      for (int mi = 0; mi < 2; ++mi) {
        const int row = m0 + wm * 64 + mi * 32 + r;
        const float rsv = P.RS[G.tok0 + row];
        bf16_t* dst = dbase + (size_t)row * 512 + c0;
#pragma unroll
        for (int ni = 0; ni < 4; ++ni)
#pragma unroll
          for (int q4 = 0; q4 < 4; ++q4) {
            u32x2 o = {pack2(siluf_(acc[mi][ni][4 * q4] * rsv), siluf_(acc[mi][ni][4 * q4 + 1] * rsv)),
                       pack2(siluf_(acc[mi][ni][4 * q4 + 2] * rsv), siluf_(acc[mi][ni][4 * q4 + 3] * rsv))};
            *(u32x2*)(dst + ni * 32 + q4 * 8) = o;
          }
      }
    } else if (nt < 13) {
      const bool isq = nt < 11;
      bf16_t* dbase = isq ? P.Q : P.KB;
      const int c0 = colw - (isq ? 2304 : 2816);
      const float* g = (isq ? P.q_norm : P.k_norm) + L * 128 + 4 * hh;
      const float osc = isq ? 0.125f * LOG2E : 1.f;
#pragma unroll
      for (int mi = 0; mi < 2; ++mi) {
        const int row = m0 + wm * 64 + mi * 32 + r;
        const float rsv = P.RS[G.tok0 + row];
        bf16_t* dst = dbase + (size_t)row * 512 + c0;
#pragma unroll
        for (int gi = 0; gi < 2; ++gi) {
          float ss = 0.f;
#pragma unroll
          for (int t2 = 0; t2 < 2; ++t2)
#pragma unroll
            for (int i = 0; i < 16; ++i) { const float v = acc[mi][2 * gi + t2][i] * rsv; ss += v * v; }
          ss += __shfl_xor(ss, 32);
          const float sc = rsqrtf(ss * (1.f / 64.f) + 1e-6f) * rsv * osc;
#pragma unroll
          for (int t2 = 0; t2 < 2; ++t2)
#pragma unroll
            for (int q4 = 0; q4 < 4; ++q4) {
              const f32x4 gv = *(const f32x4*)(g + gi * 64 + t2 * 32 + q4 * 8);
              u32x2 o = {pack2(acc[mi][2 * gi + t2][4 * q4] * sc * gv[0], acc[mi][2 * gi + t2][4 * q4 + 1] * sc * gv[1]),
                         pack2(acc[mi][2 * gi + t2][4 * q4 + 2] * sc * gv[2], acc[mi][2 * gi + t2][4 * q4 + 3] * sc * gv[3])};
              *(u32x2*)(dst + (2 * gi + t2) * 32 + q4 * 8) = o;
            }
        }
      }
    } else {
      const int hd = (n0 + wn * 128 - 3328) >> 7;
      const int row0 = m0 + wm * 64;
      const int b = row0 / G.S, s0 = row0 % G.S;
#pragma unroll
      for (int mi = 0; mi < 2; ++mi) {
        const int s = s0 + mi * 32 + r;
        const float rsv = P.RS[G.tok0 + b * G.S + s];
        bf16_t* dst = P.VT + ((size_t)((b * 4 + hd) * 128 + 4 * hh)) * G.S + s;
        const size_t Sz = (size_t)G.S;
#pragma unroll
        for (int ni = 0; ni < 4; ++ni)
#pragma unroll
          for (int q4 = 0; q4 < 4; ++q4) {
            bf16_t* pq = dst + (size_t)(ni * 32 + 8 * q4) * Sz;
            pq[0] = f2bf(acc[mi][ni][4 * q4] * rsv);
            pq[Sz] = f2bf(acc[mi][ni][4 * q4 + 1] * rsv);
            pq[2 * Sz] = f2bf(acc[mi][ni][4 * q4 + 2] * rsv);
            pq[3 * Sz] = f2bf(acc[mi][ni][4 * q4 + 3] * rsv);
            __builtin_amdgcn_sched_barrier(0);
          }
      }
    }
  }
}

DI void phase_outproj(const Params& P, int L, char* lds) {
  const int tid = opq(threadIdx.x), lane = tid & 63, w = tid >> 6, hh = lane >> 5, r = lane & 31;
  const int wm = w >> 1, wn = w & 1;
  const float* h0 = L == 0 ? P.x_prompt : P.out;
  const float* h1 = L == 0 ? P.x_sample : P.out + (size_t)NP * DM;
  const int nmt = NTOK >> 8, ntile = nmt * 4;
  for (int rd2 = 0; rd2 * 256 < 2 * ntile; ++rd2) {
    const bool isE = rd2 * 256 >= ntile;
    int mt, nt;
    if (!xcd_tile(isE ? rd2 - ntile / 256 : rd2, nmt, 4, mt, nt)) continue;
    const int m0 = mt << 8, n0 = nt << 8;
    const int colw = n0 + wn * 128 + 4 * hh;
    f32x16 acc[2][4];
    if (!isE) {
      gemm_mainloop(P.X, DM, P.WOUT + (size_t)L * DM * DM, DM, DM, m0, n0, lds, acc);
#pragma unroll
      for (int mi = 0; mi < 2; ++mi) {
        const int row = m0 + wm * 64 + mi * 32 + r;
        const float* hr = (row < NP ? h0 + (size_t)row * DM : h1 + (size_t)(row - NP) * DM) + colw;
        float* op = P.out + (size_t)row * DM + colw;
        bf16_t* rp = P.R1 + (size_t)row * DM + colw;
#pragma unroll
        for (int ni = 0; ni < 4; ++ni)
#pragma unroll
          for (int q4 = 0; q4 < 4; ++q4) {
            f32x4 hv = *(const f32x4*)(hr + ni * 32 + q4 * 8);
            hv[0] += acc[mi][ni][4 * q4]; hv[1] += acc[mi][ni][4 * q4 + 1];
            hv[2] += acc[mi][ni][4 * q4 + 2]; hv[3] += acc[mi][ni][4 * q4 + 3];
            *(f32x4*)(op + ni * 32 + q4 * 8) = hv;
            u32x2 o = {pack2(hv[0], hv[1]), pack2(hv[2], hv[3])};
            *(u32x2*)(rp + ni * 32 + q4 * 8) = o;
          }
      }
    } else {
      gemm_mainloop(P.PB, DPLE, P.WPLE + (size_t)L * DM * DPLE, DPLE, DPLE, m0, n0, lds, acc);
#pragma unroll
      for (int mi = 0; mi < 2; ++mi) {
        const int row = m0 + wm * 64 + mi * 32 + r;
        bf16_t* rp = P.R2 + (size_t)row * DM + colw;
        float ss = 0.f;
#pragma unroll
        for (int ni = 0; ni < 4; ++ni)
#pragma unroll
          for (int q4 = 0; q4 < 4; ++q4) {
            const float v0 = acc[mi][ni][4 * q4], v1 = acc[mi][ni][4 * q4 + 1], v2 = acc[mi][ni][4 * q4 + 2], v3 = acc[mi][ni][4 * q4 + 3];
            ss += v0 * v0 + v1 * v1 + v2 * v2 + v3 * v3;
            u32x2 o = {pack2(v0, v1), pack2(v2, v3)};
            *(u32x2*)(rp + ni * 32 + q4 * 8) = o;
          }
        ss += __shfl_xor(ss, 32);
        if (hh == 0) P.EPART[(size_t)(nt * 2 + wn) * NTOK + row] = ss;
      }
    }
  }
}

DI void phase_gate(const Params& P, int L, char* lds) {
  const int tid = opq(threadIdx.x), lane = tid & 63, w = tid >> 6, hh = lane >> 5, r = lane & 31;
  const int wm = w >> 1, wn = w & 1;
  const int nmt = NTOK >> 8, ntile = nmt * 4;
  for (int rd = 0; rd * 256 < ntile; ++rd) {
    int mt, nt;
    if (!xcd_tile(rd, nmt, 4, mt, nt)) continue;
    const int m0 = mt << 8, n0 = nt << 8;
    const int colw = n0 + wn * 128 + 4 * hh;
    f32x16 acc[2][4];
    gemm_mainloop(P.R1, DM, P.WGATE + (size_t)L * DM * DM, DM, DM, m0, n0, lds, acc);
    const float* gbp = P.gate_b + L * DM + colw;
    const float* pnp = P.ple_norm + L * DM + colw;
#pragma unroll
    for (int mi = 0; mi < 2; ++mi) {
      const int row = m0 + wm * 64 + mi * 32 + r;
      float es = 0.f;
#pragma unroll
      for (int j = 0; j < 8; ++j) es += P.EPART[(size_t)j * NTOK + row];
      const float rse = rsqrtf(es * (1.f / DM) + 1e-6f);
      float* op = P.out + (size_t)row * DM + colw;
      const bf16_t* ep = P.R2 + (size_t)row * DM + colw;
#pragma unroll
      for (int ni = 0; ni < 4; ++ni)
#pragma unroll
        for (int q4 = 0; q4 < 4; ++q4) {
          const int co = ni * 32 + q4 * 8;
          const f32x4 gb = *(const f32x4*)(gbp + co), pn = *(const f32x4*)(pnp + co);
          const u32x2 ev = *(const u32x2*)(ep + co);
          f32x4 hv = *(const f32x4*)(op + co);
          hv[0] += sigmoidf_(acc[mi][ni][4 * q4] + gb[0]) * (bflo(ev[0]) * rse * pn[0]);
          hv[1] += sigmoidf_(acc[mi][ni][4 * q4 + 1] + gb[1]) * (bfhi(ev[0]) * rse * pn[1]);
          hv[2] += sigmoidf_(acc[mi][ni][4 * q4 + 2] + gb[2]) * (bflo(ev[1]) * rse * pn[2]);
          hv[3] += sigmoidf_(acc[mi][ni][4 * q4 + 3] + gb[3]) * (bfhi(ev[1]) * rse * pn[3]);
          *(f32x4*)(op + co) = hv;
        }
    }
  }
}

constexpr int TC = 32;
constexpr int CB_OP = TC * 64 * 4;
constexpr int CB_BYTES = 6 * CB_OP + 128;
constexpr int PW_BYTES = 10 * 640 + 2 * 8 * 144;
constexpr int PW_BASE = 2 * CB_BYTES;

template <int N> DI void red64v(float (&x)[N]) {
#pragma unroll
  for (int i = 0; i < N; ++i) x[i] += dppf<0xB1>(x[i]);
#pragma unroll
  for (int i = 0; i < N; ++i) x[i] += dppf<0x4E>(x[i]);
#pragma unroll
  for (int i = 0; i < N; ++i) x[i] += dppf<0x141>(x[i]);
#pragma unroll
  for (int i = 0; i < N; ++i) x[i] += dppf<0x140>(x[i]);
#pragma unroll
  for (int i = 0; i < N; ++i) x[i] += __shfl_xor(x[i], 16);
#pragma unroll
  for (int i = 0; i < N; ++i) x[i] += __shfl_xor(x[i], 32);
}

struct ScanOps { f32x4 w0, w1, a0, a1, b0, b1, k0, k1, r0, r1; f32x2 v; };

DI ScanOps scan_load(const float* __restrict__ ob, int s, int coff, int row0) {
  ScanOps o;
  const float* p = ob + s * 64 + coff;
  o.w0 = *(const f32x4*)(p);                 o.w1 = *(const f32x4*)(p + 4);
  o.a0 = *(const f32x4*)(p + TC * 64);       o.a1 = *(const f32x4*)(p + TC * 64 + 4);
  o.b0 = *(const f32x4*)(p + 2 * TC * 64);   o.b1 = *(const f32x4*)(p + 2 * TC * 64 + 4);
  o.k0 = *(const f32x4*)(p + 3 * TC * 64);   o.k1 = *(const f32x4*)(p + 3 * TC * 64 + 4);
  o.r0 = *(const f32x4*)(p + 4 * TC * 64);   o.r1 = *(const f32x4*)(p + 4 * TC * 64 + 4);
  o.v = *(const f32x2*)(ob + 5 * TC * 64 + s * 64 + row0);
  return o;
}

DI f32x2 lo2(f32x4 x) { return f32x2{x[0], x[1]}; }
DI f32x2 hi2(f32x4 x) { return f32x2{x[2], x[3]}; }

DI f32x2 scan_step(f32x2 (&st)[2][4], const ScanOps& o) {
  const f32x2 a[4] = {lo2(o.a0), hi2(o.a0), lo2(o.a1), hi2(o.a1)};
  const f32x2 wv[4] = {lo2(o.w0), hi2(o.w0), lo2(o.w1), hi2(o.w1)};
  const f32x2 bv[4] = {lo2(o.b0), hi2(o.b0), lo2(o.b1), hi2(o.b1)};
  const f32x2 kv[4] = {lo2(o.k0), hi2(o.k0), lo2(o.k1), hi2(o.k1)};
  const f32x2 rv[4] = {lo2(o.r0), hi2(o.r0), lo2(o.r1), hi2(o.r1)};
  f32x2 y;
#pragma unroll
  for (int rr = 0; rr < 2; ++rr) {
    f32x2 p = st[rr][0] * a[0];
    p = st[rr][1] * a[1] + p; p = st[rr][2] * a[2] + p; p = st[rr][3] * a[3] + p;
    const float sa = red8(p[0] + p[1]);
    const f32x2 sa2 = {sa, sa};
    const f32x2 v2 = {o.v[rr], o.v[rr]};
    f32x2 q = {0.f, 0.f};
#pragma unroll
    for (int j = 0; j < 4; ++j) {
      f32x2 x = st[rr][j] * wv[j];
      x = sa2 * bv[j] + x;
      x = v2 * kv[j] + x;
      st[rr][j] = x;
      q = x * rv[j] + q;
    }
    y[rr] = red8(q[0] + q[1]);
  }
  return y;
}

DI void scan_task(const Params& P, int L_, const Group& G, int task, char* lds) {
  const int L = opqs(__builtin_amdgcn_readfirstlane(L_));
  const int tid = opq(threadIdx.x), lane = tid & 63, w = tid >> 6;
  const int dir = task & 1, b = task >> 4, hd = (task >> 1) & 7;
  const int S = G.S, nc = S / TC;
  const int sg = dir ? -1 : 1;
  const bf16_t* crb = P.CR + (size_t)b * S * CRW;

  const int srow0 = (w & 3) * 16 + (lane >> 3) * 2, scs = lane & 7;
  f32x2 st[2][4];
#pragma unroll
  for (int rr = 0; rr < 2; ++rr)
#pragma unroll
    for (int j = 0; j < 4; ++j) st[rr][j] = f32x2{0.f, 0.f};

  const int pw = w & 3, ec = lane, hh = lane >> 5, r = lane & 31;
  char* pwb = lds + PW_BASE + pw * PW_BYTES;
  const int ch = hd * 64 + ec;
  const float c_kk = P.k_k[L * 512 + ch], c_ka = P.k_a[L * 512 + ch], c_rk = P.r_k[L * 512 + ch];
  const float* cw = P.conv_w + (size_t)L * 3 * 1728;
  const float* cb = P.conv_b + (size_t)L * 1728;
  const bf16_t* wsrcW = P.WUPT + (size_t)(L * 2 + dir) * 512 * 64 + (size_t)(hd * 64 + r) * 64 + hh * 8;
  const bf16_t* wsrcA = P.AUPT + (size_t)L * 512 * 64 + (size_t)(hd * 64 + r) * 64 + hh * 8;
  const float* w0p = P.w0 + (size_t)(L * 2 + dir) * 512 + hd * 64 + r;
  const float* a0p = P.a0 + (size_t)L * 512 + hd * 64 + r;

  auto prepare = [&](int cc, char* cbuf) {
    float* oW = (float*)cbuf; float* oA = (float*)(cbuf + CB_OP); float* oB = (float*)(cbuf + 2 * CB_OP);
    float* oK = (float*)(cbuf + 3 * CB_OP); float* oR = (float*)(cbuf + 4 * CB_OP); float* oV = (float*)(cbuf + 5 * CB_OP);
    float* oBon = (float*)(cbuf + 6 * CB_OP);
    const int ln = opq(lane);
    const int tbase = dir ? S - cc * TC - 8 * pw - 9 : cc * TC + 8 * pw - 1;
    {
      u32x4 rv[7];
#pragma unroll
      for (int it = 0; it < 7; ++it) {
        int id = ln + it * 64;
        id = id < 400 ? id : 399;
        const int rr = id / 40, cc8 = id % 40, q = cc8 >> 3, c8 = (cc8 & 7) * 8;
        const int tok = tbase + rr;
        const bool ok = tok >= 0 && tok < S;
        const int tokc = tok < 0 ? 0 : (tok >= S ? S - 1 : tok);
        const int col = (q == 0 ? hd * 64 : q == 1 ? 512 + hd * 64 : q == 2 ? 1024 + hd * 64 : q == 3 ? 1536 + dir * 64 : 1664) + c8;
        const u32x4 v = *(const u32x4*)(crb + (size_t)tokc * CRW + col);
        const u32x4 z = {0u, 0u, 0u, 0u};
        rv[it] = ok ? v : z;
      }
#pragma unroll
      for (int it = 0; it < 7; ++it) {
        int id = ln + it * 64;
        id = id < 400 ? id : 399;
        *(u32x4*)(pwb + (id / 40) * 640 + (id % 40) * 16) = rv[it];
      }
    }
    asm volatile("" ::: "memory");
    float cwp[5], cwc[5], cwn[5], cbb[5];
#pragma unroll
    for (int q = 0; q < 5; ++q) {
      const int cqq = (q == 0 ? hd * 64 : q == 1 ? 512 + hd * 64 : q == 2 ? 1024 + hd * 64 : q == 3 ? 1536 + dir * 64 : 1664) + ln;
      const float w0 = cw[cqq], w1 = cw[1728 + cqq], w2 = cw[2 * 1728 + cqq];
      cwp[q] = dir ? w2 : w0; cwc[q] = w1; cwn[q] = dir ? w0 : w2; cbb[q] = cb[cqq];
    }
    bf16x8 lf[2][2][4];
#pragma unroll
    for (int nb = 0; nb < 2; ++nb)
#pragma unroll
      for (int ks = 0; ks < 4; ++ks) {
        lf[0][nb][ks] = *(const bf16x8*)(wsrcW + nb * 32 * 64 + ks * 16);
        lf[1][nb][ks] = *(const bf16x8*)(wsrcA + nb * 32 * 64 + ks * 16);
      }
    const bf16_t* raw = (const bf16_t*)pwb;
    bf16_t* zt = (bf16_t*)(pwb + 6400); bf16_t* za = (bf16_t*)(pwb + 6400 + 8 * 144);
    float kreg[8];
#pragma unroll
    for (int hf = 0; hf < 2; ++hf) {
      float xr[6][5];
#pragma unroll
      for (int j = 0; j < 6; ++j) {
        const int vi = hf * 4 + j - 1;
        const int jj = dir ? 8 - vi : vi + 1;
#pragma unroll
        for (int q = 0; q < 5; ++q) xr[j][q] = bf2f(raw[jj * 320 + q * 64 + ln]);
      }
#pragma unroll
      for (int i = 0; i < 4; ++i) {
        float v[5];
#pragma unroll
        for (int q = 0; q < 5; ++q) v[q] = cbb[q] + cwp[q] * xr[i][q] + cwc[q] * xr[i + 1][q] + cwn[q] * xr[i + 2][q];
        const int ti = hf * 4 + i, s = 8 * pw + ti;
        oR[s * 64 + ln] = v[0];
        kreg[ti] = v[1];
        oV[s * 64 + ln] = v[2];
        zt[ti * 72 + ln] = f2bf(tanhf_(v[3]));
        za[ti * 72 + ln] = f2bf(v[4]);
      }
    }
    asm volatile("" ::: "memory");
    {
      const char* az = (const char*)zt + (r & 7) * 144 + hh * 16;
      const char* aa = (const char*)za + (r & 7) * 144 + hh * 16;
#pragma unroll
      for (int nb = 0; nb < 2; ++nb) {
        f32x16 accw, acca;
#pragma unroll
        for (int i = 0; i < 16; ++i) { accw[i] = 0.f; acca[i] = 0.f; }
#pragma unroll
        for (int ks = 0; ks < 4; ++ks) {
          const bf16x8 fz = *(const bf16x8*)(az + ks * 32);
          const bf16x8 fa = *(const bf16x8*)(aa + ks * 32);
          accw = MFMA(fz, lf[0][nb][ks], accw);
          acca = MFMA(fa, lf[1][nb][ks], acca);
        }
        const float w0v = w0p[nb * 32], a0v = a0p[nb * 32];
#pragma unroll
        for (int i = 0; i < 4; ++i) {
          const int s = 8 * pw + 4 * hh + i;
          oW[s * 64 + nb * 32 + r] = __expf(-0.6065306597126334f * sigmoidf_(w0v + accw[i]));
          oA[s * 64 + nb * 32 + r] = sigmoidf_(a0v + acca[i]);
        }
      }
    }
    asm volatile("" ::: "memory");
    {
      float ag[8], kk[8], ss[8], km[8], bn[8];
#pragma unroll
      for (int i = 0; i < 8; ++i) {
        const int s = 8 * pw + i;
        ag[i] = oA[s * 64 + ln];
        kk[i] = kreg[i] * c_kk;
        ss[i] = kk[i] * kk[i];
        km[i] = kreg[i] * (1.f + (ag[i] - 1.f) * c_ka);
        bn[i] = oR[s * 64 + ln] * km[i] * c_rk;
      }
      red64v<8>(ss);
      red64v<8>(bn);
#pragma unroll
      for (int i = 0; i < 8; ++i) {
        const int s = 8 * pw + i;
        const float kn = kk[i] * rsqrtf(ss[i] + 1e-12f);
        oK[s * 64 + ln] = km[i];
        oA[s * 64 + ln] = -kn;
        oB[s * 64 + ln] = kn * ag[i];
        if (ln == 0) oBon[s] = bn[i];
      }
    }
  };

  __syncthreads();
  if (w >= 4) prepare(0, lds);
  __syncthreads();

  for (int c = 0; c < nc; ++c) {
    char* cbuf = lds + (c & 1) * CB_BYTES;
    if (w < 4) {
      const float* sb = (const float*)cbuf;
      const float* oBon = (const float*)(cbuf + 6 * CB_OP);
      ScanOps cur = scan_load(sb, 0, scs * 8, srow0);
#pragma unroll 1
      for (int s8 = 0; s8 < TC; s8 += 8) {
        f32x2 ykeep = {0.f, 0.f};
#pragma unroll
        for (int u = 0; u < 8; ++u) {
          const int s = s8 + u;
          const ScanOps nxt = scan_load(sb, s + 1 < TC ? s + 1 : s, scs * 8, srow0);
          const f32x2 y = scan_step(st, cur);
          if (u == scs) ykeep = y;
          cur = nxt;
        }
        const int s = s8 + scs;
        const int ts = dir ? S - 1 - (c * TC + s) : c * TC + s;
        const size_t lt = (size_t)b * S + ts;
        const unsigned yv = pack2(ykeep[0], ykeep[1]);
        if (dir == 0) {
          *(unsigned*)(P.X + ((size_t)G.tok0 + lt) * DM + hd * 64 + srow0) = yv;
          const float bon = oBon[s];
          const f32x2 vv = *(const f32x2*)(sb + 5 * TC * 64 + s * 64 + srow0);
          *(unsigned*)(P.BV + lt * 512 + hd * 64 + srow0) = pack2(bon * vv[0], bon * vv[1]);
        } else {
          *(unsigned*)(P.YB + lt * 512 + hd * 64 + srow0) = yv;
        }
      }
    } else if (c + 1 < nc) {
      prepare(c + 1, lds + ((c + 1) & 1) * CB_BYTES);
    }
    __syncthreads();
  }
}

DI void phase_rwkv_final(const Params& P, int L, const Group& G) {
  const int tidp = opq(threadIdx.x);
  const int lane = tidp & 63;
  const int gw = blockIdx.x * (NTHREADS / 64) + (tidp >> 6), nw = gridDim.x * (NTHREADS / 64);
  const f32x4 g0 = *(const f32x4*)(P.ln_g + L * 512 + lane * 8), g1 = *(const f32x4*)(P.ln_g + L * 512 + lane * 8 + 4);
  const f32x4 b0 = *(const f32x4*)(P.ln_b + L * 512 + lane * 8), b1 = *(const f32x4*)(P.ln_b + L * 512 + lane * 8 + 4);
  const float lg[8] = {g0[0], g0[1], g0[2], g0[3], g1[0], g1[1], g1[2], g1[3]};
  const float lb[8] = {b0[0], b0[1], b0[2], b0[3], b1[0], b1[1], b1[2], b1[3]};
  for (int lt = gw; lt < G.ntok; lt += nw) {
    bf16_t* xp = P.X + ((size_t)G.tok0 + lt) * DM + lane * 8;
    const u32x4 yf = *(const u32x4*)xp;
    const u32x4 yb = *(const u32x4*)(P.YB + (size_t)lt * 512 + lane * 8);
    const u32x4 bv = *(const u32x4*)(P.BV + (size_t)lt * 512 + lane * 8);
    const u32x4 gt = *(const u32x4*)(P.GRW + (size_t)lt * 512 + lane * 8);
    float y[8];
    float sum = 0.f;
#pragma unroll
    for (int j = 0; j < 4; ++j) {
      y[2 * j] = bflo(yf[j]) + bflo(yb[j]); y[2 * j + 1] = bfhi(yf[j]) + bfhi(yb[j]);
      sum += y[2 * j] + y[2 * j + 1];
    }
    const float mu = red8(sum) * (1.f / 64.f);
    float vs = 0.f;
#pragma unroll
    for (int j = 0; j < 8; ++j) { y[j] -= mu; vs += y[j] * y[j]; }
    const float rstd = rsqrtf(red8(vs) * (1.f / 64.f) + 64e-5f);
    u32x4 o;
#pragma unroll
    for (int j = 0; j < 4; ++j) {
      const float o0 = (y[2 * j] * rstd * lg[2 * j] + lb[2 * j] + bflo(bv[j])) * bflo(gt[j]);
      const float o1 = (y[2 * j + 1] * rstd * lg[2 * j + 1] + lb[2 * j + 1] + bfhi(bv[j])) * bfhi(gt[j]);
      o[j] = pack2(o0, o1);
    }
    *(u32x4*)xp = o;
  }
}

constexpr int AT_K = 64 * GSTR;
constexpr int AT_STAGE = 2 * AT_K + 128 * GSTR;

DI void attn_item(const Params& P, int L_, const Group& G, int item, char* lds) {
  const int L = opqs(__builtin_amdgcn_readfirstlane(L_));
  const int tid = opq(threadIdx.x), lane = tid & 63, w = tid >> 6, hh = lane >> 5, r = lane & 31;
  const int S = G.S, nqb = S >> 7;
  const int qblk = item % nqb, bh = item / nqb, hd = bh & 3, b = bh >> 2;
  const int map = w & 1, qb = w >> 1;
  const int q0 = qblk * 128 + qb * 32;
  const size_t ltq = (size_t)b * S + q0 + r;
  bf16x8 qf[4];
  {
    const bf16_t* qp = P.Q + ltq * 512 + hd * 128 + map * 64 + hh * 8;
#pragma unroll
    for (int ks = 0; ks < 4; ++ks) qf[ks] = *(const bf16x8*)(qp + ks * 16);
  }
  f32x16 o[4];
#pragma unroll
  for (int d = 0; d < 4; ++d)
#pragma unroll
    for (int i = 0; i < 16; ++i) o[d][i] = 0.f;
  f32x16 accl;
#pragma unroll
  for (int i = 0; i < 16; ++i) accl[i] = 0.f;
  const float slope2 = exp2f(-2.f * (float)(hd + 1)) * LOG2E;
  float so[16];
#pragma unroll
  for (int i = 0; i < 16; ++i) so[i] = slope2 * (float)(16 * (i >> 3) + (i & 7));
  bf16x8 ones;
#pragma unroll
  for (int j = 0; j < 8; ++j) ones[j] = (short)0x3F80;
  const float lam = P.consts[L * 4 + 0], C2 = P.consts[L * 4 + 1], lam_init = P.consts[L * 4 + 2];
  const float qposf = (float)(q0 + r);
  const int Dz = (int)ceilf(150.f / slope2);
  const int Q0 = qblk * 128;
  const int tlo = (Q0 - 63 - Dz) < 0 ? 0 : (Q0 - 63 - Dz) / 64 + 1;
  const int thx = min(S >> 6, (Q0 + 127 + Dz + 63) / 64);
  const int nt = thx - tlo;
  const int lrow = tid >> 3, lck = tid & 7;
  const bf16_t* k0p = P.KB + ((size_t)b * S + tlo * 64 + lrow) * 512 + hd * 128 + lck * 8;
  const bf16_t* v0p = P.VT + ((size_t)((b * 4 + hd) * 128 + lrow)) * S + tlo * 64 + lck * 8;
  u32x4 rk0, rk1, rv0, rv1;
  rk0 = *(const u32x4*)(k0p); rk1 = *(const u32x4*)(k0p + 64);
  rv0 = *(const u32x4*)(v0p); rv1 = *(const u32x4*)(v0p + (size_t)64 * S);
  __syncthreads();
  *(u32x4*)(lds + lrow * GSTR + lck * 16) = rk0;
  *(u32x4*)(lds + AT_K + lrow * GSTR + lck * 16) = rk1;
  *(u32x4*)(lds + 2 * AT_K + lrow * GSTR + lck * 16) = rv0;
  *(u32x4*)(lds + 2 * AT_K + (lrow + 64) * GSTR + lck * 16) = rv1;
  __syncthreads();
  const int krow = (r & ~12) | ((r & 4) << 1) | ((r & 8) >> 1);
  for (int t = 0; t < nt; ++t) {
    const bool more = t + 1 < nt;
    if (more) {
      rk0 = *(const u32x4*)(k0p + (size_t)(t + 1) * 64 * 512); rk1 = *(const u32x4*)(k0p + (size_t)(t + 1) * 64 * 512 + 64);
      rv0 = *(const u32x4*)(v0p + (t + 1) * 64); rv1 = *(const u32x4*)(v0p + (size_t)64 * S + (t + 1) * 64);
    }
    __builtin_amdgcn_sched_barrier(0);
    const char* kbuf = lds + (t & 1) * AT_STAGE + map * AT_K;
    const char* vbuf = lds + (t & 1) * AT_STAGE + 2 * AT_K;
    f32x16 s0, s1;
    const int kt0 = (tlo + t) * 64;
    const float base = (float)(kt0 + 8 * hh) - qposf;
    if (kt0 + 63 < q0) {
      const float bl = fmaf(slope2, base, -C2), bl2 = bl + 32.f * slope2;
#pragma unroll
      for (int i = 0; i < 16; ++i) { s0[i] = bl + so[i]; s1[i] = bl2 + so[i]; }
    } else if (kt0 > q0 + 31) {
      const float br = fmaf(-slope2, base, -C2), br2 = br - 32.f * slope2;
#pragma unroll
      for (int i = 0; i < 16; ++i) { s0[i] = br - so[i]; s1[i] = br2 - so[i]; }
    } else {
#pragma unroll
      for (int i = 0; i < 16; ++i) {
        const float d0 = base + (float)(16 * (i >> 3) + (i & 7));
        s0[i] = fmaf(fabsf(d0), -slope2, -C2);
        s1[i] = fmaf(fabsf(d0 + 32.f), -slope2, -C2);
      }
    }
#pragma unroll
    for (int ks = 0; ks < 4; ++ks) {
      const bf16x8 a0 = *(const bf16x8*)(kbuf + krow * GSTR + ks * 32 + hh * 16);
      const bf16x8 a1 = *(const bf16x8*)(kbuf + (32 + krow) * GSTR + ks * 32 + hh * 16);
      s0 = MFMA(a0, qf[ks], s0);
      s1 = MFMA(a1, qf[ks], s1);
    }
    bf16x8 pf[4];
    {
      u32x4 pk[4];
#pragma unroll
      for (int i = 0; i < 16; i += 2) {
        const float e0 = __builtin_amdgcn_exp2f(s0[i]), e1 = __builtin_amdgcn_exp2f(s0[i + 1]);
        const float e2 = __builtin_amdgcn_exp2f(s1[i]), e3 = __builtin_amdgcn_exp2f(s1[i + 1]);
        pk[i >> 3][(i & 7) >> 1] = pack2(e0, e1);
        pk[2 + (i >> 3)][(i & 7) >> 1] = pack2(e2, e3);
      }
#pragma unroll
      for (int j = 0; j < 4; ++j) pf[j] = __builtin_bit_cast(bf16x8, pk[j]);
    }
#pragma unroll
    for (int j = 0; j < 4; ++j) accl = MFMA(ones, pf[j], accl);
#pragma unroll
    for (int dvb = 0; dvb < 4; ++dvb)
#pragma unroll
      for (int j = 0; j < 4; ++j) {
        const bf16x8 va = *(const bf16x8*)(vbuf + (dvb * 32 + r) * GSTR + (16 * j + 8 * hh) * 2);
        o[dvb] = MFMA(va, pf[j], o[dvb]);
      }
    if (more) {
      char* d = lds + ((t + 1) & 1) * AT_STAGE;
      *(u32x4*)(d + lrow * GSTR + lck * 16) = rk0;
      *(u32x4*)(d + AT_K + lrow * GSTR + lck * 16) = rk1;
      *(u32x4*)(d + 2 * AT_K + lrow * GSTR + lck * 16) = rv0;
      *(u32x4*)(d + 2 * AT_K + (lrow + 64) * GSTR + lck * 16) = rv1;
    }
    __syncthreads();
  }
  const float linv = 1.f / accl[0];
  float* comb = (float*)lds;
  if (map == 1) {
#pragma unroll
    for (int dvb = 0; dvb < 4; ++dvb)
#pragma unroll
      for (int i = 0; i < 16; ++i) comb[(qb * 64 + dvb * 16 + i) * 64 + lane] = o[dvb][i] * linv;
  }
  __syncthreads();
  if (map == 0) {
    float ss = 0.f;
#pragma unroll
    for (int dvb = 0; dvb < 4; ++dvb)
#pragma unroll
      for (int i = 0; i < 16; ++i) {
        const float v = o[dvb][i] * linv - lam * comb[(qb * 64 + dvb * 16 + i) * 64 + lane];
        o[dvb][i] = v; ss += v * v;
      }
    ss += __shfl_xor(ss, 32);
    const float sc = rsqrtf(ss * (1.f / 128.f) + 1e-6f) * (1.f - lam_init);
    const bf16_t* gp = P.GDA + ltq * 512 + hd * 128;
    bf16_t* yp = P.X + ((size_t)G.tok0 + ltq) * DM + 512 + hd * 128;
    const float* sl = P.subln + L * 128;
#pragma unroll
    for (int dvb = 0; dvb < 4; ++dvb)
#pragma unroll
      for (int q4 = 0; q4 < 4; ++q4) {
        const int dv = dvb * 32 + 8 * q4 + 4 * hh;
        const u32x2 g = *(const u32x2*)(gp + dv);
        const f32x4 s4 = *(const f32x4*)(sl + dv);
        u32x2 ov = {pack2(o[dvb][4 * q4] * sc * s4[0] * bflo(g[0]), o[dvb][4 * q4 + 1] * sc * s4[1] * bfhi(g[0])),
                    pack2(o[dvb][4 * q4 + 2] * sc * s4[2] * bflo(g[1]), o[dvb][4 * q4 + 3] * sc * s4[3] * bfhi(g[1]))};
        *(u32x2*)(yp + dv) = ov;
      }
  }
}

DI void phase_mixers(const Params& P, int L, const Group& G, int* ctr, char* lds, int* s_item, int mode = 0) {
  const int nscan = mode == 2 ? 0 : G.B * 16;
  const int nattn = mode == 1 ? 0 : G.B * 4 * (G.S >> 7);
  const int total = nscan + nattn;
  for (;;) {
    __syncthreads();
    if (threadIdx.x == 0) *s_item = atomicAdd(ctr, 1);
    __syncthreads();
    const int it = *s_item;
    if (it >= total) break;
    if (it < nscan) scan_task(P, L, G, it, lds);
    else attn_item(P, L, G, it - nscan, lds);
  }
}

__global__ void __launch_bounds__(NTHREADS) fwd_megakernel(Params P) {
  __shared__ __attribute__((aligned(16))) char lds[LDS_BYTES];
  __shared__ int s_item;
  cg::grid_group grid = cg::this_grid();
  phase_weights(P, lds);
  for (int ph = 0; ph < 18; ++ph) {
    const int L = ph / 9, k = ph % 9;
    const int g = (k >= 4 && k <= 6) ? 1 : 0;
    Group G;
    G.tok0 = g ? NP : 0; G.B = g ? 8 : 16; G.S = g ? 8192 : 2048; G.ntok = g ? NS : NP;
#ifdef PROBE_SCAN
    if (k == 2 || k == 5) { phase_mixers(P, L, G, P.ctr + 64 + (L * 2 + g) * 16, lds, &s_item, 1); grid.sync(); }
#endif
#ifdef PROBE_ATTN
    if (k == 2 || k == 5) { phase_mixers(P, L, G, P.ctr + 128 + (L * 2 + g) * 16, lds, &s_item, 2); grid.sync(); }
#endif
#ifdef PROBE_INPROJ
    if (k == 1 || k == 4) { phase_inproj(P, L, G, lds); grid.sync(); }
#endif
    if (k == 0) phase_prep(P, L);
    else if (k == 1 || k == 4) phase_inproj(P, L, G, lds);
    else if (k == 2 || k == 5) phase_mixers(P, L, G, P.ctr + (L * 2 + g) * 16, lds, &s_item);
    else if (k == 3 || k == 6) phase_rwkv_final(P, L, G);
    else if (k == 7) phase_outproj(P, L, lds);
    else phase_gate(P, L, lds);
    grid.sync();
  }
}

extern "C" void kernel_launch(void* const* d_in, const int* in_sizes, int n_in, void* d_out, int out_size, void* d_ws,
                              size_t ws_size, hipStream_t stream) {
  Params P{};
  const float* const* in = (const float* const*)d_in;
  P.x_prompt = in[0]; P.x_sample = in[1]; P.p_prompt = in[2]; P.p_sample = in[3];
  P.norm_pre = in[4]; P.w_in = in[5]; P.w_out = in[6]; P.conv_w = in[7]; P.conv_b = in[8];
  P.w0 = in[9]; P.w_up = in[10]; P.a0 = in[11]; P.a_up = in[12]; P.k_k = in[13]; P.k_a = in[14];
  P.r_k = in[15]; P.ln_g = in[16]; P.ln_b = in[17]; P.q_norm = in[18]; P.k_norm = in[19];
  P.lam_vec = in[20]; P.subln = in[21]; P.ple_proj = in[22]; P.ple_norm = in[23];
  P.gate_w = in[24]; P.gate_b = in[25];
  P.out = (float*)d_out;
  char* ws = (char*)d_ws;
  size_t off = 0;
  auto take = [&](size_t bytes) { char* p = ws + off; off += (bytes + 255) & ~(size_t)255; return p; };
  P.ctr = (int*)take(1024);
  P.consts = (float*)take(1024);
  P.X = (bf16_t*)take((size_t)NTOK * DM * 2);
  P.PB = (bf16_t*)take((size_t)NTOK * DPLE * 2);
  P.RS = (float*)take((size_t)NTOK * 4);
  P.WIN = (bf16_t*)take((size_t)2 * NIN * DM * 2);
  P.WOUT = (bf16_t*)take((size_t)2 * DM * DM * 2);
  P.WPLE = (bf16_t*)take((size_t)2 * DM * DPLE * 2);
  P.WGATE = (bf16_t*)take((size_t)2 * DM * DM * 2);
  P.WUPT = (bf16_t*)take((size_t)4 * 512 * 64 * 2);
  P.AUPT = (bf16_t*)take((size_t)2 * 512 * 64 * 2);
  P.CR = (bf16_t*)take((size_t)GS * CRW * 2);
  P.GRW = (bf16_t*)take((size_t)GS * 512 * 2);
  P.Q = (bf16_t*)take((size_t)GS * 512 * 2);
  P.KB = (bf16_t*)take((size_t)GS * 512 * 2);
  P.VT = (bf16_t*)take((size_t)GS * 512 * 2);
  P.GDA = (bf16_t*)take((size_t)GS * 512 * 2);
  P.YB = (bf16_t*)take((size_t)GS * 512 * 2);
  P.BV = (bf16_t*)take((size_t)GS * 512 * 2);
  P.R1 = P.CR;
  P.R2 = P.GRW;
  P.EPART = (float*)P.VT;
  if (off > ws_size) { fprintf(stderr, "workspace too small: need %zu have %zu\n", off, ws_size); return; }
  hipMemsetAsync(P.ctr, 0, 1024, stream);
  static int grid_blocks = 0;
  if (!grid_blocks) {
    int dev = 0, cus = 0, per_cu = 0;
    hipGetDevice(&dev);
    hipDeviceGetAttribute(&cus, hipDeviceAttributeMultiprocessorCount, dev);
    hipOccupancyMaxActiveBlocksPerMultiprocessor(&per_cu, fwd_megakernel, NTHREADS, 0);
    if (per_cu < 1) { fprintf(stderr, "occupancy query returned %d\n", per_cu); per_cu = 1; }
    grid_blocks = 256;
    if (cus < 256) fprintf(stderr, "unexpected CU count %d\n", cus);
  }
  void* args[] = {&P};
  hipError_t e = hipLaunchCooperativeKernel((void*)fwd_megakernel, dim3(grid_blocks), dim3(NTHREADS), args, 0, stream);
  if (e != hipSuccess) fprintf(stderr, "cooperative launch failed: %s (grid %d)\n", hipGetErrorString(e), grid_blocks);
}
```

```cpp
#include <hip/hip_runtime.h>
#include <hip/hip_cooperative_groups.h>
#include <cstdio>
namespace cg = cooperative_groups;

#define DI __device__ __forceinline__
typedef __attribute__((ext_vector_type(8))) short bf16x8;
typedef __attribute__((ext_vector_type(16))) float f32x16;
typedef __attribute__((ext_vector_type(4))) float f32x4;
typedef __attribute__((ext_vector_type(2))) float f32x2;
typedef __attribute__((ext_vector_type(4))) unsigned u32x4;
typedef __attribute__((ext_vector_type(2))) unsigned u32x2;
typedef unsigned short bf16_t;
#define MFMA(a, b, c) __builtin_amdgcn_mfma_f32_32x32x16_bf16((a), (b), (c), 0, 0, 0)

constexpr int DM = 1024;
constexpr int NP = 16 * 2048;
constexpr int NS = 8 * 8192;
constexpr int NTOK = NP + NS;
constexpr int DPLE = 256;
constexpr int IN_COLS = 4288;
constexpr int NIN = 4352;
constexpr int CRW = 1792;
constexpr int GS = NS;
constexpr float LOG2E = 1.4426950408889634f;
constexpr int NTHREADS = 512;
constexpr int LDS_BYTES = 147456;

struct Params {
  const float* x_prompt; const float* x_sample; const float* p_prompt; const float* p_sample;
  const float* norm_pre; const float* w_in; const float* w_out; const float* conv_w; const float* conv_b;
  const float* w0; const float* w_up; const float* a0; const float* a_up; const float* k_k; const float* k_a;
  const float* r_k; const float* ln_g; const float* ln_b; const float* q_norm; const float* k_norm;
  const float* lam_vec; const float* subln; const float* ple_proj; const float* ple_norm;
  const float* gate_w; const float* gate_b;
  float* out;
  bf16_t* X; bf16_t* PB; float* RS;
  bf16_t* CR; bf16_t* GRW; bf16_t* Q; bf16_t* KB; bf16_t* VT; bf16_t* GDA;
  bf16_t* R1; bf16_t* R2; float* EPART; bf16_t* YB; bf16_t* BV;
  bf16_t* WIN; bf16_t* WOUT; bf16_t* WPLE; bf16_t* WGATE; bf16_t* WUPT; bf16_t* AUPT;
  float* consts; int* ctr;
};

struct Group { int tok0, B, S, ntok; };

DI unsigned pack2(float a, float b) {
  typedef __attribute__((ext_vector_type(2))) __bf16 bf2;
  f32x2 v = {a, b};
  bf2 r = __builtin_convertvector(v, bf2);
  return __builtin_bit_cast(unsigned, r);
}
DI bf16_t f2bf(float a) { return (bf16_t)(pack2(a, 0.f) & 0xffffu); }
DI float bf2f(unsigned short u) { return __uint_as_float(((unsigned)u) << 16); }
DI float bflo(unsigned u) { return __uint_as_float(u << 16); }
DI float bfhi(unsigned u) { return __uint_as_float(u & 0xffff0000u); }
template <int CTRL> DI float dppf(float x) {
  return __int_as_float(__builtin_amdgcn_update_dpp(0, __float_as_int(x), CTRL, 0xF, 0xF, true));
}
DI float red4(float x) { x += dppf<0xB1>(x); x += dppf<0x4E>(x); return x; }
DI float red8(float x) { x = red4(x); x += dppf<0x141>(x); return x; }
DI float red32(float x) {
  x += __shfl_xor(x, 1); x += __shfl_xor(x, 2); x += __shfl_xor(x, 4); x += __shfl_xor(x, 8); x += __shfl_xor(x, 16);
  return x;
}
DI float sigmoidf_(float x) { return __builtin_amdgcn_rcpf(1.f + __expf(-x)); }
DI float siluf_(float x) { return x * __builtin_amdgcn_rcpf(1.f + __expf(-x)); }
DI float tanhf_(float x) { return 1.f - 2.f * __builtin_amdgcn_rcpf(1.f + __expf(2.f * x)); }
DI int opq(int x) { asm volatile("" : "+v"(x)); return x; }
DI int opqs(int x) { asm volatile("" : "+s"(x)); return x; }
DI int crow(int i, int h) { return (i & 3) + 8 * (i >> 2) + 4 * h; }

DI void transpose_convert(const float* __restrict__ src, int K, int N, bf16_t* __restrict__ dst, int Nd, int mode,
                          const float* __restrict__ rowscale, float* lds) {
  const int tid = opq(threadIdx.x);
  const int tk = K >> 6, tn = Nd >> 6;
  for (int t = blockIdx.x; t < tk * tn; t += gridDim.x) {
    const int k0 = (t % tk) << 6, n0 = (t / tk) << 6;
    int sn0 = n0;
    if (mode == 1) sn0 = (n0 < 1728) ? n0 : (n0 < 1792 ? -1 : n0 - 64);
    __syncthreads();
#pragma unroll
    for (int it = 0; it < 2; ++it) {
      const int kk = (tid >> 4) + 32 * it, n4 = (tid & 15) * 4;
      f32x4 v = {0.f, 0.f, 0.f, 0.f};
      if (sn0 >= 0) v = *(const f32x4*)(src + (size_t)(k0 + kk) * N + sn0 + n4);
      const float sc = rowscale ? rowscale[k0 + kk] : 1.f;
      lds[kk * 65 + n4 + 0] = v[0] * sc; lds[kk * 65 + n4 + 1] = v[1] * sc;
      lds[kk * 65 + n4 + 2] = v[2] * sc; lds[kk * 65 + n4 + 3] = v[3] * sc;
    }
    __syncthreads();
    const int nn = tid >> 3, k8 = (tid & 7) * 8;
    u32x4 o;
    o[0] = pack2(lds[(k8 + 0) * 65 + nn], lds[(k8 + 1) * 65 + nn]);
    o[1] = pack2(lds[(k8 + 2) * 65 + nn], lds[(k8 + 3) * 65 + nn]);
    o[2] = pack2(lds[(k8 + 4) * 65 + nn], lds[(k8 + 5) * 65 + nn]);
    o[3] = pack2(lds[(k8 + 6) * 65 + nn], lds[(k8 + 7) * 65 + nn]);
    *(u32x4*)(dst + (size_t)(n0 + nn) * K + k0 + k8) = o;
  }
}

DI void phase_weights(const Params& P, char* lds) {
  float* l = (float*)lds;
  for (int L = 0; L < 2; ++L) {
    transpose_convert(P.w_in + (size_t)L * DM * IN_COLS, DM, IN_COLS, P.WIN + (size_t)L * NIN * DM, NIN, 1, P.norm_pre + L * DM, l);
    transpose_convert(P.w_out + (size_t)L * DM * DM, DM, DM, P.WOUT + (size_t)L * DM * DM, DM, 0, nullptr, l);
    transpose_convert(P.ple_proj + (size_t)L * DPLE * DM, DPLE, DM, P.WPLE + (size_t)L * DM * DPLE, DM, 0, nullptr, l);
    transpose_convert(P.gate_w + (size_t)L * DM * DM, DM, DM, P.WGATE + (size_t)L * DM * DM, DM, 0, nullptr, l);
    for (int d = 0; d < 2; ++d)
      transpose_convert(P.w_up + (size_t)(L * 2 + d) * 64 * 512, 64, 512, P.WUPT + (size_t)(L * 2 + d) * 512 * 64, 512, 0, nullptr, l);
    transpose_convert(P.a_up + (size_t)L * 64 * 512, 64, 512, P.AUPT + (size_t)L * 512 * 64, 512, 0, nullptr, l);
  }
  if (blockIdx.x == 0 && threadIdx.x < 128) {
    const int L = threadIdx.x >> 6, lane = threadIdx.x & 63;
    const float* lv = P.lam_vec + L * 256;
    float s01 = lv[lane] * lv[64 + lane], s23 = lv[128 + lane] * lv[192 + lane];
    float mq = fmaxf(fabsf(P.q_norm[L * 128 + lane]), fabsf(P.q_norm[L * 128 + 64 + lane]));
    float mk = fmaxf(fabsf(P.k_norm[L * 128 + lane]), fabsf(P.k_norm[L * 128 + 64 + lane]));
    for (int o = 32; o >= 1; o >>= 1) {
      s01 += __shfl_xor(s01, o); s23 += __shfl_xor(s23, o);
      mq = fmaxf(mq, __shfl_xor(mq, o)); mk = fmaxf(mk, __shfl_xor(mk, o));
    }
    if (lane == 0) {
      const float lam_init = 0.8f - 0.6f * expf(-0.3f * (float)L);
      P.consts[L * 4 + 0] = expf(s01) - expf(s23) + lam_init;
      P.consts[L * 4 + 1] = 8.25f * mq * mk * LOG2E;
      P.consts[L * 4 + 2] = lam_init;
    }
  }
}

DI void phase_prep(const Params& P, int L) {
  const float* h0 = L == 0 ? P.x_prompt : P.out;
  const float* h1 = L == 0 ? P.x_sample : P.out + (size_t)NP * DM;
  const float* p0 = P.p_prompt + (size_t)L * NP * DPLE;
  const float* p1 = P.p_sample + (size_t)L * NS * DPLE;
  const int tidp = opq(threadIdx.x);
  const int lane = tidp & 63;
  const int gw = blockIdx.x * (NTHREADS / 64) + (tidp >> 6), nw = gridDim.x * (NTHREADS / 64);
  for (int tok = gw; tok < NTOK; tok += nw) {
    const float* hr = tok < NP ? h0 + (size_t)tok * DM : h1 + (size_t)(tok - NP) * DM;
    float ss = 0.f;
#pragma unroll
    for (int i = 0; i < 4; ++i) {
      f32x4 v = *(const f32x4*)(hr + i * 256 + lane * 4);
      ss += v[0] * v[0] + v[1] * v[1] + v[2] * v[2] + v[3] * v[3];
      u32x2 o = {pack2(v[0], v[1]), pack2(v[2], v[3])};
      *(u32x2*)(P.X + (size_t)tok * DM + i * 256 + lane * 4) = o;
    }
    for (int o = 32; o >= 1; o >>= 1) ss += __shfl_xor(ss, o);
    if (lane == 0) P.RS[tok] = rsqrtf(ss * (1.f / DM) + 1e-6f);
    const float* pr = tok < NP ? p0 + (size_t)tok * DPLE : p1 + (size_t)(tok - NP) * DPLE;
    f32x4 v = *(const f32x4*)(pr + lane * 4);
    u32x2 o = {pack2(v[0], v[1]), pack2(v[2], v[3])};
    *(u32x2*)(P.PB + (size_t)tok * DPLE + lane * 4) = o;
  }
}

constexpr int GSTR = 144;
constexpr int GA_BYTES = 256 * GSTR;
constexpr int GSTAGE = 2 * GA_BYTES;

DI void gemm_mainloop(const bf16_t* __restrict__ A, int lda, const bf16_t* __restrict__ Bw, int ldb, int K,
                      int m0, int n0, char* lds, f32x16 (&acc)[2][4]) {
  const int tid = opq(threadIdx.x), lane = tid & 63, w = tid >> 6, hh = lane >> 5, r = lane & 31;
  const int wm = w >> 1, wn = w & 1;
#pragma unroll
  for (int mi = 0; mi < 2; ++mi)
#pragma unroll
    for (int ni = 0; ni < 4; ++ni)
#pragma unroll
      for (int i = 0; i < 16; ++i) acc[mi][ni][i] = 0.f;
  const int lrow = tid >> 3, lkc = tid & 7;
  const bf16_t* ap = A + (size_t)(m0 + lrow) * lda + lkc * 8;
  const bf16_t* bp = Bw + (size_t)(n0 + lrow) * ldb + lkc * 8;
  const int nk = K >> 6;
  u32x4 ra[4], rb[4];
#pragma unroll
  for (int i = 0; i < 4; ++i) {
    ra[i] = *(const u32x4*)(ap + (size_t)(64 * i) * lda);
    rb[i] = *(const u32x4*)(bp + (size_t)(64 * i) * ldb);
  }
  __syncthreads();
#pragma unroll
  for (int i = 0; i < 4; ++i) {
    *(u32x4*)(lds + (lrow + 64 * i) * GSTR + lkc * 16) = ra[i];
    *(u32x4*)(lds + GA_BYTES + (lrow + 64 * i) * GSTR + lkc * 16) = rb[i];
  }
  __syncthreads();
  for (int kt = 0; kt < nk; ++kt) {
    const bool more = kt + 1 < nk;
    if (more) {
#pragma unroll
      for (int i = 0; i < 4; ++i) {
        ra[i] = *(const u32x4*)(ap + (size_t)(64 * i) * lda + (kt + 1) * 64);
        rb[i] = *(const u32x4*)(bp + (size_t)(64 * i) * ldb + (kt + 1) * 64);
      }
    }
    __builtin_amdgcn_sched_barrier(0);
    const char* sa = lds + (kt & 1) * GSTAGE + (wm * 64 + r) * GSTR + hh * 16;
    const char* sb = lds + (kt & 1) * GSTAGE + GA_BYTES + (wn * 128 + r) * GSTR + hh * 16;
    bf16x8 fa[2][2], fb[2][4];
#pragma unroll
    for (int mi = 0; mi < 2; ++mi) fa[0][mi] = *(const bf16x8*)(sa + mi * 32 * GSTR);
#pragma unroll
    for (int ni = 0; ni < 4; ++ni) fb[0][ni] = *(const bf16x8*)(sb + ni * 32 * GSTR);
#pragma unroll
    for (int ks = 0; ks < 4; ++ks) {
      if (ks < 3) {
#pragma unroll
        for (int mi = 0; mi < 2; ++mi) fa[(ks + 1) & 1][mi] = *(const bf16x8*)(sa + mi * 32 * GSTR + (ks + 1) * 32);
#pragma unroll
        for (int ni = 0; ni < 4; ++ni) fb[(ks + 1) & 1][ni] = *(const bf16x8*)(sb + ni * 32 * GSTR + (ks + 1) * 32);
      }
      __builtin_amdgcn_sched_barrier(0);
#pragma unroll
      for (int mi = 0; mi < 2; ++mi)
#pragma unroll
        for (int ni = 0; ni < 4; ++ni) acc[mi][ni] = MFMA(fb[ks & 1][ni], fa[ks & 1][mi], acc[mi][ni]);
      __builtin_amdgcn_sched_barrier(0);
    }
    if (more) {
      char* d = lds + ((kt + 1) & 1) * GSTAGE;
#pragma unroll
      for (int i = 0; i < 4; ++i) {
        *(u32x4*)(d + (lrow + 64 * i) * GSTR + lkc * 16) = ra[i];
        *(u32x4*)(d + GA_BYTES + (lrow + 64 * i) * GSTR + lkc * 16) = rb[i];
      }
    }
    __syncthreads();
  }
}

DI bool xcd_tile(int rd, int nM, int nN, int& mt, int& nt) {
  const int xcd = blockIdx.x & 7, j = blockIdx.x >> 3;
  const int u = (rd * 8 + xcd) * 32 + j;
  if (u >= nM * nN) return false;
  const int band = u / (8 * nN), rem = u % (8 * nN);
  nt = rem >> 3; mt = band * 8 + (rem & 7);
  return true;
}

DI void phase_inproj(const Params& P, int L, const Group& G, char* lds) {
  const int tid = opq(threadIdx.x), lane = tid & 63, w = tid >> 6, hh = lane >> 5, r = lane & 31;
  const int wm = w >> 1, wn = w & 1;
  const int nmt = G.ntok >> 8, ntile = nmt * 17;
  const bf16_t* A = P.X + (size_t)G.tok0 * DM;
  const bf16_t* Bw = P.WIN + (size_t)L * NIN * DM;
  for (int rd = 0; rd * 256 < ntile; ++rd) {
    int mt, nt;
    if (!xcd_tile(rd, nmt, 17, mt, nt)) continue;
    const int m0 = mt << 8, n0 = nt << 8;
    f32x16 acc[2][4];
    gemm_mainloop(A, DM, Bw, DM, DM, m0, n0, lds, acc);
    const int colw = n0 + wn * 128 + 4 * hh;
    if (nt < 7) {
#pragma unroll
      for (int mi = 0; mi < 2; ++mi) {
        const int row = m0 + wm * 64 + mi * 32 + r;
        const float rsv = P.RS[G.tok0 + row];
        bf16_t* dst = P.CR + (size_t)row * CRW + colw;
#pragma unroll
        for (int ni = 0; ni < 4; ++ni)
#pragma unroll
          for (int q4 = 0; q4 < 4; ++q4) {
            u32x2 o = {pack2(acc[mi][ni][4 * q4] * rsv, acc[mi][ni][4 * q4 + 1] * rsv),
                       pack2(acc[mi][ni][4 * q4 + 2] * rsv, acc[mi][ni][4 * q4 + 3] * rsv)};
            *(u32x2*)(dst + ni * 32 + q4 * 8) = o;
          }
      }
    } else if (nt < 9 || nt >= 15) {
      bf16_t* dbase = nt < 9 ? P.GRW : P.GDA;
      const int c0 = colw - (nt < 9 ? 1792 : 3840);
#pragma unroll
      for (int mi = 0; mi < 2; ++mi) {
        const int row = m0 + wm * 64 + mi * 32 + r;
        const float rsv = P.RS[G.tok0 + row];
        bf16_t* dst = dbase + (size_t)row * 512 + c0;
#pragma unroll
        for (int ni = 0; ni < 4; ++ni)
#pragma unroll
          for (int q4 = 0; q4 < 4; ++q4) {
            u32x2 o = {pack2(siluf_(acc[mi][ni][4 * q4] * rsv), siluf_(acc[mi][ni][4 * q4 + 1] * rsv)),
                       pack2(siluf_(acc[mi][ni][4 * q4 + 2] * rsv), siluf_(acc[mi][ni][4 * q4 + 3] * rsv))};
            *(u32x2*)(dst + ni * 32 + q4 * 8) = o;
          }
      }
    } else if (nt < 13) {
      const bool isq = nt < 11;
      bf16_t* dbase = isq ? P.Q : P.KB;
      const int c0 = colw - (isq ? 2304 : 2816);
      const float* g = (isq ? P.q_norm : P.k_norm) + L * 128 + 4 * hh;
      const float osc = isq ? 0.125f * LOG2E : 1.f;
#pragma unroll
      for (int mi = 0; mi < 2; ++mi) {
        const int row = m0 + wm * 64 + mi * 32 + r;
        const float rsv = P.RS[G.tok0 + row];
        bf16_t* dst = dbase + (size_t)row * 512 + c0;
#pragma unroll
        for (int gi = 0; gi < 2; ++gi) {
          float ss = 0.f;
#pragma unroll
          for (int t2 = 0; t2 < 2; ++t2)
#pragma unroll
            for (int i = 0; i < 16; ++i) { const float v = acc[mi][2 * gi + t2][i] * rsv; ss += v * v; }
          ss += __shfl_xor(ss, 32);
          const float sc = rsqrtf(ss * (1.f / 64.f) + 1e-6f) * rsv * osc;
#pragma unroll
          for (int t2 = 0; t2 < 2; ++t2)
#pragma unroll
            for (int q4 = 0; q4 < 4; ++q4) {
              const f32x4 gv = *(const f32x4*)(g + gi * 64 + t2 * 32 + q4 * 8);
              u32x2 o = {pack2(acc[mi][2 * gi + t2][4 * q4] * sc * gv[0], acc[mi][2 * gi + t2][4 * q4 + 1] * sc * gv[1]),
                         pack2(acc[mi][2 * gi + t2][4 * q4 + 2] * sc * gv[2], acc[mi][2 * gi + t2][4 * q4 + 3] * sc * gv[3])};
              *(u32x2*)(dst + (2 * gi + t2) * 32 + q4 * 8) = o;
            }
        }
      }
    } else {
      const int hd = (n0 + wn * 128 - 3328) >> 7;
      const int row0 = m0 + wm * 64;
      const int b = row0 / G.S, s0 = row0 % G.S;
#pragma unroll
      for (int mi = 0; mi < 2; ++mi) {
        const int s = s0 + mi * 32 + r;
        const float rsv = P.RS[G.tok0 + b * G.S + s];
        bf16_t* dst = P.VT + ((size_t)((b * 4 + hd) * 128 + 4 * hh)) * G.S + s;
        const size_t Sz = (size_t)G.S;
#pragma unroll
        for (int ni = 0; ni < 4; ++ni)
#pragma unroll
          for (int q4 = 0; q4 < 4; ++q4) {
            bf16_t* pq = dst + (size_t)(ni * 32 + 8 * q4) * Sz;
            pq[0] = f2bf(acc[mi][ni][4 * q4] * rsv);
            pq[Sz] = f2bf(acc[mi][ni][4 * q4 + 1] * rsv);
            pq[2 * Sz] = f2bf(acc[mi][ni][4 * q4 + 2] * rsv);
            pq[3 * Sz] = f2bf(acc[mi][ni][4 * q4 + 3] * rsv);
            __builtin_amdgcn_sched_barrier(0);
          }
      }
    }
  }
}

DI void phase_outproj(const Params& P, int L, char* lds) {
  const int tid = opq(threadIdx.x), lane = tid & 63, w = tid >> 6, hh = lane >> 5, r = lane & 31;
  const int wm = w >> 1, wn = w & 1;
  const float* h0 = L == 0 ? P.x_prompt : P.out;
  const float* h1 = L == 0 ? P.x_sample : P.out + (size_t)NP * DM;
  const int nmt = NTOK >> 8, ntile = nmt * 4;
  for (int rd2 = 0; rd2 * 256 < 2 * ntile; ++rd2) {
    const bool isE = rd2 * 256 >= ntile;
    int mt, nt;
    if (!xcd_tile(isE ? rd2 - ntile / 256 : rd2, nmt, 4, mt, nt)) continue;
    const int m0 = mt << 8, n0 = nt << 8;
    const int colw = n0 + wn * 128 + 4 * hh;
    f32x16 acc[2][4];
    if (!isE) {
      gemm_mainloop(P.X, DM, P.WOUT + (size_t)L * DM * DM, DM, DM, m0, n0, lds, acc);
#pragma unroll
      for (int mi = 0; mi < 2; ++mi) {
        const int row = m0 + wm * 64 + mi * 32 + r;
        const float* hr = (row < NP ? h0 + (size_t)row * DM : h1 + (size_t)(row - NP) * DM) + colw;
        float* op = P.out + (size_t)row * DM + colw;
        bf16_t* rp = P.R1 + (size_t)row * DM + colw;
#pragma unroll
        for (int ni = 0; ni < 4; ++ni)
#pragma unroll
          for (int q4 = 0; q4 < 4; ++q4) {
            f32x4 hv = *(const f32x4*)(hr + ni * 32 + q4 * 8);
            hv[0] += acc[mi][ni][4 * q4]; hv[1] += acc[mi][ni][4 * q4 + 1];
            hv[2] += acc[mi][ni][4 * q4 + 2]; hv[3] += acc[mi][ni][4 * q4 + 3];
            *(f32x4*)(op + ni * 32 + q4 * 8) = hv;
            u32x2 o = {pack2(hv[0], hv[1]), pack2(hv[2], hv[3])};
            *(u32x2*)(rp + ni * 32 + q4 * 8) = o;
          }
      }
    } else {
      gemm_mainloop(P.PB, DPLE, P.WPLE + (size_t)L * DM * DPLE, DPLE, DPLE, m0, n0, lds, acc);
#pragma unroll
      for (int mi = 0; mi < 2; ++mi) {
        const int row = m0 + wm * 64 + mi * 32 + r;
        bf16_t* rp = P.R2 + (size_t)row * DM + colw;
        float ss = 0.f;
#pragma unroll
        for (int ni = 0; ni < 4; ++ni)
#pragma unroll
          for (int q4 = 0; q4 < 4; ++q4) {
            const float v0 = acc[mi][ni][4 * q4], v1 = acc[mi][ni][4 * q4 + 1], v2 = acc[mi][ni][4 * q4 + 2], v3 = acc[mi][ni][4 * q4 + 3];
            ss += v0 * v0 + v1 * v1 + v2 * v2 + v3 * v3;
            u32x2 o = {pack2(v0, v1), pack2(v2, v3)};
            *(u32x2*)(rp + ni * 32 + q4 * 8) = o;
          }
        ss += __shfl_xor(ss, 32);
        if (hh == 0) P.EPART[(size_t)(nt * 2 + wn) * NTOK + row] = ss;
      }
    }
  }
}

DI void phase_gate(const Params& P, int L, char* lds) {
  const int tid = opq(threadIdx.x), lane = tid & 63, w = tid >> 6, hh = lane >> 5, r = lane & 31;
  const int wm = w >> 1, wn = w & 1;
  const int nmt = NTOK >> 8, ntile = nmt * 4;
  for (int rd = 0; rd * 256 < ntile; ++rd) {
    int mt, nt;
    if (!xcd_tile(rd, nmt, 4, mt, nt)) continue;
    const int m0 = mt << 8, n0 = nt << 8;
    const int colw = n0 + wn * 128 + 4 * hh;
    f32x16 acc[2][4];
    gemm_mainloop(P.R1, DM, P.WGATE + (size_t)L * DM * DM, DM, DM, m0, n0, lds, acc);
    const float* gbp = P.gate_b + L * DM + colw;
    const float* pnp = P.ple_norm + L * DM + colw;
#pragma unroll
    for (int mi = 0; mi < 2; ++mi) {
      const int row = m0 + wm * 64 + mi * 32 + r;
      float es = 0.f;
#pragma unroll
      for (int j = 0; j < 8; ++j) es += P.EPART[(size_t)j * NTOK + row];
      const float rse = rsqrtf(es * (1.f / DM) + 1e-6f);
      float* op = P.out + (size_t)row * DM + colw;
      const bf16_t* ep = P.R2 + (size_t)row * DM + colw;
#pragma unroll
      for (int ni = 0; ni < 4; ++ni)
#pragma unroll
        for (int q4 = 0; q4 < 4; ++q4) {
          const int co = ni * 32 + q4 * 8;
          const f32x4 gb = *(const f32x4*)(gbp + co), pn = *(const f32x4*)(pnp + co);
          const u32x2 ev = *(const u32x2*)(ep + co);
          f32x4 hv = *(const f32x4*)(op + co);
          hv[0] += sigmoidf_(acc[mi][ni][4 * q4] + gb[0]) * (bflo(ev[0]) * rse * pn[0]);
          hv[1] += sigmoidf_(acc[mi][ni][4 * q4 + 1] + gb[1]) * (bfhi(ev[0]) * rse * pn[1]);
          hv[2] += sigmoidf_(acc[mi][ni][4 * q4 + 2] + gb[2]) * (bflo(ev[1]) * rse * pn[2]);
          hv[3] += sigmoidf_(acc[mi][ni][4 * q4 + 3] + gb[3]) * (bfhi(ev[1]) * rse * pn[3]);
          *(f32x4*)(op + co) = hv;
        }
    }
  }
}

constexpr int TC = 32;
constexpr int CB_OP = TC * 64 * 4;
constexpr int CB_BYTES = 6 * CB_OP + 128;
constexpr int PW_BYTES = 10 * 640 + 2 * 8 * 144;
constexpr int PW_BASE = 2 * CB_BYTES;

template <int N> DI void red64v(float (&x)[N]) {
#pragma unroll
  for (int i = 0; i < N; ++i) x[i] += dppf<0xB1>(x[i]);
#pragma unroll
  for (int i = 0; i < N; ++i) x[i] += dppf<0x4E>(x[i]);
#pragma unroll
  for (int i = 0; i < N; ++i) x[i] += dppf<0x141>(x[i]);
#pragma unroll
  for (int i = 0; i < N; ++i) x[i] += dppf<0x140>(x[i]);
#pragma unroll
  for (int i = 0; i < N; ++i) x[i] += __shfl_xor(x[i], 16);
#pragma unroll
  for (int i = 0; i < N; ++i) x[i] += __shfl_xor(x[i], 32);
}

struct ScanOps { f32x4 w0, w1, a0, a1, b0, b1, k0, k1, r0, r1; f32x2 v; };

DI ScanOps scan_load(const float* __restrict__ ob, int s, int coff, int row0) {
  ScanOps o;
  const float* p = ob + s * 64 + coff;
  o.w0 = *(const f32x4*)(p);                 o.w1 = *(const f32x4*)(p + 4);
  o.a0 = *(const f32x4*)(p + TC * 64);       o.a1 = *(const f32x4*)(p + TC * 64 + 4);
  o.b0 = *(const f32x4*)(p + 2 * TC * 64);   o.b1 = *(const f32x4*)(p + 2 * TC * 64 + 4);
  o.k0 = *(const f32x4*)(p + 3 * TC * 64);   o.k1 = *(const f32x4*)(p + 3 * TC * 64 + 4);
  o.r0 = *(const f32x4*)(p + 4 * TC * 64);   o.r1 = *(const f32x4*)(p + 4 * TC * 64 + 4);
  o.v = *(const f32x2*)(ob + 5 * TC * 64 + s * 64 + row0);
  return o;
}

DI f32x2 lo2(f32x4 x) { return f32x2{x[0], x[1]}; }
DI f32x2 hi2(f32x4 x) { return f32x2{x[2], x[3]}; }

DI f32x2 scan_step(f32x2 (&st)[2][4], const ScanOps& o) {
  const f32x2 a[4] = {lo2(o.a0), hi2(o.a0), lo2(o.a1), hi2(o.a1)};
  const f32x2 wv[4] = {lo2(o.w0), hi2(o.w0), lo2(o.w1), hi2(o.w1)};
  const f32x2 bv[4] = {lo2(o.b0), hi2(o.b0), lo2(o.b1), hi2(o.b1)};
  const f32x2 kv[4] = {lo2(o.k0), hi2(o.k0), lo2(o.k1), hi2(o.k1)};
  const f32x2 rv[4] = {lo2(o.r0), hi2(o.r0), lo2(o.r1), hi2(o.r1)};
  f32x2 y;
#pragma unroll
  for (int rr = 0; rr < 2; ++rr) {
    f32x2 p = st[rr][0] * a[0];
    p = st[rr][1] * a[1] + p; p = st[rr][2] * a[2] + p; p = st[rr][3] * a[3] + p;
    const float sa = red8(p[0] + p[1]);
    const f32x2 sa2 = {sa, sa};
    const f32x2 v2 = {o.v[rr], o.v[rr]};
    f32x2 q = {0.f, 0.f};
#pragma unroll
    for (int j = 0; j < 4; ++j) {
      f32x2 x = st[rr][j] * wv[j];
      x = sa2 * bv[j] + x;
      x = v2 * kv[j] + x;
      st[rr][j] = x;
      q = x * rv[j] + q;
    }
    y[rr] = red8(q[0] + q[1]);
  }
  return y;
}

DI void scan_task(const Params& P, int L_, const Group& G, int task, char* lds) {
  const int L = opqs(__builtin_amdgcn_readfirstlane(L_));
  const int tid = opq(threadIdx.x), lane = tid & 63, w = tid >> 6;
  const int dir = task & 1, b = task >> 4, hd = (task >> 1) & 7;
  const int S = G.S, nc = S / TC;
  const int sg = dir ? -1 : 1;
  const bf16_t* crb = P.CR + (size_t)b * S * CRW;

  const int srow0 = (w & 3) * 16 + (lane >> 3) * 2, scs = lane & 7;
  f32x2 st[2][4];
#pragma unroll
  for (int rr = 0; rr < 2; ++rr)
#pragma unroll
    for (int j = 0; j < 4; ++j) st[rr][j] = f32x2{0.f, 0.f};

  const int pw = w & 3, ec = lane, hh = lane >> 5, r = lane & 31;
  char* pwb = lds + PW_BASE + pw * PW_BYTES;
  const int ch = hd * 64 + ec;
  const float c_kk = P.k_k[L * 512 + ch], c_ka = P.k_a[L * 512 + ch], c_rk = P.r_k[L * 512 + ch];
  const float* cw = P.conv_w + (size_t)L * 3 * 1728;
  const float* cb = P.conv_b + (size_t)L * 1728;
  const bf16_t* wsrcW = P.WUPT + (size_t)(L * 2 + dir) * 512 * 64 + (size_t)(hd * 64 + r) * 64 + hh * 8;
  const bf16_t* wsrcA = P.AUPT + (size_t)L * 512 * 64 + (size_t)(hd * 64 + r) * 64 + hh * 8;
  const float* w0p = P.w0 + (size_t)(L * 2 + dir) * 512 + hd * 64 + r;
  const float* a0p = P.a0 + (size_t)L * 512 + hd * 64 + r;

  auto prepare = [&](int cc, char* cbuf) {
    float* oW = (float*)cbuf; float* oA = (float*)(cbuf + CB_OP); float* oB = (float*)(cbuf + 2 * CB_OP);
    float* oK = (float*)(cbuf + 3 * CB_OP); float* oR = (float*)(cbuf + 4 * CB_OP); float* oV = (float*)(cbuf + 5 * CB_OP);
    float* oBon = (float*)(cbuf + 6 * CB_OP);
    const int ln = opq(lane);
    const int tbase = dir ? S - cc * TC - 8 * pw - 9 : cc * TC + 8 * pw - 1;
    {
      u32x4 rv[7];
#pragma unroll
      for (int it = 0; it < 7; ++it) {
        int id = ln + it * 64;
        id = id < 400 ? id : 399;
        const int rr = id / 40, cc8 = id % 40, q = cc8 >> 3, c8 = (cc8 & 7) * 8;
        const int tok = tbase + rr;
        const bool ok = tok >= 0 && tok < S;
        const int tokc = tok < 0 ? 0 : (tok >= S ? S - 1 : tok);
        const int col = (q == 0 ? hd * 64 : q == 1 ? 512 + hd * 64 : q == 2 ? 1024 + hd * 64 : q == 3 ? 1536 + dir * 64 : 1664) + c8;
        const u32x4 v = *(const u32x4*)(crb + (size_t)tokc * CRW + col);
        const u32x4 z = {0u, 0u, 0u, 0u};
        rv[it] = ok ? v : z;
      }
#pragma unroll
      for (int it = 0; it < 7; ++it) {
        int id = ln + it * 64;
        id = id < 400 ? id : 399;
        *(u32x4*)(pwb + (id / 40) * 640 + (id % 40) * 16) = rv[it];
      }
    }
    asm volatile("" ::: "memory");
    float cwp[5], cwc[5], cwn[5], cbb[5];
#pragma unroll
    for (int q = 0; q < 5; ++q) {
      const int cqq = (q == 0 ? hd * 64 : q == 1 ? 512 + hd * 64 : q == 2 ? 1024 + hd * 64 : q == 3 ? 1536 + dir * 64 : 1664) + ln;
      const float w0 = cw[cqq], w1 = cw[1728 + cqq], w2 = cw[2 * 1728 + cqq];
      cwp[q] = dir ? w2 : w0; cwc[q] = w1; cwn[q] = dir ? w0 : w2; cbb[q] = cb[cqq];
    }
    bf16x8 lf[2][2][4];
#pragma unroll
    for (int nb = 0; nb < 2; ++nb)
#pragma unroll
      for (int ks = 0; ks < 4; ++ks) {
        lf[0][nb][ks] = *(const bf16x8*)(wsrcW + nb * 32 * 64 + ks * 16);
        lf[1][nb][ks] = *(const bf16x8*)(wsrcA + nb * 32 * 64 + ks * 16);
      }
    const bf16_t* raw = (const bf16_t*)pwb;
    bf16_t* zt = (bf16_t*)(pwb + 6400); bf16_t* za = (bf16_t*)(pwb + 6400 + 8 * 144);
    float kreg[8];
#pragma unroll
    for (int hf = 0; hf < 2; ++hf) {
      float xr[6][5];
#pragma unroll
      for (int j = 0; j < 6; ++j) {
        const int vi = hf * 4 + j - 1;
        const int jj = dir ? 8 - vi : vi + 1;
#pragma unroll
        for (int q = 0; q < 5; ++q) xr[j][q] = bf2f(raw[jj * 320 + q * 64 + ln]);
      }
#pragma unroll
      for (int i = 0; i < 4; ++i) {
        float v[5];
#pragma unroll
        for (int q = 0; q < 5; ++q) v[q] = cbb[q] + cwp[q] * xr[i][q] + cwc[q] * xr[i + 1][q] + cwn[q] * xr[i + 2][q];
        const int ti = hf * 4 + i, s = 8 * pw + ti;
        oR[s * 64 + ln] = v[0];
        kreg[ti] = v[1];
        oV[s * 64 + ln] = v[2];
        zt[ti * 72 + ln] = f2bf(tanhf_(v[3]));
        za[ti * 72 + ln] = f2bf(v[4]);
      }
    }
    asm volatile("" ::: "memory");
    {
      const char* az = (const char*)zt + (r & 7) * 144 + hh * 16;
      const char* aa = (const char*)za + (r & 7) * 144 + hh * 16;
#pragma unroll
      for (int nb = 0; nb < 2; ++nb) {
        f32x16 accw, acca;
#pragma unroll
        for (int i = 0; i < 16; ++i) { accw[i] = 0.f; acca[i] = 0.f; }
#pragma unroll
        for (int ks = 0; ks < 4; ++ks) {
          const bf16x8 fz = *(const bf16x8*)(az + ks * 32);
          const bf16x8 fa = *(const bf16x8*)(aa + ks * 32);
          accw = MFMA(fz, lf[0][nb][ks], accw);
          acca = MFMA(fa, lf[1][nb][ks], acca);
        }
        const float w0v = w0p[nb * 32], a0v = a0p[nb * 32];
#pragma unroll
        for (int i = 0; i < 4; ++i) {
          const int s = 8 * pw + 4 * hh + i;
          oW[s * 64 + nb * 32 + r] = __expf(-0.6065306597126334f * sigmoidf_(w0v + accw[i]));
          oA[s * 64 + nb * 32 + r] = sigmoidf_(a0v + acca[i]);
        }
      }
    }
    asm volatile("" ::: "memory");
    {
      float ag[8], kk[8], ss[8], km[8], bn[8];
#pragma unroll
      for (int i = 0; i < 8; ++i) {
        const int s = 8 * pw + i;
        ag[i] = oA[s * 64 + ln];
        kk[i] = kreg[i] * c_kk;
        ss[i] = kk[i] * kk[i];
        km[i] = kreg[i] * (1.f + (ag[i] - 1.f) * c_ka);
        bn[i] = oR[s * 64 + ln] * km[i] * c_rk;
      }
      red64v<8>(ss);
      red64v<8>(bn);
#pragma unroll
      for (int i = 0; i < 8; ++i) {
        const int s = 8 * pw + i;
        const float kn = kk[i] * rsqrtf(ss[i] + 1e-12f);
        oK[s * 64 + ln] = km[i];
        oA[s * 64 + ln] = -kn;
        oB[s * 64 + ln] = kn * ag[i];
        if (ln == 0) oBon[s] = bn[i];
      }
    }
  };

  __syncthreads();
  if (w >= 4) prepare(0, lds);
  __syncthreads();

  for (int c = 0; c < nc; ++c) {
    char* cbuf = lds + (c & 1) * CB_BYTES;
    if (w < 4) {
      const float* sb = (const float*)cbuf;
      const float* oBon = (const float*)(cbuf + 6 * CB_OP);
      ScanOps cur = scan_load(sb, 0, scs * 8, srow0);
#pragma unroll 1
      for (int s8 = 0; s8 < TC; s8 += 8) {
        f32x2 ykeep = {0.f, 0.f};
#pragma unroll
        for (int u = 0; u < 8; ++u) {
          const int s = s8 + u;
          const ScanOps nxt = scan_load(sb, s + 1 < TC ? s + 1 : s, scs * 8, srow0);
          const f32x2 y = scan_step(st, cur);
          if (u == scs) ykeep = y;
          cur = nxt;
        }
        const int s = s8 + scs;
        const int ts = dir ? S - 1 - (c * TC + s) : c * TC + s;
        const size_t lt = (size_t)b * S + ts;
        const unsigned yv = pack2(ykeep[0], ykeep[1]);
        if (dir == 0) {
          *(unsigned*)(P.X + ((size_t)G.tok0 + lt) * DM + hd * 64 + srow0) = yv;
          const float bon = oBon[s];
          const f32x2 vv = *(const f32x2*)(sb + 5 * TC * 64 + s * 64 + srow0);
          *(unsigned*)(P.BV + lt * 512 + hd * 64 + srow0) = pack2(bon * vv[0], bon * vv[1]);
        } else {
          *(unsigned*)(P.YB + lt * 512 + hd * 64 + srow0) = yv;
        }
      }
    } else if (c + 1 < nc) {
      prepare(c + 1, lds + ((c + 1) & 1) * CB_BYTES);
    }
    __syncthreads();
  }
}

DI void phase_rwkv_final(const Params& P, int L, const Group& G) {
  const int tidp = opq(threadIdx.x);
  const int lane = tidp & 63;
  const int gw = blockIdx.x * (NTHREADS / 64) + (tidp >> 6), nw = gridDim.x * (NTHREADS / 64);
  const f32x4 g0 = *(const f32x4*)(P.ln_g + L * 512 + lane * 8), g1 = *(const f32x4*)(P.ln_g + L * 512 + lane * 8 + 4);
  const f32x4 b0 = *(const f32x4*)(P.ln_b + L * 512 + lane * 8), b1 = *(const f32x4*)(P.ln_b + L * 512 + lane * 8 + 4);
  const float lg[8] = {g0[0], g0[1], g0[2], g0[3], g1[0], g1[1], g1[2], g1[3]};
  const float lb[8] = {b0[0], b0[1], b0[2], b0[3], b1[0], b1[1], b1[2], b1[3]};
  for (int lt = gw; lt < G.ntok; lt += nw) {
    bf16_t* xp = P.X + ((size_t)G.tok0 + lt) * DM + lane * 8;
    const u32x4 yf = *(const u32x4*)xp;
    const u32x4 yb = *(const u32x4*)(P.YB + (size_t)lt * 512 + lane * 8);
    const u32x4 bv = *(const u32x4*)(P.BV + (size_t)lt * 512 + lane * 8);
    const u32x4 gt = *(const u32x4*)(P.GRW + (size_t)lt * 512 + lane * 8);
    float y[8];
    float sum = 0.f;
#pragma unroll
    for (int j = 0; j < 4; ++j) {
      y[2 * j] = bflo(yf[j]) + bflo(yb[j]); y[2 * j + 1] = bfhi(yf[j]) + bfhi(yb[j]);
      sum += y[2 * j] + y[2 * j + 1];
    }
    const float mu = red8(sum) * (1.f / 64.f);
    float vs = 0.f;
#pragma unroll
    for (int j = 0; j < 8; ++j) { y[j] -= mu; vs += y[j] * y[j]; }
    const float rstd = rsqrtf(red8(vs) * (1.f / 64.f) + 64e-5f);
    u32x4 o;
#pragma unroll
    for (int j = 0; j < 4; ++j) {
      const float o0 = (y[2 * j] * rstd * lg[2 * j] + lb[2 * j] + bflo(bv[j])) * bflo(gt[j]);
      const float o1 = (y[2 * j + 1] * rstd * lg[2 * j + 1] + lb[2 * j + 1] + bfhi(bv[j])) * bfhi(gt[j]);
      o[j] = pack2(o0, o1);
    }
    *(u32x4*)xp = o;
  }
}

constexpr int AT_K = 64 * GSTR;
constexpr int AT_STAGE = 2 * AT_K + 128 * GSTR;

DI void attn_item(const Params& P, int L_, const Group& G, int item, char* lds) {
  const int L = opqs(__builtin_amdgcn_readfirstlane(L_));
  const int tid = opq(threadIdx.x), lane = tid & 63, w = tid >> 6, hh = lane >> 5, r = lane & 31;
  const int S = G.S, nqb = S >> 7;
  const int qblk = item % nqb, bh = item / nqb, hd = bh & 3, b = bh >> 2;
  const int map = w & 1, qb = w >> 1;
  const int q0 = qblk * 128 + qb * 32;
  const size_t ltq = (size_t)b * S + q0 + r;
  bf16x8 qf[4];
  {
    const bf16_t* qp = P.Q + ltq * 512 + hd * 128 + map * 64 + hh * 8;
#pragma unroll
    for (int ks = 0; ks < 4; ++ks) qf[ks] = *(const bf16x8*)(qp + ks * 16);
  }
  f32x16 o[4];
#pragma unroll
  for (int d = 0; d < 4; ++d)
#pragma unroll
    for (int i = 0; i < 16; ++i) o[d][i] = 0.f;
  f32x16 accl;
#pragma unroll
  for (int i = 0; i < 16; ++i) accl[i] = 0.f;
  const float slope2 = exp2f(-2.f * (float)(hd + 1)) * LOG2E;
  float so[16];
#pragma unroll
  for (int i = 0; i < 16; ++i) so[i] = slope2 * (float)(16 * (i >> 3) + (i & 7));
  bf16x8 ones;
#pragma unroll
  for (int j = 0; j < 8; ++j) ones[j] = (short)0x3F80;
  const float lam = P.consts[L * 4 + 0], C2 = P.consts[L * 4 + 1], lam_init = P.consts[L * 4 + 2];
  const float qposf = (float)(q0 + r);
  const int Dz = (int)ceilf(150.f / slope2);
  const int Q0 = qblk * 128;
  const int tlo = (Q0 - 63 - Dz) < 0 ? 0 : (Q0 - 63 - Dz) / 64 + 1;
  const int thx = min(S >> 6, (Q0 + 127 + Dz + 63) / 64);
  const int nt = thx - tlo;
  const int lrow = tid >> 3, lck = tid & 7;
  const bf16_t* k0p = P.KB + ((size_t)b * S + tlo * 64 + lrow) * 512 + hd * 128 + lck * 8;
  const bf16_t* v0p = P.VT + ((size_t)((b * 4 + hd) * 128 + lrow)) * S + tlo * 64 + lck * 8;
  u32x4 ra0, ra1, ra2, ra3, rb0, rb1, rb2, rb3;
  auto ldtile = [&](int tt, u32x4& x0, u32x4& x1, u32x4& x2, u32x4& x3) {
    const int tc = tt < nt ? tt : nt - 1;
    x0 = *(const u32x4*)(k0p + (size_t)tc * 64 * 512); x1 = *(const u32x4*)(k0p + (size_t)tc * 64 * 512 + 64);
    x2 = *(const u32x4*)(v0p + tc * 64); x3 = *(const u32x4*)(v0p + (size_t)64 * S + tc * 64);
  };
  auto sttile = [&](int slot, const u32x4& x0, const u32x4& x1, const u32x4& x2, const u32x4& x3) {
    char* d = lds + slot * AT_STAGE;
    *(u32x4*)(d + lrow * GSTR + lck * 16) = x0;
    *(u32x4*)(d + AT_K + lrow * GSTR + lck * 16) = x1;
    *(u32x4*)(d + 2 * AT_K + lrow * GSTR + lck * 16) = x2;
    *(u32x4*)(d + 2 * AT_K + (lrow + 64) * GSTR + lck * 16) = x3;
  };
  ldtile(0, ra0, ra1, ra2, ra3);
  ldtile(1, rb0, rb1, rb2, rb3);
  __syncthreads();
  sttile(0, ra0, ra1, ra2, ra3);
  ldtile(2, ra0, ra1, ra2, ra3);
  __syncthreads();
  const int krow = (r & ~12) | ((r & 4) << 1) | ((r & 8) >> 1);
  auto compute = [&](int t) {
    const char* kbuf = lds + (t & 1) * AT_STAGE + map * AT_K;
    const char* vbuf = lds + (t & 1) * AT_STAGE + 2 * AT_K;
    f32x16 s0, s1;
    const int kt0 = (tlo + t) * 64;
    const float base = (float)(kt0 + 8 * hh) - qposf;
    if (kt0 + 63 < q0) {
      const float bl = fmaf(slope2, base, -C2), bl2 = bl + 32.f * slope2;
#pragma unroll
      for (int i = 0; i < 16; ++i) { s0[i] = bl + so[i]; s1[i] = bl2 + so[i]; }
    } else if (kt0 > q0 + 31) {
      const float br = fmaf(-slope2, base, -C2), br2 = br - 32.f * slope2;
#pragma unroll
      for (int i = 0; i < 16; ++i) { s0[i] = br - so[i]; s1[i] = br2 - so[i]; }
    } else {
#pragma unroll
      for (int i = 0; i < 16; ++i) {
        const float d0 = base + (float)(16 * (i >> 3) + (i & 7));
        s0[i] = fmaf(fabsf(d0), -slope2, -C2);
        s1[i] = fmaf(fabsf(d0 + 32.f), -slope2, -C2);
      }
    }
#pragma unroll
    for (int ks = 0; ks < 4; ++ks) {
      const bf16x8 a0 = *(const bf16x8*)(kbuf + krow * GSTR + ks * 32 + hh * 16);
      const bf16x8 a1 = *(const bf16x8*)(kbuf + (32 + krow) * GSTR + ks * 32 + hh * 16);
      s0 = MFMA(a0, qf[ks], s0);
      s1 = MFMA(a1, qf[ks], s1);
    }
    bf16x8 pf[4];
    {
      u32x4 pk[4];
#pragma unroll
      for (int i = 0; i < 16; i += 2) {
        const float e0 = __builtin_amdgcn_exp2f(s0[i]), e1 = __builtin_amdgcn_exp2f(s0[i + 1]);
        const float e2 = __builtin_amdgcn_exp2f(s1[i]), e3 = __builtin_amdgcn_exp2f(s1[i + 1]);
        pk[i >> 3][(i & 7) >> 1] = pack2(e0, e1);
        pk[2 + (i >> 3)][(i & 7) >> 1] = pack2(e2, e3);
      }
#pragma unroll
      for (int j = 0; j < 4; ++j) pf[j] = __builtin_bit_cast(bf16x8, pk[j]);
    }
#pragma unroll
    for (int j = 0; j < 4; ++j) accl = MFMA(ones, pf[j], accl);
#pragma unroll
    for (int dvb = 0; dvb < 4; ++dvb)
#pragma unroll
      for (int j = 0; j < 4; ++j) {
        const bf16x8 va = *(const bf16x8*)(vbuf + (dvb * 32 + r) * GSTR + (16 * j + 8 * hh) * 2);
        o[dvb] = MFMA(va, pf[j], o[dvb]);
      }
  };
  for (int t = 0; t < nt; t += 2) {
    compute(t);
    sttile(1, rb0, rb1, rb2, rb3);
    __builtin_amdgcn_sched_barrier(0);
    ldtile(t + 3, rb0, rb1, rb2, rb3);
    __builtin_amdgcn_sched_barrier(0);
    __syncthreads();
    if (t + 1 >= nt) break;
    compute(t + 1);
    sttile(0, ra0, ra1, ra2, ra3);
    __builtin_amdgcn_sched_barrier(0);
    ldtile(t + 4, ra0, ra1, ra2, ra3);
    __builtin_amdgcn_sched_barrier(0);
    __syncthreads();
  }
  const float linv = 1.f / accl[0];
  float* comb = (float*)lds;
  if (map == 1) {
#pragma unroll
    for (int dvb = 0; dvb < 4; ++dvb)
#pragma unroll
      for (int i = 0; i < 16; ++i) comb[(qb * 64 + dvb * 16 + i) * 64 + lane] = o[dvb][i] * linv;
  }
  __syncthreads();
  if (map == 0) {
    float ss = 0.f;
#pragma unroll
    for (int dvb = 0; dvb < 4; ++dvb)
#pragma unroll
      for (int i = 0; i < 16; ++i) {
        const float v = o[dvb][i] * linv - lam * comb[(qb * 64 + dvb * 16 + i) * 64 + lane];
        o[dvb][i] = v; ss += v * v;
      }
    ss += __shfl_xor(ss, 32);
    const float sc = rsqrtf(ss * (1.f / 128.f) + 1e-6f) * (1.f - lam_init);
    const bf16_t* gp = P.GDA + ltq * 512 + hd * 128;
    bf16_t* yp = P.X + ((size_t)G.tok0 + ltq) * DM + 512 + hd * 128;
    const float* sl = P.subln + L * 128;
#pragma unroll
    for (int dvb = 0; dvb < 4; ++dvb)
#pragma unroll
      for (int q4 = 0; q4 < 4; ++q4) {
        const int dv = dvb * 32 + 8 * q4 + 4 * hh;
        const u32x2 g = *(const u32x2*)(gp + dv);
        const f32x4 s4 = *(const f32x4*)(sl + dv);
        u32x2 ov = {pack2(o[dvb][4 * q4] * sc * s4[0] * bflo(g[0]), o[dvb][4 * q4 + 1] * sc * s4[1] * bfhi(g[0])),
                    pack2(o[dvb][4 * q4 + 2] * sc * s4[2] * bflo(g[1]), o[dvb][4 * q4 + 3] * sc * s4[3] * bfhi(g[1]))};
        *(u32x2*)(yp + dv) = ov;
      }
  }
}

DI void phase_mixers(const Params& P, int L, const Group& G, int* ctr, char* lds, int* s_item, int mode = 0) {
  const int nscan = mode == 2 ? 0 : G.B * 16;
  const int nattn = mode == 1 ? 0 : G.B * 4 * (G.S >> 7);
  const int total = nscan + nattn;
  for (;;) {
    __syncthreads();
    if (threadIdx.x == 0) *s_item = atomicAdd(ctr, 1);
    __syncthreads();
    const int it = *s_item;
    if (it >= total) break;
    if (it < nscan) scan_task(P, L, G, it, lds);
    else attn_item(P, L, G, it - nscan, lds);
  }
}

__global__ void __launch_bounds__(NTHREADS) fwd_megakernel(Params P) {
  __shared__ __attribute__((aligned(16))) char lds[LDS_BYTES];
  __shared__ int s_item;
  cg::grid_group grid = cg::this_grid();
  phase_weights(P, lds);
  for (int ph = 0; ph < 18; ++ph) {
    const int L = ph / 9, k = ph % 9;
    const int g = (k >= 4 && k <= 6) ? 1 : 0;
    Group G;
    G.tok0 = g ? NP : 0; G.B = g ? 8 : 16; G.S = g ? 8192 : 2048; G.ntok = g ? NS : NP;
#ifdef PROBE_SCAN
    if (k == 2 || k == 5) { phase_mixers(P, L, G, P.ctr + 64 + (L * 2 + g) * 16, lds, &s_item, 1); grid.sync(); }
#endif
#ifdef PROBE_ATTN
    if (k == 2 || k == 5) { phase_mixers(P, L, G, P.ctr + 128 + (L * 2 + g) * 16, lds, &s_item, 2); grid.sync(); }
#endif
#ifdef PROBE_INPROJ
    if (k == 1 || k == 4) { phase_inproj(P, L, G, lds); grid.sync(); }
#endif
    if (k == 0) phase_prep(P, L);
    else if (k == 1 || k == 4) phase_inproj(P, L, G, lds);
    else if (k == 2 || k == 5) phase_mixers(P, L, G, P.ctr + (L * 2 + g) * 16, lds, &s_item);
    else if (k == 3 || k == 6) phase_rwkv_final(P, L, G);
    else if (k == 7) phase_outproj(P, L, lds);
    else phase_gate(P, L, lds);
    grid.sync();
  }
}

extern "C" void kernel_launch(void* const* d_in, const int* in_sizes, int n_in, void* d_out, int out_size, void* d_ws,
                              size_t ws_size, hipStream_t stream) {
  Params P{};
  const float* const* in = (const float* const*)d_in;
  P.x_prompt = in[0]; P.x_sample = in[1]; P.p_prompt = in[2]; P.p_sample = in[3];
  P.norm_pre = in[4]; P.w_in = in[5]; P.w_out = in[6]; P.conv_w = in[7]; P.conv_b = in[8];
  P.w0 = in[9]; P.w_up = in[10]; P.a0 = in[11]; P.a_up = in[12]; P.k_k = in[13]; P.k_a = in[14];
  P.r_k = in[15]; P.ln_g = in[16]; P.ln_b = in[17]; P.q_norm = in[18]; P.k_norm = in[19];
  P.lam_vec = in[20]; P.subln = in[21]; P.ple_proj = in[22]; P.ple_norm = in[23];
  P.gate_w = in[24]; P.gate_b = in[25];
  P.out = (float*)d_out;
  char* ws = (char*)d_ws;
  size_t off = 0;
  auto take = [&](size_t bytes) { char* p = ws + off; off += (bytes + 255) & ~(size_t)255; return p; };
  P.ctr = (int*)take(1024);
  P.consts = (float*)take(1024);
  P.X = (bf16_t*)take((size_t)NTOK * DM * 2);
  P.PB = (bf16_t*)take((size_t)NTOK * DPLE * 2);
  P.RS = (float*)take((size_t)NTOK * 4);
  P.WIN = (bf16_t*)take((size_t)2 * NIN * DM * 2);
  P.WOUT = (bf16_t*)take((size_t)2 * DM * DM * 2);
  P.WPLE = (bf16_t*)take((size_t)2 * DM * DPLE * 2);
  P.WGATE = (bf16_t*)take((size_t)2 * DM * DM * 2);
  P.WUPT = (bf16_t*)take((size_t)4 * 512 * 64 * 2);
  P.AUPT = (bf16_t*)take((size_t)2 * 512 * 64 * 2);
  P.CR = (bf16_t*)take((size_t)GS * CRW * 2);
  P.GRW = (bf16_t*)take((size_t)GS * 512 * 2);
  P.Q = (bf16_t*)take((size_t)GS * 512 * 2);
  P.KB = (bf16_t*)take((size_t)GS * 512 * 2);
  P.VT = (bf16_t*)take((size_t)GS * 512 * 2);
  P.GDA = (bf16_t*)take((size_t)GS * 512 * 2);
  P.YB = (bf16_t*)take((size_t)GS * 512 * 2);
  P.BV = (bf16_t*)take((size_t)GS * 512 * 2);
  P.R1 = P.CR;
  P.R2 = P.GRW;
  P.EPART = (float*)P.VT;
  if (off > ws_size) { fprintf(stderr, "workspace too small: need %zu have %zu\n", off, ws_size); return; }
  hipMemsetAsync(P.ctr, 0, 1024, stream);
  static int grid_blocks = 0;
  if (!grid_blocks) {
    int dev = 0, cus = 0, per_cu = 0;
    hipGetDevice(&dev);
    hipDeviceGetAttribute(&cus, hipDeviceAttributeMultiprocessorCount, dev);
    hipOccupancyMaxActiveBlocksPerMultiprocessor(&per_cu, fwd_megakernel, NTHREADS, 0);
    if (per_cu < 1) { fprintf(stderr, "occupancy query returned %d\n", per_cu); per_cu = 1; }
    grid_blocks = 256;
    if (cus < 256) fprintf(stderr, "unexpected CU count %d\n", cus);
  }
  void* args[] = {&P};
  hipError_t e = hipLaunchCooperativeKernel((void*)fwd_megakernel, dim3(grid_blocks), dim3(NTHREADS), args, 0, stream);
  if (e != hipSuccess) fprintf(stderr, "cooperative launch failed: %s (grid %d)\n", hipGetErrorString(e), grid_blocks);
}
```

```cpp
#include <hip/hip_runtime.h>
#include <hip/hip_cooperative_groups.h>
#include <cstdio>
namespace cg = cooperative_groups;

#define DI __device__ __forceinline__
typedef __attribute__((ext_vector_type(8))) short bf16x8;
typedef __attribute__((ext_vector_type(16))) float f32x16;
typedef __attribute__((ext_vector_type(4))) float f32x4;
typedef __attribute__((ext_vector_type(2))) float f32x2;
typedef __attribute__((ext_vector_type(4))) unsigned u32x4;
typedef __attribute__((ext_vector_type(2))) unsigned u32x2;
typedef unsigned short bf16_t;
#define MFMA(a, b, c) __builtin_amdgcn_mfma_f32_32x32x16_bf16((a), (b), (c), 0, 0, 0)

constexpr int DM = 1024;
constexpr int NP = 16 * 2048;
constexpr int NS = 8 * 8192;
constexpr int NTOK = NP + NS;
constexpr int DPLE = 256;
constexpr int IN_COLS = 4288;
constexpr int NIN = 4352;
constexpr int CRW = 1792;
constexpr int GS = NS;
constexpr float LOG2E = 1.4426950408889634f;
constexpr int NTHREADS = 512;
constexpr int LDS_BYTES = 147456;

struct Params {
  const float* x_prompt; const float* x_sample; const float* p_prompt; const float* p_sample;
  const float* norm_pre; const float* w_in; const float* w_out; const float* conv_w; const float* conv_b;
  const float* w0; const float* w_up; const float* a0; const float* a_up; const float* k_k; const float* k_a;
  const float* r_k; const float* ln_g; const float* ln_b; const float* q_norm; const float* k_norm;
  const float* lam_vec; const float* subln; const float* ple_proj; const float* ple_norm;
  const float* gate_w; const float* gate_b;
  float* out;
  bf16_t* X; bf16_t* PB; float* RS;
  bf16_t* CR; bf16_t* GRW; bf16_t* Q; bf16_t* KB; bf16_t* VT; bf16_t* GDA;
  bf16_t* R1; bf16_t* R2; float* EPART; bf16_t* YB; bf16_t* BV;
  bf16_t* WIN; bf16_t* WOUT; bf16_t* WPLE; bf16_t* WGATE; bf16_t* WUPT; bf16_t* AUPT;
  float* consts; int* ctr;
};

struct Group { int tok0, B, S, ntok; };

DI unsigned pack2(float a, float b) {
  typedef __attribute__((ext_vector_type(2))) __bf16 bf2;
  f32x2 v = {a, b};
  bf2 r = __builtin_convertvector(v, bf2);
  return __builtin_bit_cast(unsigned, r);
}
DI bf16_t f2bf(float a) { return (bf16_t)(pack2(a, 0.f) & 0xffffu); }
DI float bf2f(unsigned short u) { return __uint_as_float(((unsigned)u) << 16); }
DI float bflo(unsigned u) { return __uint_as_float(u << 16); }
DI float bfhi(unsigned u) { return __uint_as_float(u & 0xffff0000u); }
template <int CTRL> DI float dppf(float x) {
  return __int_as_float(__builtin_amdgcn_update_dpp(0, __float_as_int(x), CTRL, 0xF, 0xF, true));
}
DI float red4(float x) { x += dppf<0xB1>(x); x += dppf<0x4E>(x); return x; }
DI float red8(float x) { x = red4(x); x += dppf<0x141>(x); return x; }
DI float red32(float x) {
  x += __shfl_xor(x, 1); x += __shfl_xor(x, 2); x += __shfl_xor(x, 4); x += __shfl_xor(x, 8); x += __shfl_xor(x, 16);
  return x;
}
DI float sigmoidf_(float x) { return __builtin_amdgcn_rcpf(1.f + __expf(-x)); }
DI float siluf_(float x) { return x * __builtin_amdgcn_rcpf(1.f + __expf(-x)); }
DI float tanhf_(float x) { return 1.f - 2.f * __builtin_amdgcn_rcpf(1.f + __expf(2.f * x)); }
DI int opq(int x) { asm volatile("" : "+v"(x)); return x; }
DI int opqs(int x) { asm volatile("" : "+s"(x)); return x; }
DI int crow(int i, int h) { return (i & 3) + 8 * (i >> 2) + 4 * h; }

DI void transpose_convert(const float* __restrict__ src, int K, int N, bf16_t* __restrict__ dst, int Nd, int mode,
                          const float* __restrict__ rowscale, float* lds) {
  const int tid = opq(threadIdx.x);
  const int tk = K >> 6, tn = Nd >> 6;
  for (int t = blockIdx.x; t < tk * tn; t += gridDim.x) {
    const int k0 = (t % tk) << 6, n0 = (t / tk) << 6;
    int sn0 = n0;
    if (mode == 1) sn0 = (n0 < 1728) ? n0 : (n0 < 1792 ? -1 : n0 - 64);
    __syncthreads();
#pragma unroll
    for (int it = 0; it < 2; ++it) {
      const int kk = (tid >> 4) + 32 * it, n4 = (tid & 15) * 4;
      f32x4 v = {0.f, 0.f, 0.f, 0.f};
      if (sn0 >= 0) v = *(const f32x4*)(src + (size_t)(k0 + kk) * N + sn0 + n4);
      const float sc = rowscale ? rowscale[k0 + kk] : 1.f;
      lds[kk * 65 + n4 + 0] = v[0] * sc; lds[kk * 65 + n4 + 1] = v[1] * sc;
      lds[kk * 65 + n4 + 2] = v[2] * sc; lds[kk * 65 + n4 + 3] = v[3] * sc;
    }
    __syncthreads();
    const int nn = tid >> 3, k8 = (tid & 7) * 8;
    u32x4 o;
    o[0] = pack2(lds[(k8 + 0) * 65 + nn], lds[(k8 + 1) * 65 + nn]);
    o[1] = pack2(lds[(k8 + 2) * 65 + nn], lds[(k8 + 3) * 65 + nn]);
    o[2] = pack2(lds[(k8 + 4) * 65 + nn], lds[(k8 + 5) * 65 + nn]);
    o[3] = pack2(lds[(k8 + 6) * 65 + nn], lds[(k8 + 7) * 65 + nn]);
    *(u32x4*)(dst + (size_t)(n0 + nn) * K + k0 + k8) = o;
  }
}

DI void phase_weights(const Params& P, char* lds) {
  float* l = (float*)lds;
  for (int L = 0; L < 2; ++L) {
    transpose_convert(P.w_in + (size_t)L * DM * IN_COLS, DM, IN_COLS, P.WIN + (size_t)L * NIN * DM, NIN, 1, P.norm_pre + L * DM, l);
    transpose_convert(P.w_out + (size_t)L * DM * DM, DM, DM, P.WOUT + (size_t)L * DM * DM, DM, 0, nullptr, l);
    transpose_convert(P.ple_proj + (size_t)L * DPLE * DM, DPLE, DM, P.WPLE + (size_t)L * DM * DPLE, DM, 0, nullptr, l);
    transpose_convert(P.gate_w + (size_t)L * DM * DM, DM, DM, P.WGATE + (size_t)L * DM * DM, DM, 0, nullptr, l);
    for (int d = 0; d < 2; ++d)
      transpose_convert(P.w_up + (size_t)(L * 2 + d) * 64 * 512, 64, 512, P.WUPT + (size_t)(L * 2 + d) * 512 * 64, 512, 0, nullptr, l);
    transpose_convert(P.a_up + (size_t)L * 64 * 512, 64, 512, P.AUPT + (size_t)L * 512 * 64, 512, 0, nullptr, l);
  }
  if (blockIdx.x == 0 && threadIdx.x < 128) {
    const int L = threadIdx.x >> 6, lane = threadIdx.x & 63;
    const float* lv = P.lam_vec + L * 256;
    float s01 = lv[lane] * lv[64 + lane], s23 = lv[128 + lane] * lv[192 + lane];
    float mq = fmaxf(fabsf(P.q_norm[L * 128 + lane]), fabsf(P.q_norm[L * 128 + 64 + lane]));
    float mk = fmaxf(fabsf(P.k_norm[L * 128 + lane]), fabsf(P.k_norm[L * 128 + 64 + lane]));
    for (int o = 32; o >= 1; o >>= 1) {
      s01 += __shfl_xor(s01, o); s23 += __shfl_xor(s23, o);
      mq = fmaxf(mq, __shfl_xor(mq, o)); mk = fmaxf(mk, __shfl_xor(mk, o));
    }
    if (lane == 0) {
      const float lam_init = 0.8f - 0.6f * expf(-0.3f * (float)L);
      P.consts[L * 4 + 0] = expf(s01) - expf(s23) + lam_init;
      P.consts[L * 4 + 1] = 8.25f * mq * mk * LOG2E;
      P.consts[L * 4 + 2] = lam_init;
    }
  }
}

DI void phase_prep(const Params& P, int L) {
  const float* h0 = L == 0 ? P.x_prompt : P.out;
  const float* h1 = L == 0 ? P.x_sample : P.out + (size_t)NP * DM;
  const float* p0 = P.p_prompt + (size_t)L * NP * DPLE;
  const float* p1 = P.p_sample + (size_t)L * NS * DPLE;
  const int tidp = opq(threadIdx.x);
  const int lane = tidp & 63;
  const int gw = blockIdx.x * (NTHREADS / 64) + (tidp >> 6), nw = gridDim.x * (NTHREADS / 64);
  for (int tok = gw; tok < NTOK; tok += nw) {
    const float* hr = tok < NP ? h0 + (size_t)tok * DM : h1 + (size_t)(tok - NP) * DM;
    float ss = 0.f;
#pragma unroll
    for (int i = 0; i < 4; ++i) {
      f32x4 v = *(const f32x4*)(hr + i * 256 + lane * 4);
      ss += v[0] * v[0] + v[1] * v[1] + v[2] * v[2] + v[3] * v[3];
      u32x2 o = {pack2(v[0], v[1]), pack2(v[2], v[3])};
      *(u32x2*)(P.X + (size_t)tok * DM + i * 256 + lane * 4) = o;
    }
    for (int o = 32; o >= 1; o >>= 1) ss += __shfl_xor(ss, o);
    if (lane == 0) P.RS[tok] = rsqrtf(ss * (1.f / DM) + 1e-6f);
    const float* pr = tok < NP ? p0 + (size_t)tok * DPLE : p1 + (size_t)(tok - NP) * DPLE;
    f32x4 v = *(const f32x4*)(pr + lane * 4);
    u32x2 o = {pack2(v[0], v[1]), pack2(v[2], v[3])};
    *(u32x2*)(P.PB + (size_t)tok * DPLE + lane * 4) = o;
  }
}

constexpr int GSTR = 144;
constexpr int GA_BYTES = 256 * GSTR;
constexpr int GSTAGE = 2 * GA_BYTES;

DI void gemm_mainloop(const bf16_t* __restrict__ A, int lda, const bf16_t* __restrict__ Bw, int ldb, int K,
                      int m0, int n0, char* lds, f32x16 (&acc)[2][4]) {
  const int tid = opq(threadIdx.x), lane = tid & 63, w = tid >> 6, hh = lane >> 5, r = lane & 31;
  const int wm = w >> 1, wn = w & 1;
#pragma unroll
  for (int mi = 0; mi < 2; ++mi)
#pragma unroll
    for (int ni = 0; ni < 4; ++ni)
#pragma unroll
      for (int i = 0; i < 16; ++i) acc[mi][ni][i] = 0.f;
  const int lrow = tid >> 3, lkc = tid & 7;
  const bf16_t* ap = A + (size_t)(m0 + lrow) * lda + lkc * 8;
  const bf16_t* bp = Bw + (size_t)(n0 + lrow) * ldb + lkc * 8;
  const int nk = K >> 6;
  u32x4 ra[4], rb[4];
#pragma unroll
  for (int i = 0; i < 4; ++i) {
    ra[i] = *(const u32x4*)(ap + (size_t)(64 * i) * lda);
    rb[i] = *(const u32x4*)(bp + (size_t)(64 * i) * ldb);
  }
  __syncthreads();
#pragma unroll
  for (int i = 0; i < 4; ++i) {
    *(u32x4*)(lds + (lrow + 64 * i) * GSTR + lkc * 16) = ra[i];
    *(u32x4*)(lds + GA_BYTES + (lrow + 64 * i) * GSTR + lkc * 16) = rb[i];
  }
  __syncthreads();
  for (int kt = 0; kt < nk; ++kt) {
    const bool more = kt + 1 < nk;
    if (more) {
#pragma unroll
      for (int i = 0; i < 4; ++i) {
        ra[i] = *(const u32x4*)(ap + (size_t)(64 * i) * lda + (kt + 1) * 64);
        rb[i] = *(const u32x4*)(bp + (size_t)(64 * i) * ldb + (kt + 1) * 64);
      }
    }
    __builtin_amdgcn_sched_barrier(0);
    const char* sa = lds + (kt & 1) * GSTAGE + (wm * 64 + r) * GSTR + hh * 16;
    const char* sb = lds + (kt & 1) * GSTAGE + GA_BYTES + (wn * 128 + r) * GSTR + hh * 16;
    bf16x8 fa[2][2], fb[2][4];
#pragma unroll
    for (int mi = 0; mi < 2; ++mi) fa[0][mi] = *(const bf16x8*)(sa + mi * 32 * GSTR);
#pragma unroll
    for (int ni = 0; ni < 4; ++ni) fb[0][ni] = *(const bf16x8*)(sb + ni * 32 * GSTR);
#pragma unroll
    for (int ks = 0; ks < 4; ++ks) {
      if (ks < 3) {
#pragma unroll
        for (int mi = 0; mi < 2; ++mi) fa[(ks + 1) & 1][mi] = *(const bf16x8*)(sa + mi * 32 * GSTR + (ks + 1) * 32);
#pragma unroll
        for (int ni = 0; ni < 4; ++ni) fb[(ks + 1) & 1][ni] = *(const bf16x8*)(sb + ni * 32 * GSTR + (ks + 1) * 32);
      }
      __builtin_amdgcn_sched_barrier(0);
#pragma unroll
      for (int mi = 0; mi < 2; ++mi)
#pragma unroll
        for (int ni = 0; ni < 4; ++ni) acc[mi][ni] = MFMA(fb[ks & 1][ni], fa[ks & 1][mi], acc[mi][ni]);
      __builtin_amdgcn_sched_barrier(0);
    }
    if (more) {
      char* d = lds + ((kt + 1) & 1) * GSTAGE;
#pragma unroll
      for (int i = 0; i < 4; ++i) {
        *(u32x4*)(d + (lrow + 64 * i) * GSTR + lkc * 16) = ra[i];
        *(u32x4*)(d + GA_BYTES + (lrow + 64 * i) * GSTR + lkc * 16) = rb[i];
      }
    }
    __syncthreads();
  }
}

DI bool xcd_tile(int rd, int nM, int nN, int& mt, int& nt) {
  const int xcd = blockIdx.x & 7, j = blockIdx.x >> 3;
  const int u = (rd * 8 + xcd) * 32 + j;
  if (u >= nM * nN) return false;
  const int band = u / (8 * nN), rem = u % (8 * nN);
  nt = rem >> 3; mt = band * 8 + (rem & 7);
  return true;
}

DI void phase_inproj(const Params& P, int L, const Group& G, char* lds) {
  const int tid = opq(threadIdx.x), lane = tid & 63, w = tid >> 6, hh = lane >> 5, r = lane & 31;
  const int wm = w >> 1, wn = w & 1;
  const int nmt = G.ntok >> 8, ntile = nmt * 17;
  const bf16_t* A = P.X + (size_t)G.tok0 * DM;
  const bf16_t* Bw = P.WIN + (size_t)L * NIN * DM;
  for (int rd = 0; rd * 256 < ntile; ++rd) {
    int mt, nt;
    if (!xcd_tile(rd, nmt, 17, mt, nt)) continue;
    const int m0 = mt << 8, n0 = nt << 8;
    f32x16 acc[2][4];
    gemm_mainloop(A, DM, Bw, DM, DM, m0, n0, lds, acc);
    const int colw = n0 + wn * 128 + 4 * hh;
    if (nt < 7) {
#pragma unroll
      for (int mi = 0; mi < 2; ++mi) {
        const int row = m0 + wm * 64 + mi * 32 + r;
        const float rsv = P.RS[G.tok0 + row];
        bf16_t* dst = P.CR + (size_t)row * CRW + colw;
#pragma unroll
        for (int ni = 0; ni < 4; ++ni)
#pragma unroll
          for (int q4 = 0; q4 < 4; ++q4) {
            u32x2 o = {pack2(acc[mi][ni][4 * q4] * rsv, acc[mi][ni][4 * q4 + 1] * rsv),
                       pack2(acc[mi][ni][4 * q4 + 2] * rsv, acc[mi][ni][4 * q4 + 3] * rsv)};
            *(u32x2*)(dst + ni * 32 + q4 * 8) = o;
          }
      }
    } else if (nt < 9 || nt >= 15) {
      bf16_t* dbase = nt < 9 ? P.GRW : P.GDA;
      const int c0 = colw - (nt < 9 ? 1792 : 3840);
#pragma unroll
      for (int mi = 0; mi < 2; ++mi) {
        const int row = m0 + wm * 64 + mi * 32 + r;
        const float rsv = P.RS[G.tok0 + row];
        bf16_t* dst = dbase + (size_t)row * 512 + c0;
#pragma unroll
        for (int ni = 0; ni < 4; ++ni)
#pragma unroll
          for (int q4 = 0; q4 < 4; ++q4) {
            u32x2 o = {pack2(siluf_(acc[mi][ni][4 * q4] * rsv), siluf_(acc[mi][ni][4 * q4 + 1] * rsv)),
                       pack2(siluf_(acc[mi][ni][4 * q4 + 2] * rsv), siluf_(acc[mi][ni][4 * q4 + 3] * rsv))};
            *(u32x2*)(dst + ni * 32 + q4 * 8) = o;
          }
      }
    } else if (nt < 13) {
      const bool isq = nt < 11;
      bf16_t* dbase = isq ? P.Q : P.KB;
      const int c0 = colw - (isq ? 2304 : 2816);
      const float* g = (isq ? P.q_norm : P.k_norm) + L * 128 + 4 * hh;
      const float osc = isq ? 0.125f * LOG2E : 1.f;
#pragma unroll
      for (int mi = 0; mi < 2; ++mi) {
        const int row = m0 + wm * 64 + mi * 32 + r;
        const float rsv = P.RS[G.tok0 + row];
        bf16_t* dst = dbase + (size_t)row * 512 + c0;
#pragma unroll
        for (int gi = 0; gi < 2; ++gi) {
          float ss = 0.f;
#pragma unroll
          for (int t2 = 0; t2 < 2; ++t2)
#pragma unroll
            for (int i = 0; i < 16; ++i) { const float v = acc[mi][2 * gi + t2][i] * rsv; ss += v * v; }
          ss += __shfl_xor(ss, 32);
          const float sc = rsqrtf(ss * (1.f / 64.f) + 1e-6f) * rsv * osc;
#pragma unroll
          for (int t2 = 0; t2 < 2; ++t2)
#pragma unroll
            for (int q4 = 0; q4 < 4; ++q4) {
              const f32x4 gv = *(const f32x4*)(g + gi * 64 + t2 * 32 + q4 * 8);
              u32x2 o = {pack2(acc[mi][2 * gi + t2][4 * q4] * sc * gv[0], acc[mi][2 * gi + t2][4 * q4 + 1] * sc * gv[1]),
                         pack2(acc[mi][2 * gi + t2][4 * q4 + 2] * sc * gv[2], acc[mi][2 * gi + t2][4 * q4 + 3] * sc * gv[3])};
              *(u32x2*)(dst + (2 * gi + t2) * 32 + q4 * 8) = o;
            }
        }
      }
    } else {
      const int hd = (n0 + wn * 128 - 3328) >> 7;
      const int row0 = m0 + wm * 64;
      const int b = row0 / G.S, s0 = row0 % G.S;
#pragma unroll
      for (int mi = 0; mi < 2; ++mi) {
        const int s = s0 + mi * 32 + r;
        const float rsv = P.RS[G.tok0 + b * G.S + s];
        bf16_t* dst = P.VT + ((size_t)((b * 4 + hd) * 128 + 4 * hh)) * G.S + s;
        const size_t Sz = (size_t)G.S;
#pragma unroll
        for (int ni = 0; ni < 4; ++ni)
#pragma unroll
          for (int q4 = 0; q4 < 4; ++q4) {
            bf16_t* pq = dst + (size_t)(ni * 32 + 8 * q4) * Sz;
            pq[0] = f2bf(acc[mi][ni][4 * q4] * rsv);
            pq[Sz] = f2bf(acc[mi][ni][4 * q4 + 1] * rsv);
            pq[2 * Sz] = f2bf(acc[mi][ni][4 * q4 + 2] * rsv);
            pq[3 * Sz] = f2bf(acc[mi][ni][4 * q4 + 3] * rsv);
            __builtin_amdgcn_sched_barrier(0);
          }
      }
    }
  }
}

DI void phase_outproj(const Params& P, int L, char* lds) {
  const int tid = opq(threadIdx.x), lane = tid & 63, w = tid >> 6, hh = lane >> 5, r = lane & 31;
  const int wm = w >> 1, wn = w & 1;
  const float* h0 = L == 0 ? P.x_prompt : P.out;
  const float* h1 = L == 0 ? P.x_sample : P.out + (size_t)NP * DM;
  const int nmt = NTOK >> 8, ntile = nmt * 4;
  for (int rd2 = 0; rd2 * 256 < 2 * ntile; ++rd2) {
    const bool isE = rd2 * 256 >= ntile;
    int mt, nt;
    if (!xcd_tile(isE ? rd2 - ntile / 256 : rd2, nmt, 4, mt, nt)) continue;
    const int m0 = mt << 8, n0 = nt << 8;
    const int colw = n0 + wn * 128 + 4 * hh;
    f32x16 acc[2][4];
    if (!isE) {
      gemm_mainloop(P.X, DM, P.WOUT + (size_t)L * DM * DM, DM, DM, m0, n0, lds, acc);
#pragma unroll
      for (int mi = 0; mi < 2; ++mi) {
        const int row = m0 + wm * 64 + mi * 32 + r;
        const float* hr = (row < NP ? h0 + (size_t)row * DM : h1 + (size_t)(row - NP) * DM) + colw;
        float* op = P.out + (size_t)row * DM + colw;
        bf16_t* rp = P.R1 + (size_t)row * DM + colw;
#pragma unroll
        for (int ni = 0; ni < 4; ++ni)
#pragma unroll
          for (int q4 = 0; q4 < 4; ++q4) {
            f32x4 hv = *(const f32x4*)(hr + ni * 32 + q4 * 8);
            hv[0] += acc[mi][ni][4 * q4]; hv[1] += acc[mi][ni][4 * q4 + 1];
            hv[2] += acc[mi][ni][4 * q4 + 2]; hv[3] += acc[mi][ni][4 * q4 + 3];
            *(f32x4*)(op + ni * 32 + q4 * 8) = hv;
            u32x2 o = {pack2(hv[0], hv[1]), pack2(hv[2], hv[3])};
            *(u32x2*)(rp + ni * 32 + q4 * 8) = o;
          }
      }
    } else {
      gemm_mainloop(P.PB, DPLE, P.WPLE + (size_t)L * DM * DPLE, DPLE, DPLE, m0, n0, lds, acc);
#pragma unroll
      for (int mi = 0; mi < 2; ++mi) {
        const int row = m0 + wm * 64 + mi * 32 + r;
        bf16_t* rp = P.R2 + (size_t)row * DM + colw;
        float ss = 0.f;
#pragma unroll
        for (int ni = 0; ni < 4; ++ni)
#pragma unroll
          for (int q4 = 0; q4 < 4; ++q4) {
            const float v0 = acc[mi][ni][4 * q4], v1 = acc[mi][ni][4 * q4 + 1], v2 = acc[mi][ni][4 * q4 + 2], v3 = acc[mi][ni][4 * q4 + 3];
            ss += v0 * v0 + v1 * v1 + v2 * v2 + v3 * v3;
            u32x2 o = {pack2(v0, v1), pack2(v2, v3)};
            *(u32x2*)(rp + ni * 32 + q4 * 8) = o;
          }
        ss += __shfl_xor(ss, 32);
        if (hh == 0) P.EPART[(size_t)(nt * 2 + wn) * NTOK + row] = ss;
      }
    }
  }
}

DI void phase_gate(const Params& P, int L, char* lds) {
  const int tid = opq(threadIdx.x), lane = tid & 63, w = tid >> 6, hh = lane >> 5, r = lane & 31;
  const int wm = w >> 1, wn = w & 1;
  const int nmt = NTOK >> 8, ntile = nmt * 4;
  for (int rd = 0; rd * 256 < ntile; ++rd) {
    int mt, nt;
    if (!xcd_tile(rd, nmt, 4, mt, nt)) continue;
    const int m0 = mt << 8, n0 = nt << 8;
    const int colw = n0 + wn * 128 + 4 * hh;
    f32x16 acc[2][4];
    gemm_mainloop(P.R1, DM, P.WGATE + (size_t)L * DM * DM, DM, DM, m0, n0, lds, acc);
    const float* gbp = P.gate_b + L * DM + colw;
    const float* pnp = P.ple_norm + L * DM + colw;
#pragma unroll
    for (int mi = 0; mi < 2; ++mi) {
      const int row = m0 + wm * 64 + mi * 32 + r;
      float es = 0.f;
#pragma unroll
      for (int j = 0; j < 8; ++j) es += P.EPART[(size_t)j * NTOK + row];
      const float rse = rsqrtf(es * (1.f / DM) + 1e-6f);
      float* op = P.out + (size_t)row * DM + colw;
      const bf16_t* ep = P.R2 + (size_t)row * DM + colw;
#pragma unroll
      for (int ni = 0; ni < 4; ++ni)
#pragma unroll
        for (int q4 = 0; q4 < 4; ++q4) {
          const int co = ni * 32 + q4 * 8;
          const f32x4 gb = *(const f32x4*)(gbp + co), pn = *(const f32x4*)(pnp + co);
          const u32x2 ev = *(const u32x2*)(ep + co);
          f32x4 hv = *(const f32x4*)(op + co);
          hv[0] += sigmoidf_(acc[mi][ni][4 * q4] + gb[0]) * (bflo(ev[0]) * rse * pn[0]);
          hv[1] += sigmoidf_(acc[mi][ni][4 * q4 + 1] + gb[1]) * (bfhi(ev[0]) * rse * pn[1]);
          hv[2] += sigmoidf_(acc[mi][ni][4 * q4 + 2] + gb[2]) * (bflo(ev[1]) * rse * pn[2]);
          hv[3] += sigmoidf_(acc[mi][ni][4 * q4 + 3] + gb[3]) * (bfhi(ev[1]) * rse * pn[3]);
          *(f32x4*)(op + co) = hv;
        }
    }
  }
}

constexpr int TC = 32;
constexpr int CB_OP = TC * 64 * 4;
constexpr int CB_BYTES = 6 * CB_OP + 128 + 1024;
constexpr int PW_BYTES = 10 * 640 + 2 * 8 * 144;
constexpr int PW_BASE = 2 * CB_BYTES;

template <int N> DI void red64v(float (&x)[N]) {
#pragma unroll
  for (int i = 0; i < N; ++i) x[i] += dppf<0xB1>(x[i]);
#pragma unroll
  for (int i = 0; i < N; ++i) x[i] += dppf<0x4E>(x[i]);
#pragma unroll
  for (int i = 0; i < N; ++i) x[i] += dppf<0x141>(x[i]);
#pragma unroll
  for (int i = 0; i < N; ++i) x[i] += dppf<0x140>(x[i]);
#pragma unroll
  for (int i = 0; i < N; ++i) x[i] += __shfl_xor(x[i], 16);
#pragma unroll
  for (int i = 0; i < N; ++i) x[i] += __shfl_xor(x[i], 32);
}

struct ScanOps { f32x4 a0, a1, b0, b1, k0, k1, r0, r1; f32x2 v; };

DI ScanOps scan_load(const float* __restrict__ ob, int s, int coff, int row0) {
  ScanOps o;
  const float* p = ob + s * 64 + coff;
  o.a0 = *(const f32x4*)(p + TC * 64);       o.a1 = *(const f32x4*)(p + TC * 64 + 4);
  o.b0 = *(const f32x4*)(p + 2 * TC * 64);   o.b1 = *(const f32x4*)(p + 2 * TC * 64 + 4);
  o.k0 = *(const f32x4*)(p + 3 * TC * 64);   o.k1 = *(const f32x4*)(p + 3 * TC * 64 + 4);
  o.r0 = *(const f32x4*)(p + 4 * TC * 64);   o.r1 = *(const f32x4*)(p + 4 * TC * 64 + 4);
  o.v = *(const f32x2*)(ob + 5 * TC * 64 + s * 64 + row0);
  return o;
}

DI f32x2 lo2(f32x4 x) { return f32x2{x[0], x[1]}; }
DI f32x2 hi2(f32x4 x) { return f32x2{x[2], x[3]}; }

DI f32x2 scan_step(f32x2 (&st)[2][4], const ScanOps& o) {
  const f32x2 a[4] = {lo2(o.a0), hi2(o.a0), lo2(o.a1), hi2(o.a1)};
  const f32x2 bv[4] = {lo2(o.b0), hi2(o.b0), lo2(o.b1), hi2(o.b1)};
  const f32x2 kv[4] = {lo2(o.k0), hi2(o.k0), lo2(o.k1), hi2(o.k1)};
  const f32x2 rv[4] = {lo2(o.r0), hi2(o.r0), lo2(o.r1), hi2(o.r1)};
  f32x2 y;
#pragma unroll
  for (int rr = 0; rr < 2; ++rr) {
    f32x2 p = st[rr][0] * a[0];
    p = st[rr][1] * a[1] + p; p = st[rr][2] * a[2] + p; p = st[rr][3] * a[3] + p;
    const float sa = red8(p[0] + p[1]);
    const f32x2 sa2 = {sa, sa};
    const f32x2 v2 = {o.v[rr], o.v[rr]};
    f32x2 q = {0.f, 0.f};
#pragma unroll
    for (int j = 0; j < 4; ++j) {
      f32x2 x = sa2 * bv[j] + st[rr][j];
      x = v2 * kv[j] + x;
      st[rr][j] = x;
      q = x * rv[j] + q;
    }
    y[rr] = red8(q[0] + q[1]);
  }
  return y;
}

DI void scan_task(const Params& P, int L_, const Group& G, int task, char* lds) {
  const int L = opqs(__builtin_amdgcn_readfirstlane(L_));
  const int tid = opq(threadIdx.x), lane = tid & 63, w = tid >> 6;
  const int dir = task & 1, b = task >> 4, hd = (task >> 1) & 7;
  const int S = G.S, nc = S / TC;
  const int sg = dir ? -1 : 1;
  const bf16_t* crb = P.CR + (size_t)b * S * CRW;

  const int srow0 = (w & 3) * 16 + (lane >> 3) * 2, scs = lane & 7;
  f32x2 st[2][4];
#pragma unroll
  for (int rr = 0; rr < 2; ++rr)
#pragma unroll
    for (int j = 0; j < 4; ++j) st[rr][j] = f32x2{0.f, 0.f};

  const int pw = w & 3, ec = lane, hh = lane >> 5, r = lane & 31;
  char* pwb = lds + PW_BASE + pw * PW_BYTES;
  const int ch = hd * 64 + ec;
  const float c_kk = P.k_k[L * 512 + ch], c_ka = P.k_a[L * 512 + ch], c_rk = P.r_k[L * 512 + ch];
  const float* cw = P.conv_w + (size_t)L * 3 * 1728;
  const float* cb = P.conv_b + (size_t)L * 1728;
  const bf16_t* wsrcW = P.WUPT + (size_t)(L * 2 + dir) * 512 * 64 + (size_t)(hd * 64 + r) * 64 + hh * 8;
  const bf16_t* wsrcA = P.AUPT + (size_t)L * 512 * 64 + (size_t)(hd * 64 + r) * 64 + hh * 8;
  const float* w0p = P.w0 + (size_t)(L * 2 + dir) * 512 + hd * 64 + r;
  const float* a0p = P.a0 + (size_t)L * 512 + hd * 64 + r;

  auto prepare = [&](int cc, char* cbuf) {
    float* oW = (float*)cbuf; float* oA = (float*)(cbuf + CB_OP); float* oB = (float*)(cbuf + 2 * CB_OP);
    float* oK = (float*)(cbuf + 3 * CB_OP); float* oR = (float*)(cbuf + 4 * CB_OP); float* oV = (float*)(cbuf + 5 * CB_OP);
    float* oBon = (float*)(cbuf + 6 * CB_OP);
    const int ln = opq(lane);
    const int tbase = dir ? S - cc * TC - 8 * pw - 9 : cc * TC + 8 * pw - 1;
    {
      u32x4 rv[7];
#pragma unroll
      for (int it = 0; it < 7; ++it) {
        int id = ln + it * 64;
        id = id < 400 ? id : 399;
        const int rr = id / 40, cc8 = id % 40, q = cc8 >> 3, c8 = (cc8 & 7) * 8;
        const int tok = tbase + rr;
        const bool ok = tok >= 0 && tok < S;
        const int tokc = tok < 0 ? 0 : (tok >= S ? S - 1 : tok);
        const int col = (q == 0 ? hd * 64 : q == 1 ? 512 + hd * 64 : q == 2 ? 1024 + hd * 64 : q == 3 ? 1536 + dir * 64 : 1664) + c8;
        const u32x4 v = *(const u32x4*)(crb + (size_t)tokc * CRW + col);
        const u32x4 z = {0u, 0u, 0u, 0u};
        rv[it] = ok ? v : z;
      }
#pragma unroll
      for (int it = 0; it < 7; ++it) {
        int id = ln + it * 64;
        id = id < 400 ? id : 399;
        *(u32x4*)(pwb + (id / 40) * 640 + (id % 40) * 16) = rv[it];
      }
    }
    asm volatile("" ::: "memory");
    float cwp[5], cwc[5], cwn[5], cbb[5];
#pragma unroll
    for (int q = 0; q < 5; ++q) {
      const int cqq = (q == 0 ? hd * 64 : q == 1 ? 512 + hd * 64 : q == 2 ? 1024 + hd * 64 : q == 3 ? 1536 + dir * 64 : 1664) + ln;
      const float w0 = cw[cqq], w1 = cw[1728 + cqq], w2 = cw[2 * 1728 + cqq];
      cwp[q] = dir ? w2 : w0; cwc[q] = w1; cwn[q] = dir ? w0 : w2; cbb[q] = cb[cqq];
    }
    bf16x8 lf[2][2][4];
#pragma unroll
    for (int nb = 0; nb < 2; ++nb)
#pragma unroll
      for (int ks = 0; ks < 4; ++ks) {
        lf[0][nb][ks] = *(const bf16x8*)(wsrcW + nb * 32 * 64 + ks * 16);
        lf[1][nb][ks] = *(const bf16x8*)(wsrcA + nb * 32 * 64 + ks * 16);
      }
    const bf16_t* raw = (const bf16_t*)pwb;
    bf16_t* zt = (bf16_t*)(pwb + 6400); bf16_t* za = (bf16_t*)(pwb + 6400 + 8 * 144);
    float kreg[8];
#pragma unroll
    for (int hf = 0; hf < 2; ++hf) {
      float xr[6][5];
#pragma unroll
      for (int j = 0; j < 6; ++j) {
        const int vi = hf * 4 + j - 1;
        const int jj = dir ? 8 - vi : vi + 1;
#pragma unroll
        for (int q = 0; q < 5; ++q) xr[j][q] = bf2f(raw[jj * 320 + q * 64 + ln]);
      }
#pragma unroll
      for (int i = 0; i < 4; ++i) {
        float v[5];
#pragma unroll
        for (int q = 0; q < 5; ++q) v[q] = cbb[q] + cwp[q] * xr[i][q] + cwc[q] * xr[i + 1][q] + cwn[q] * xr[i + 2][q];
        const int ti = hf * 4 + i, s = 8 * pw + ti;
        oR[s * 64 + ln] = v[0];
        kreg[ti] = v[1];
        oV[s * 64 + ln] = v[2];
        zt[ti * 72 + ln] = f2bf(tanhf_(v[3]));
        za[ti * 72 + ln] = f2bf(v[4]);
      }
    }
    asm volatile("" ::: "memory");
    {
      const char* az = (const char*)zt + (r & 7) * 144 + hh * 16;
      const char* aa = (const char*)za + (r & 7) * 144 + hh * 16;
#pragma unroll
      for (int nb = 0; nb < 2; ++nb) {
        f32x16 accw, acca;
#pragma unroll
        for (int i = 0; i < 16; ++i) { accw[i] = 0.f; acca[i] = 0.f; }
#pragma unroll
        for (int ks = 0; ks < 4; ++ks) {
          const bf16x8 fz = *(const bf16x8*)(az + ks * 32);
          const bf16x8 fa = *(const bf16x8*)(aa + ks * 32);
          accw = MFMA(fz, lf[0][nb][ks], accw);
          acca = MFMA(fa, lf[1][nb][ks], acca);
        }
        const float w0v = w0p[nb * 32], a0v = a0p[nb * 32];
#pragma unroll
        for (int i = 0; i < 4; ++i) {
          const int s = 8 * pw + 4 * hh + i;
          oW[s * 64 + nb * 32 + r] = __expf(-0.6065306597126334f * sigmoidf_(w0v + accw[i]));
          oA[s * 64 + nb * 32 + r] = sigmoidf_(a0v + acca[i]);
        }
      }
    }
    asm volatile("" ::: "memory");
    {
      float ag[8], kk[8], ss[8], km[8], bn[8];
#pragma unroll
      for (int i = 0; i < 8; ++i) {
        const int s = 8 * pw + i;
        ag[i] = oA[s * 64 + ln];
        kk[i] = kreg[i] * c_kk;
        ss[i] = kk[i] * kk[i];
        km[i] = kreg[i] * (1.f + (ag[i] - 1.f) * c_ka);
        bn[i] = oR[s * 64 + ln] * km[i] * c_rk;
      }
      red64v<8>(ss);
      red64v<8>(bn);
      float g = 1.f;
#pragma unroll
      for (int i = 0; i < 8; ++i) {
        const int s = 8 * pw + i;
        const float kn = kk[i] * rsqrtf(ss[i] + 1e-12f);
        const float gprev = g;
        g *= oW[s * 64 + ln];
        const float ginv = __builtin_amdgcn_rcpf(g);
        oK[s * 64 + ln] = km[i] * ginv;
        oA[s * 64 + ln] = -kn * gprev;
        oB[s * 64 + ln] = kn * ag[i] * ginv;
        oR[s * 64 + ln] = oR[s * 64 + ln] * g;
        if (ln == 0) oBon[s] = bn[i];
      }
      ((float*)(cbuf + 6 * CB_OP + 128))[pw * 64 + ln] = g;
    }
  };

  __syncthreads();
  if (w >= 4) prepare(0, lds);
  __syncthreads();

  for (int c = 0; c < nc; ++c) {
    char* cbuf = lds + (c & 1) * CB_BYTES;
    if (w < 4) {
      const float* sb = (const float*)cbuf;
      const float* oBon = (const float*)(cbuf + 6 * CB_OP);
      ScanOps cur = scan_load(sb, 0, scs * 8, srow0);
#pragma unroll 1
      for (int s8 = 0; s8 < TC; s8 += 8) {
        f32x2 ykeep = {0.f, 0.f};
#pragma unroll
        for (int u = 0; u < 8; ++u) {
          const int s = s8 + u;
          const ScanOps nxt = scan_load(sb, s + 1 < TC ? s + 1 : s, scs * 8, srow0);
          const f32x2 y = scan_step(st, cur);
          if (u == scs) ykeep = y;
          cur = nxt;
        }
        {
          const float* g8 = (const float*)(cbuf + 6 * CB_OP + 128) + (s8 >> 3) * 64 + scs * 8;
          const f32x4 ga = *(const f32x4*)g8, gb = *(const f32x4*)(g8 + 4);
          const f32x2 gg[4] = {lo2(ga), hi2(ga), lo2(gb), hi2(gb)};
#pragma unroll
          for (int rr = 0; rr < 2; ++rr)
#pragma unroll
            for (int j = 0; j < 4; ++j) st[rr][j] = st[rr][j] * gg[j];
        }
        const int s = s8 + scs;
        const int ts = dir ? S - 1 - (c * TC + s) : c * TC + s;
        const size_t lt = (size_t)b * S + ts;
        const unsigned yv = pack2(ykeep[0], ykeep[1]);
        if (dir == 0) {
          *(unsigned*)(P.X + ((size_t)G.tok0 + lt) * DM + hd * 64 + srow0) = yv;
          const float bon = oBon[s];
          const f32x2 vv = *(const f32x2*)(sb + 5 * TC * 64 + s * 64 + srow0);
          *(unsigned*)(P.BV + lt * 512 + hd * 64 + srow0) = pack2(bon * vv[0], bon * vv[1]);
        } else {
          *(unsigned*)(P.YB + lt * 512 + hd * 64 + srow0) = yv;
        }
      }
    } else if (c + 1 < nc) {
      prepare(c + 1, lds + ((c + 1) & 1) * CB_BYTES);
    }
    __syncthreads();
  }
}

DI void phase_rwkv_final(const Params& P, int L, const Group& G) {
  const int tidp = opq(threadIdx.x);
  const int lane = tidp & 63;
  const int gw = blockIdx.x * (NTHREADS / 64) + (tidp >> 6), nw = gridDim.x * (NTHREADS / 64);
  const f32x4 g0 = *(const f32x4*)(P.ln_g + L * 512 + lane * 8), g1 = *(const f32x4*)(P.ln_g + L * 512 + lane * 8 + 4);
  const f32x4 b0 = *(const f32x4*)(P.ln_b + L * 512 + lane * 8), b1 = *(const f32x4*)(P.ln_b + L * 512 + lane * 8 + 4);
  const float lg[8] = {g0[0], g0[1], g0[2], g0[3], g1[0], g1[1], g1[2], g1[3]};
  const float lb[8] = {b0[0], b0[1], b0[2], b0[3], b1[0], b1[1], b1[2], b1[3]};
  for (int lt = gw; lt < G.ntok; lt += nw) {
    bf16_t* xp = P.X + ((size_t)G.tok0 + lt) * DM + lane * 8;
    const u32x4 yf = *(const u32x4*)xp;
    const u32x4 yb = *(const u32x4*)(P.YB + (size_t)lt * 512 + lane * 8);
    const u32x4 bv = *(const u32x4*)(P.BV + (size_t)lt * 512 + lane * 8);
    const u32x4 gt = *(const u32x4*)(P.GRW + (size_t)lt * 512 + lane * 8);
    float y[8];
    float sum = 0.f;
#pragma unroll
    for (int j = 0; j < 4; ++j) {
      y[2 * j] = bflo(yf[j]) + bflo(yb[j]); y[2 * j + 1] = bfhi(yf[j]) + bfhi(yb[j]);
      sum += y[2 * j] + y[2 * j + 1];
    }
    const float mu = red8(sum) * (1.f / 64.f);
    float vs = 0.f;
#pragma unroll
    for (int j = 0; j < 8; ++j) { y[j] -= mu; vs += y[j] * y[j]; }
    const float rstd = rsqrtf(red8(vs) * (1.f / 64.f) + 64e-5f);
    u32x4 o;
#pragma unroll
    for (int j = 0; j < 4; ++j) {
      const float o0 = (y[2 * j] * rstd * lg[2 * j] + lb[2 * j] + bflo(bv[j])) * bflo(gt[j]);
      const float o1 = (y[2 * j + 1] * rstd * lg[2 * j + 1] + lb[2 * j + 1] + bfhi(bv[j])) * bfhi(gt[j]);
      o[j] = pack2(o0, o1);
    }
    *(u32x4*)xp = o;
  }
}

constexpr int AT_K = 64 * GSTR;
constexpr int AT_STAGE = 2 * AT_K + 128 * GSTR;

DI void attn_item(const Params& P, int L_, const Group& G, int item, char* lds) {
  const int L = opqs(__builtin_amdgcn_readfirstlane(L_));
  const int tid = opq(threadIdx.x), lane = tid & 63, w = tid >> 6, hh = lane >> 5, r = lane & 31;
  const int S = G.S, nqb = S >> 7;
  const int qblk = item % nqb, bh = item / nqb, hd = bh & 3, b = bh >> 2;
  const int map = w & 1, qb = w >> 1;
  const int q0 = qblk * 128 + qb * 32;
  const size_t ltq = (size_t)b * S + q0 + r;
  bf16x8 qf[4];
  {
    const bf16_t* qp = P.Q + ltq * 512 + hd * 128 + map * 64 + hh * 8;
#pragma unroll
    for (int ks = 0; ks < 4; ++ks) qf[ks] = *(const bf16x8*)(qp + ks * 16);
  }
  f32x16 o[4];
#pragma unroll
  for (int d = 0; d < 4; ++d)
#pragma unroll
    for (int i = 0; i < 16; ++i) o[d][i] = 0.f;
  f32x16 accl;
#pragma unroll
  for (int i = 0; i < 16; ++i) accl[i] = 0.f;
  const float slope2 = exp2f(-2.f * (float)(hd + 1)) * LOG2E;
  float so[16];
#pragma unroll
  for (int i = 0; i < 16; ++i) so[i] = slope2 * (float)(16 * (i >> 3) + (i & 7));
  bf16x8 ones;
#pragma unroll
  for (int j = 0; j < 8; ++j) ones[j] = (short)0x3F80;
  const float lam = P.consts[L * 4 + 0], C2 = P.consts[L * 4 + 1], lam_init = P.consts[L * 4 + 2];
  const float qposf = (float)(q0 + r);
  const int Dz = (int)ceilf(150.f / slope2);
  const int Q0 = qblk * 128;
  const int tlo = (Q0 - 63 - Dz) < 0 ? 0 : (Q0 - 63 - Dz) / 64 + 1;
  const int thx = min(S >> 6, (Q0 + 127 + Dz + 63) / 64);
  const int nt = thx - tlo;
  const int lrow = tid >> 3, lck = tid & 7;
  const bf16_t* k0p = P.KB + ((size_t)b * S + tlo * 64 + lrow) * 512 + hd * 128 + lck * 8;
  const bf16_t* v0p = P.VT + ((size_t)((b * 4 + hd) * 128 + lrow)) * S + tlo * 64 + lck * 8;
  u32x4 ra0, ra1, ra2, ra3, rb0, rb1, rb2, rb3;
  auto ldtile = [&](int tt, u32x4& x0, u32x4& x1, u32x4& x2, u32x4& x3) {
    const int tc = tt < nt ? tt : nt - 1;
    x0 = *(const u32x4*)(k0p + (size_t)tc * 64 * 512); x1 = *(const u32x4*)(k0p + (size_t)tc * 64 * 512 + 64);
    x2 = *(const u32x4*)(v0p + tc * 64); x3 = *(const u32x4*)(v0p + (size_t)64 * S + tc * 64);
  };
  auto sttile = [&](int slot, const u32x4& x0, const u32x4& x1, const u32x4& x2, const u32x4& x3) {
    char* d = lds + slot * AT_STAGE;
    *(u32x4*)(d + lrow * GSTR + lck * 16) = x0;
    *(u32x4*)(d + AT_K + lrow * GSTR + lck * 16) = x1;
    *(u32x4*)(d + 2 * AT_K + lrow * GSTR + lck * 16) = x2;
    *(u32x4*)(d + 2 * AT_K + (lrow + 64) * GSTR + lck * 16) = x3;
  };
  ldtile(0, ra0, ra1, ra2, ra3);
  ldtile(1, rb0, rb1, rb2, rb3);
  __syncthreads();
  sttile(0, ra0, ra1, ra2, ra3);
  ldtile(2, ra0, ra1, ra2, ra3);
  __syncthreads();
  const int krow = (r & ~12) | ((r & 4) << 1) | ((r & 8) >> 1);
  auto compute = [&](int t) {
    const char* kbuf = lds + (t & 1) * AT_STAGE + map * AT_K;
    const char* vbuf = lds + (t & 1) * AT_STAGE + 2 * AT_K;
    f32x16 s0, s1;
    const int kt0 = (tlo + t) * 64;
    const float base = (float)(kt0 + 8 * hh) - qposf;
    if (kt0 + 63 < q0) {
      const float bl = fmaf(slope2, base, -C2), bl2 = bl + 32.f * slope2;
#pragma unroll
      for (int i = 0; i < 16; ++i) { s0[i] = bl + so[i]; s1[i] = bl2 + so[i]; }
    } else if (kt0 > q0 + 31) {
      const float br = fmaf(-slope2, base, -C2), br2 = br - 32.f * slope2;
#pragma unroll
      for (int i = 0; i < 16; ++i) { s0[i] = br - so[i]; s1[i] = br2 - so[i]; }
    } else {
#pragma unroll
      for (int i = 0; i < 16; ++i) {
        const float d0 = base + (float)(16 * (i >> 3) + (i & 7));
        s0[i] = fmaf(fabsf(d0), -slope2, -C2);
        s1[i] = fmaf(fabsf(d0 + 32.f), -slope2, -C2);
      }
    }
#pragma unroll
    for (int ks = 0; ks < 4; ++ks) {
      const bf16x8 a0 = *(const bf16x8*)(kbuf + krow * GSTR + ks * 32 + hh * 16);
      const bf16x8 a1 = *(const bf16x8*)(kbuf + (32 + krow) * GSTR + ks * 32 + hh * 16);
      s0 = MFMA(a0, qf[ks], s0);
      s1 = MFMA(a1, qf[ks], s1);
    }
    bf16x8 pf[4];
    {
      u32x4 pk[4];
#pragma unroll
      for (int i = 0; i < 16; i += 2) {
        const float e0 = __builtin_amdgcn_exp2f(s0[i]), e1 = __builtin_amdgcn_exp2f(s0[i + 1]);
        const float e2 = __builtin_amdgcn_exp2f(s1[i]), e3 = __builtin_amdgcn_exp2f(s1[i + 1]);
        pk[i >> 3][(i & 7) >> 1] = pack2(e0, e1);
        pk[2 + (i >> 3)][(i & 7) >> 1] = pack2(e2, e3);
      }
#pragma unroll
      for (int j = 0; j < 4; ++j) pf[j] = __builtin_bit_cast(bf16x8, pk[j]);
    }
#pragma unroll
    for (int j = 0; j < 4; ++j) accl = MFMA(ones, pf[j], accl);
#pragma unroll
    for (int dvb = 0; dvb < 4; ++dvb)
#pragma unroll
      for (int j = 0; j < 4; ++j) {
        const bf16x8 va = *(const bf16x8*)(vbuf + (dvb * 32 + r) * GSTR + (16 * j + 8 * hh) * 2);
        o[dvb] = MFMA(va, pf[j], o[dvb]);
      }
  };
  for (int t = 0; t < nt; t += 2) {
    compute(t);
    sttile(1, rb0, rb1, rb2, rb3);
    __builtin_amdgcn_sched_barrier(0);
    ldtile(t + 3, rb0, rb1, rb2, rb3);
    __builtin_amdgcn_sched_barrier(0);
    __syncthreads();
    if (t + 1 >= nt) break;
    compute(t + 1);
    sttile(0, ra0, ra1, ra2, ra3);
    __builtin_amdgcn_sched_barrier(0);
    ldtile(t + 4, ra0, ra1, ra2, ra3);
    __builtin_amdgcn_sched_barrier(0);
    __syncthreads();
  }
  const float linv = 1.f / accl[0];
  float* comb = (float*)lds;
  if (map == 1) {
#pragma unroll
    for (int dvb = 0; dvb < 4; ++dvb)
#pragma unroll
      for (int i = 0; i < 16; ++i) comb[(qb * 64 + dvb * 16 + i) * 64 + lane] = o[dvb][i] * linv;
  }
  __syncthreads();
  if (map == 0) {
    float ss = 0.f;
#pragma unroll
    for (int dvb = 0; dvb < 4; ++dvb)
#pragma unroll
      for (int i = 0; i < 16; ++i) {
        const float v = o[dvb][i] * linv - lam * comb[(qb * 64 + dvb * 16 + i) * 64 + lane];
        o[dvb][i] = v; ss += v * v;
      }
    ss += __shfl_xor(ss, 32);
    const float sc = rsqrtf(ss * (1.f / 128.f) + 1e-6f) * (1.f - lam_init);
    const bf16_t* gp = P.GDA + ltq * 512 + hd * 128;
    bf16_t* yp = P.X + ((size_t)G.tok0 + ltq) * DM + 512 + hd * 128;
    const float* sl = P.subln + L * 128;
#pragma unroll
    for (int dvb = 0; dvb < 4; ++dvb)
#pragma unroll
      for (int q4 = 0; q4 < 4; ++q4) {
        const int dv = dvb * 32 + 8 * q4 + 4 * hh;
        const u32x2 g = *(const u32x2*)(gp + dv);
        const f32x4 s4 = *(const f32x4*)(sl + dv);
        u32x2 ov = {pack2(o[dvb][4 * q4] * sc * s4[0] * bflo(g[0]), o[dvb][4 * q4 + 1] * sc * s4[1] * bfhi(g[0])),
                    pack2(o[dvb][4 * q4 + 2] * sc * s4[2] * bflo(g[1]), o[dvb][4 * q4 + 3] * sc * s4[3] * bfhi(g[1]))};
        *(u32x2*)(yp + dv) = ov;
      }
  }
}

DI void phase_mixers(const Params& P, int L, const Group& G, int* ctr, char* lds, int* s_item, int mode = 0) {
  const int nscan = mode == 2 ? 0 : G.B * 16;
  const int nattn = mode == 1 ? 0 : G.B * 4 * (G.S >> 7);
  const int total = nscan + nattn;
  for (;;) {
    __syncthreads();
    if (threadIdx.x == 0) *s_item = atomicAdd(ctr, 1);
    __syncthreads();
    const int it = *s_item;
    if (it >= total) break;
    if (it < nscan) scan_task(P, L, G, it, lds);
    else attn_item(P, L, G, it - nscan, lds);
  }
}

__global__ void __launch_bounds__(NTHREADS) fwd_megakernel(Params P) {
  __shared__ __attribute__((aligned(16))) char lds[LDS_BYTES];
  __shared__ int s_item;
  cg::grid_group grid = cg::this_grid();
  phase_weights(P, lds);
  for (int ph = 0; ph < 18; ++ph) {
    const int L = ph / 9, k = ph % 9;
    const int g = (k >= 4 && k <= 6) ? 1 : 0;
    Group G;
    G.tok0 = g ? NP : 0; G.B = g ? 8 : 16; G.S = g ? 8192 : 2048; G.ntok = g ? NS : NP;
#ifdef PROBE_SCAN
    if (k == 2 || k == 5) { phase_mixers(P, L, G, P.ctr + 64 + (L * 2 + g) * 16, lds, &s_item, 1); grid.sync(); }
#endif
#ifdef PROBE_ATTN
    if (k == 2 || k == 5) { phase_mixers(P, L, G, P.ctr + 128 + (L * 2 + g) * 16, lds, &s_item, 2); grid.sync(); }
#endif
#ifdef PROBE_INPROJ
    if (k == 1 || k == 4) { phase_inproj(P, L, G, lds); grid.sync(); }
#endif
    if (k == 0) phase_prep(P, L);
    else if (k == 1 || k == 4) phase_inproj(P, L, G, lds);
    else if (k == 2 || k == 5) phase_mixers(P, L, G, P.ctr + (L * 2 + g) * 16, lds, &s_item);
    else if (k == 3 || k == 6) phase_rwkv_final(P, L, G);
    else if (k == 7) phase_outproj(P, L, lds);
    else phase_gate(P, L, lds);
    grid.sync();
  }
}

extern "C" void kernel_launch(void* const* d_in, const int* in_sizes, int n_in, void* d_out, int out_size, void* d_ws,
                              size_t ws_size, hipStream_t stream) {
  Params P{};
  const float* const* in = (const float* const*)d_in;
  P.x_prompt = in[0]; P.x_sample = in[1]; P.p_prompt = in[2]; P.p_sample = in[3];
  P.norm_pre = in[4]; P.w_in = in[5]; P.w_out = in[6]; P.conv_w = in[7]; P.conv_b = in[8];
  P.w0 = in[9]; P.w_up = in[10]; P.a0 = in[11]; P.a_up = in[12]; P.k_k = in[13]; P.k_a = in[14];
  P.r_k = in[15]; P.ln_g = in[16]; P.ln_b = in[17]; P.q_norm = in[18]; P.k_norm = in[19];
  P.lam_vec = in[20]; P.subln = in[21]; P.ple_proj = in[22]; P.ple_norm = in[23];
  P.gate_w = in[24]; P.gate_b = in[25];
  P.out = (float*)d_out;
  char* ws = (char*)d_ws;
  size_t off = 0;
  auto take = [&](size_t bytes) { char* p = ws + off; off += (bytes + 255) & ~(size_t)255; return p; };
  P.ctr = (int*)take(1024);
  P.consts = (float*)take(1024);
  P.X = (bf16_t*)take((size_t)NTOK * DM * 2);
  P.PB = (bf16_t*)take((size_t)NTOK * DPLE * 2);
  P.RS = (float*)take((size_t)NTOK * 4);
  P.WIN = (bf16_t*)take((size_t)2 * NIN * DM * 2);
  P.WOUT = (bf16_t*)take((size_t)2 * DM * DM * 2);
  P.WPLE = (bf16_t*)take((size_t)2 * DM * DPLE * 2);
  P.WGATE = (bf16_t*)take((size_t)2 * DM * DM * 2);
  P.WUPT = (bf16_t*)take((size_t)4 * 512 * 64 * 2);
  P.AUPT = (bf16_t*)take((size_t)2 * 512 * 64 * 2);
  P.CR = (bf16_t*)take((size_t)GS * CRW * 2);
  P.GRW = (bf16_t*)take((size_t)GS * 512 * 2);
  P.Q = (bf16_t*)take((size_t)GS * 512 * 2);
  P.KB = (bf16_t*)take((size_t)GS * 512 * 2);
  P.VT = (bf16_t*)take((size_t)GS * 512 * 2);
  P.GDA = (bf16_t*)take((size_t)GS * 512 * 2);
  P.YB = (bf16_t*)take((size_t)GS * 512 * 2);
  P.BV = (bf16_t*)take((size_t)GS * 512 * 2);
  P.R1 = P.CR;
  P.R2 = P.GRW;
  P.EPART = (float*)P.VT;
  if (off > ws_size) { fprintf(stderr, "workspace too small: need %zu have %zu\n", off, ws_size); return; }
  hipMemsetAsync(P.ctr, 0, 1024, stream);
  static int grid_blocks = 0;
  if (!grid_blocks) {
    int dev = 0, cus = 0, per_cu = 0;
    hipGetDevice(&dev);
    hipDeviceGetAttribute(&cus, hipDeviceAttributeMultiprocessorCount, dev);
    hipOccupancyMaxActiveBlocksPerMultiprocessor(&per_cu, fwd_megakernel, NTHREADS, 0);
    if (per_cu < 1) { fprintf(stderr, "occupancy query returned %d\n", per_cu); per_cu = 1; }
    grid_blocks = 256;
    if (cus < 256) fprintf(stderr, "unexpected CU count %d\n", cus);
  }
  void* args[] = {&P};
  hipError_t e = hipLaunchCooperativeKernel((void*)fwd_megakernel, dim3(grid_blocks), dim3(NTHREADS), args, 0, stream);
  if (e != hipSuccess) fprintf(stderr, "cooperative launch failed: %s (grid %d)\n", hipGetErrorString(e), grid_blocks);
}
```

```cpp
#include <hip/hip_runtime.h>
#include <hip/hip_cooperative_groups.h>
#include <cstdio>
namespace cg = cooperative_groups;

#define DI __device__ __forceinline__
typedef __attribute__((ext_vector_type(8))) short bf16x8;
typedef __attribute__((ext_vector_type(16))) float f32x16;
typedef __attribute__((ext_vector_type(4))) float f32x4;
typedef __attribute__((ext_vector_type(2))) float f32x2;
typedef __attribute__((ext_vector_type(4))) unsigned u32x4;
typedef __attribute__((ext_vector_type(2))) unsigned u32x2;
typedef unsigned short bf16_t;
#define MFMA(a, b, c) __builtin_amdgcn_mfma_f32_32x32x16_bf16((a), (b), (c), 0, 0, 0)

constexpr int DM = 1024;
constexpr int NP = 16 * 2048;
constexpr int NS = 8 * 8192;
constexpr int NTOK = NP + NS;
constexpr int DPLE = 256;
constexpr int IN_COLS = 4288;
constexpr int NIN = 4352;
constexpr int CRW = 1792;
constexpr int GS = NS;
constexpr float LOG2E = 1.4426950408889634f;
constexpr int NTHREADS = 512;
constexpr int LDS_BYTES = 147456;

struct Params {
  const float* x_prompt; const float* x_sample; const float* p_prompt; const float* p_sample;
  const float* norm_pre; const float* w_in; const float* w_out; const float* conv_w; const float* conv_b;
  const float* w0; const float* w_up; const float* a0; const float* a_up; const float* k_k; const float* k_a;
  const float* r_k; const float* ln_g; const float* ln_b; const float* q_norm; const float* k_norm;
  const float* lam_vec; const float* subln; const float* ple_proj; const float* ple_norm;
  const float* gate_w; const float* gate_b;
  float* out;
  bf16_t* X; bf16_t* PB; float* RS;
  bf16_t* CR; bf16_t* GRW; bf16_t* Q; bf16_t* KB; bf16_t* VT; bf16_t* GDA;
  bf16_t* R1; bf16_t* R2; float* EPART; bf16_t* YB; bf16_t* BV;
  bf16_t* WIN; bf16_t* WOUT; bf16_t* WPLE; bf16_t* WGATE; bf16_t* WUPT; bf16_t* AUPT;
  float* consts; int* ctr;
};

struct Group { int tok0, B, S, ntok; };

DI unsigned pack2(float a, float b) {
  typedef __attribute__((ext_vector_type(2))) __bf16 bf2;
  f32x2 v = {a, b};
  bf2 r = __builtin_convertvector(v, bf2);
  return __builtin_bit_cast(unsigned, r);
}
DI bf16_t f2bf(float a) { return (bf16_t)(pack2(a, 0.f) & 0xffffu); }
DI float bf2f(unsigned short u) { return __uint_as_float(((unsigned)u) << 16); }
DI float bflo(unsigned u) { return __uint_as_float(u << 16); }
DI float bfhi(unsigned u) { return __uint_as_float(u & 0xffff0000u); }
template <int CTRL> DI float dppf(float x) {
  return __int_as_float(__builtin_amdgcn_update_dpp(0, __float_as_int(x), CTRL, 0xF, 0xF, true));
}
DI float red4(float x) { x += dppf<0xB1>(x); x += dppf<0x4E>(x); return x; }
DI float red8(float x) { x = red4(x); x += dppf<0x141>(x); return x; }
DI float red32(float x) {
  x += __shfl_xor(x, 1); x += __shfl_xor(x, 2); x += __shfl_xor(x, 4); x += __shfl_xor(x, 8); x += __shfl_xor(x, 16);
  return x;
}
DI float sigmoidf_(float x) { return __builtin_amdgcn_rcpf(1.f + __expf(-x)); }
DI float siluf_(float x) { return x * __builtin_amdgcn_rcpf(1.f + __expf(-x)); }
DI float tanhf_(float x) { return 1.f - 2.f * __builtin_amdgcn_rcpf(1.f + __expf(2.f * x)); }
DI int opq(int x) { asm volatile("" : "+v"(x)); return x; }
DI int opqs(int x) { asm volatile("" : "+s"(x)); return x; }
DI int crow(int i, int h) { return (i & 3) + 8 * (i >> 2) + 4 * h; }

DI void transpose_convert(const float* __restrict__ src, int K, int N, bf16_t* __restrict__ dst, int Nd, int mode,
                          const float* __restrict__ rowscale, float* lds) {
  const int tid = opq(threadIdx.x);
  const int tk = K >> 6, tn = Nd >> 6;
  for (int t = blockIdx.x; t < tk * tn; t += gridDim.x) {
    const int k0 = (t % tk) << 6, n0 = (t / tk) << 6;
    int sn0 = n0;
    if (mode == 1) sn0 = (n0 < 1728) ? n0 : (n0 < 1792 ? -1 : n0 - 64);
    __syncthreads();
#pragma unroll
    for (int it = 0; it < 2; ++it) {
      const int kk = (tid >> 4) + 32 * it, n4 = (tid & 15) * 4;
      f32x4 v = {0.f, 0.f, 0.f, 0.f};
      if (sn0 >= 0) v = *(const f32x4*)(src + (size_t)(k0 + kk) * N + sn0 + n4);
      const float sc = rowscale ? rowscale[k0 + kk] : 1.f;
      lds[kk * 65 + n4 + 0] = v[0] * sc; lds[kk * 65 + n4 + 1] = v[1] * sc;
      lds[kk * 65 + n4 + 2] = v[2] * sc; lds[kk * 65 + n4 + 3] = v[3] * sc;
    }
    __syncthreads();
    const int nn = tid >> 3, k8 = (tid & 7) * 8;
    u32x4 o;
    o[0] = pack2(lds[(k8 + 0) * 65 + nn], lds[(k8 + 1) * 65 + nn]);
    o[1] = pack2(lds[(k8 + 2) * 65 + nn], lds[(k8 + 3) * 65 + nn]);
    o[2] = pack2(lds[(k8 + 4) * 65 + nn], lds[(k8 + 5) * 65 + nn]);
    o[3] = pack2(lds[(k8 + 6) * 65 + nn], lds[(k8 + 7) * 65 + nn]);
    *(u32x4*)(dst + (size_t)(n0 + nn) * K + k0 + k8) = o;
  }
}

DI void phase_weights(const Params& P, char* lds) {
  float* l = (float*)lds;
  for (int L = 0; L < 2; ++L) {
    transpose_convert(P.w_in + (size_t)L * DM * IN_COLS, DM, IN_COLS, P.WIN + (size_t)L * NIN * DM, NIN, 1, P.norm_pre + L * DM, l);
    transpose_convert(P.w_out + (size_t)L * DM * DM, DM, DM, P.WOUT + (size_t)L * DM * DM, DM, 0, nullptr, l);
    transpose_convert(P.ple_proj + (size_t)L * DPLE * DM, DPLE, DM, P.WPLE + (size_t)L * DM * DPLE, DM, 0, nullptr, l);
    transpose_convert(P.gate_w + (size_t)L * DM * DM, DM, DM, P.WGATE + (size_t)L * DM * DM, DM, 0, nullptr, l);
    for (int d = 0; d < 2; ++d)
      transpose_convert(P.w_up + (size_t)(L * 2 + d) * 64 * 512, 64, 512, P.WUPT + (size_t)(L * 2 + d) * 512 * 64, 512, 0, nullptr, l);
    transpose_convert(P.a_up + (size_t)L * 64 * 512, 64, 512, P.AUPT + (size_t)L * 512 * 64, 512, 0, nullptr, l);
  }
  if (blockIdx.x == 0 && threadIdx.x < 128) {
    const int L = threadIdx.x >> 6, lane = threadIdx.x & 63;
    const float* lv = P.lam_vec + L * 256;
    float s01 = lv[lane] * lv[64 + lane], s23 = lv[128 + lane] * lv[192 + lane];
    float mq = fmaxf(fabsf(P.q_norm[L * 128 + lane]), fabsf(P.q_norm[L * 128 + 64 + lane]));
    float mk = fmaxf(fabsf(P.k_norm[L * 128 + lane]), fabsf(P.k_norm[L * 128 + 64 + lane]));
    for (int o = 32; o >= 1; o >>= 1) {
      s01 += __shfl_xor(s01, o); s23 += __shfl_xor(s23, o);
      mq = fmaxf(mq, __shfl_xor(mq, o)); mk = fmaxf(mk, __shfl_xor(mk, o));
    }
    if (lane == 0) {
      const float lam_init = 0.8f - 0.6f * expf(-0.3f * (float)L);
      P.consts[L * 4 + 0] = expf(s01) - expf(s23) + lam_init;
      P.consts[L * 4 + 1] = 8.25f * mq * mk * LOG2E;
      P.consts[L * 4 + 2] = lam_init;
    }
  }
}

DI void phase_prep(const Params& P, int L) {
  const float* h0 = L == 0 ? P.x_prompt : P.out;
  const float* h1 = L == 0 ? P.x_sample : P.out + (size_t)NP * DM;
  const float* p0 = P.p_prompt + (size_t)L * NP * DPLE;
  const float* p1 = P.p_sample + (size_t)L * NS * DPLE;
  const int tidp = opq(threadIdx.x);
  const int lane = tidp & 63;
  const int gw = blockIdx.x * (NTHREADS / 64) + (tidp >> 6), nw = gridDim.x * (NTHREADS / 64);
  for (int tok = gw; tok < NTOK; tok += nw) {
    const float* hr = tok < NP ? h0 + (size_t)tok * DM : h1 + (size_t)(tok - NP) * DM;
    float ss = 0.f;
#pragma unroll
    for (int i = 0; i < 4; ++i) {
      f32x4 v = *(const f32x4*)(hr + i * 256 + lane * 4);
      ss += v[0] * v[0] + v[1] * v[1] + v[2] * v[2] + v[3] * v[3];
      u32x2 o = {pack2(v[0], v[1]), pack2(v[2], v[3])};
      *(u32x2*)(P.X + (size_t)tok * DM + i * 256 + lane * 4) = o;
    }
    for (int o = 32; o >= 1; o >>= 1) ss += __shfl_xor(ss, o);
    if (lane == 0) P.RS[tok] = rsqrtf(ss * (1.f / DM) + 1e-6f);
    const float* pr = tok < NP ? p0 + (size_t)tok * DPLE : p1 + (size_t)(tok - NP) * DPLE;
    f32x4 v = *(const f32x4*)(pr + lane * 4);
    u32x2 o = {pack2(v[0], v[1]), pack2(v[2], v[3])};
    *(u32x2*)(P.PB + (size_t)tok * DPLE + lane * 4) = o;
  }
}

constexpr int GSTR = 144;
constexpr int GA_BYTES = 256 * GSTR;
constexpr int GSTAGE = 2 * GA_BYTES;

DI void gemm_mainloop(const bf16_t* __restrict__ A, int lda, const bf16_t* __restrict__ Bw, int ldb, int K,
                      int m0, int n0, char* lds, f32x16 (&acc)[2][4]) {
  const int tid = opq(threadIdx.x), lane = tid & 63, w = tid >> 6, hh = lane >> 5, r = lane & 31;
  const int wm = w >> 1, wn = w & 1;
#pragma unroll
  for (int mi = 0; mi < 2; ++mi)
#pragma unroll
    for (int ni = 0; ni < 4; ++ni)
#pragma unroll
      for (int i = 0; i < 16; ++i) acc[mi][ni][i] = 0.f;
  const int lrow = tid >> 3, lkc = tid & 7;
  const bf16_t* ap = A + (size_t)(m0 + lrow) * lda + lkc * 8;
  const bf16_t* bp = Bw + (size_t)(n0 + lrow) * ldb + lkc * 8;
  const int nk = K >> 6;
  u32x4 ra[4], rb[4];
#pragma unroll
  for (int i = 0; i < 4; ++i) {
    ra[i] = *(const u32x4*)(ap + (size_t)(64 * i) * lda);
    rb[i] = *(const u32x4*)(bp + (size_t)(64 * i) * ldb);
  }
  __syncthreads();
#pragma unroll
  for (int i = 0; i < 4; ++i) {
    *(u32x4*)(lds + (lrow + 64 * i) * GSTR + lkc * 16) = ra[i];
    *(u32x4*)(lds + GA_BYTES + (lrow + 64 * i) * GSTR + lkc * 16) = rb[i];
  }
  __syncthreads();
  for (int kt = 0; kt < nk; ++kt) {
    const bool more = kt + 1 < nk;
    if (more) {
#pragma unroll
      for (int i = 0; i < 4; ++i) {
        ra[i] = *(const u32x4*)(ap + (size_t)(64 * i) * lda + (kt + 1) * 64);
        rb[i] = *(const u32x4*)(bp + (size_t)(64 * i) * ldb + (kt + 1) * 64);
      }
    }
    __builtin_amdgcn_sched_barrier(0);
    const char* sa = lds + (kt & 1) * GSTAGE + (wm * 64 + r) * GSTR + hh * 16;
    const char* sb = lds + (kt & 1) * GSTAGE + GA_BYTES + (wn * 128 + r) * GSTR + hh * 16;
    bf16x8 fa[2][2], fb[2][4];
#pragma unroll
    for (int mi = 0; mi < 2; ++mi) fa[0][mi] = *(const bf16x8*)(sa + mi * 32 * GSTR);
#pragma unroll
    for (int ni = 0; ni < 4; ++ni) fb[0][ni] = *(const bf16x8*)(sb + ni * 32 * GSTR);
#pragma unroll
    for (int ks = 0; ks < 4; ++ks) {
      if (ks < 3) {
#pragma unroll
        for (int mi = 0; mi < 2; ++mi) fa[(ks + 1) & 1][mi] = *(const bf16x8*)(sa + mi * 32 * GSTR + (ks + 1) * 32);
#pragma unroll
        for (int ni = 0; ni < 4; ++ni) fb[(ks + 1) & 1][ni] = *(const bf16x8*)(sb + ni * 32 * GSTR + (ks + 1) * 32);
      }
      __builtin_amdgcn_sched_barrier(0);
#pragma unroll
      for (int mi = 0; mi < 2; ++mi)
#pragma unroll
        for (int ni = 0; ni < 4; ++ni) acc[mi][ni] = MFMA(fb[ks & 1][ni], fa[ks & 1][mi], acc[mi][ni]);
      __builtin_amdgcn_sched_barrier(0);
    }
    if (more) {
      char* d = lds + ((kt + 1) & 1) * GSTAGE;
#pragma unroll
      for (int i = 0; i < 4; ++i) {
        *(u32x4*)(d + (lrow + 64 * i) * GSTR + lkc * 16) = ra[i];
        *(u32x4*)(d + GA_BYTES + (lrow + 64 * i) * GSTR + lkc * 16) = rb[i];
      }
    }
    __syncthreads();
  }
}

DI bool xcd_tile(int rd, int nM, int nN, int& mt, int& nt) {
  const int xcd = blockIdx.x & 7, j = blockIdx.x >> 3;
  const int u = (rd * 8 + xcd) * 32 + j;
  if (u >= nM * nN) return false;
  const int band = u / (8 * nN), rem = u % (8 * nN);
  nt = rem >> 3; mt = band * 8 + (rem & 7);
  return true;
}

DI void phase_inproj(const Params& P, int L, const Group& G, char* lds) {
  const int tid = opq(threadIdx.x), lane = tid & 63, w = tid >> 6, hh = lane >> 5, r = lane & 31;
  const int wm = w >> 1, wn = w & 1;
  const int nmt = G.ntok >> 8, ntile = nmt * 17;
  const bf16_t* A = P.X + (size_t)G.tok0 * DM;
  const bf16_t* Bw = P.WIN + (size_t)L * NIN * DM;
  for (int rd = 0; rd * 256 < ntile; ++rd) {
    int mt, nt;
    if (!xcd_tile(rd, nmt, 17, mt, nt)) continue;
    const int m0 = mt << 8, n0 = nt << 8;
    f32x16 acc[2][4];
    gemm_mainloop(A, DM, Bw, DM, DM, m0, n0, lds, acc);
    const int colw = n0 + wn * 128 + 4 * hh;
    if (nt < 7) {
#pragma unroll
      for (int mi = 0; mi < 2; ++mi) {
        const int row = m0 + wm * 64 + mi * 32 + r;
        const float rsv = P.RS[G.tok0 + row];
        bf16_t* dst = P.CR + (size_t)row * CRW + colw;
#pragma unroll
        for (int ni = 0; ni < 4; ++ni)
#pragma unroll
          for (int q4 = 0; q4 < 4; ++q4) {
            u32x2 o = {pack2(acc[mi][ni][4 * q4] * rsv, acc[mi][ni][4 * q4 + 1] * rsv),
                       pack2(acc[mi][ni][4 * q4 + 2] * rsv, acc[mi][ni][4 * q4 + 3] * rsv)};
            *(u32x2*)(dst + ni * 32 + q4 * 8) = o;
          }
      }
    } else if (nt < 9 || nt >= 15) {
      bf16_t* dbase = nt < 9 ? P.GRW : P.GDA;
      const int c0 = colw - (nt < 9 ? 1792 : 3840);
#pragma unroll
      for (int mi = 0; mi < 2; ++mi) {
        const int row = m0 + wm * 64 + mi * 32 + r;
        const float rsv = P.RS[G.tok0 + row];
        bf16_t* dst = dbase + (size_t)row * 512 + c0;
#pragma unroll
        for (int ni = 0; ni < 4; ++ni)
#pragma unroll
          for (int q4 = 0; q4 < 4; ++q4) {
            u32x2 o = {pack2(siluf_(acc[mi][ni][4 * q4] * rsv), siluf_(acc[mi][ni][4 * q4 + 1] * rsv)),
                       pack2(siluf_(acc[mi][ni][4 * q4 + 2] * rsv), siluf_(acc[mi][ni][4 * q4 + 3] * rsv))};
            *(u32x2*)(dst + ni * 32 + q4 * 8) = o;
          }
      }
    } else if (nt < 13) {
      const bool isq = nt < 11;
      bf16_t* dbase = isq ? P.Q : P.KB;
      const int c0 = colw - (isq ? 2304 : 2816);
      const float* g = (isq ? P.q_norm : P.k_norm) + L * 128 + 4 * hh;
      const float osc = isq ? 0.125f * LOG2E : 1.f;
#pragma unroll
      for (int mi = 0; mi < 2; ++mi) {
        const int row = m0 + wm * 64 + mi * 32 + r;
        const float rsv = P.RS[G.tok0 + row];
        bf16_t* dst = dbase + (size_t)row * 512 + c0;
#pragma unroll
        for (int gi = 0; gi < 2; ++gi) {
          float ss = 0.f;
#pragma unroll
          for (int t2 = 0; t2 < 2; ++t2)
#pragma unroll
            for (int i = 0; i < 16; ++i) { const float v = acc[mi][2 * gi + t2][i] * rsv; ss += v * v; }
          ss += __shfl_xor(ss, 32);
          const float sc = rsqrtf(ss * (1.f / 64.f) + 1e-6f) * rsv * osc;
#pragma unroll
          for (int t2 = 0; t2 < 2; ++t2)
#pragma unroll
            for (int q4 = 0; q4 < 4; ++q4) {
              const f32x4 gv = *(const f32x4*)(g + gi * 64 + t2 * 32 + q4 * 8);
              u32x2 o = {pack2(acc[mi][2 * gi + t2][4 * q4] * sc * gv[0], acc[mi][2 * gi + t2][4 * q4 + 1] * sc * gv[1]),
                         pack2(acc[mi][2 * gi + t2][4 * q4 + 2] * sc * gv[2], acc[mi][2 * gi + t2][4 * q4 + 3] * sc * gv[3])};
              *(u32x2*)(dst + (2 * gi + t2) * 32 + q4 * 8) = o;
            }
        }
      }
    } else {
      const int hd = (n0 + wn * 128 - 3328) >> 7;
      const int row0 = m0 + wm * 64;
      const int b = row0 / G.S, s0 = row0 % G.S;
#pragma unroll
      for (int mi = 0; mi < 2; ++mi) {
        const int s = s0 + mi * 32 + r;
        const float rsv = P.RS[G.tok0 + b * G.S + s];
        bf16_t* dst = P.VT + ((size_t)((b * 4 + hd) * 128 + 4 * hh)) * G.S + s;
        const size_t Sz = (size_t)G.S;
#pragma unroll
        for (int ni = 0; ni < 4; ++ni)
#pragma unroll
          for (int q4 = 0; q4 < 4; ++q4) {
            bf16_t* pq = dst + (size_t)(ni * 32 + 8 * q4) * Sz;
            pq[0] = f2bf(acc[mi][ni][4 * q4] * rsv);
            pq[Sz] = f2bf(acc[mi][ni][4 * q4 + 1] * rsv);
            pq[2 * Sz] = f2bf(acc[mi][ni][4 * q4 + 2] * rsv);
            pq[3 * Sz] = f2bf(acc[mi][ni][4 * q4 + 3] * rsv);
            __builtin_amdgcn_sched_barrier(0);
          }
      }
    }
  }
}

DI void phase_outproj(const Params& P, int L, char* lds) {
  const int tid = opq(threadIdx.x), lane = tid & 63, w = tid >> 6, hh = lane >> 5, r = lane & 31;
  const int wm = w >> 1, wn = w & 1;
  const float* h0 = L == 0 ? P.x_prompt : P.out;
  const float* h1 = L == 0 ? P.x_sample : P.out + (size_t)NP * DM;
  const int nmt = NTOK >> 8, ntile = nmt * 4;
  for (int rd2 = 0; rd2 * 256 < 2 * ntile; ++rd2) {
    const bool isE = rd2 * 256 >= ntile;
    int mt, nt;
    if (!xcd_tile(isE ? rd2 - ntile / 256 : rd2, nmt, 4, mt, nt)) continue;
    const int m0 = mt << 8, n0 = nt << 8;
    const int colw = n0 + wn * 128 + 4 * hh;
    f32x16 acc[2][4];
    if (!isE) {
      gemm_mainloop(P.X, DM, P.WOUT + (size_t)L * DM * DM, DM, DM, m0, n0, lds, acc);
#pragma unroll
      for (int mi = 0; mi < 2; ++mi) {
        const int row = m0 + wm * 64 + mi * 32 + r;
        const float* hr = (row < NP ? h0 + (size_t)row * DM : h1 + (size_t)(row - NP) * DM) + colw;
        float* op = P.out + (size_t)row * DM + colw;
        bf16_t* rp = P.R1 + (size_t)row * DM + colw;
#pragma unroll
        for (int ni = 0; ni < 4; ++ni)
#pragma unroll
          for (int q4 = 0; q4 < 4; ++q4) {
            f32x4 hv = *(const f32x4*)(hr + ni * 32 + q4 * 8);
            hv[0] += acc[mi][ni][4 * q4]; hv[1] += acc[mi][ni][4 * q4 + 1];
            hv[2] += acc[mi][ni][4 * q4 + 2]; hv[3] += acc[mi][ni][4 * q4 + 3];
            *(f32x4*)(op + ni * 32 + q4 * 8) = hv;
            u32x2 o = {pack2(hv[0], hv[1]), pack2(hv[2], hv[3])};
            *(u32x2*)(rp + ni * 32 + q4 * 8) = o;
          }
      }
    } else {
      gemm_mainloop(P.PB, DPLE, P.WPLE + (size_t)L * DM * DPLE, DPLE, DPLE, m0, n0, lds, acc);
#pragma unroll
      for (int mi = 0; mi < 2; ++mi) {
        const int row = m0 + wm * 64 + mi * 32 + r;
        bf16_t* rp = P.R2 + (size_t)row * DM + colw;
        float ss = 0.f;
#pragma unroll
        for (int ni = 0; ni < 4; ++ni)
#pragma unroll
          for (int q4 = 0; q4 < 4; ++q4) {
            const float v0 = acc[mi][ni][4 * q4], v1 = acc[mi][ni][4 * q4 + 1], v2 = acc[mi][ni][4 * q4 + 2], v3 = acc[mi][ni][4 * q4 + 3];
            ss += v0 * v0 + v1 * v1 + v2 * v2 + v3 * v3;
            u32x2 o = {pack2(v0, v1), pack2(v2, v3)};
            *(u32x2*)(rp + ni * 32 + q4 * 8) = o;
          }
        ss += __shfl_xor(ss, 32);
        if (hh == 0) P.EPART[(size_t)(nt * 2 + wn) * NTOK + row] = ss;
      }
    }
  }
}

DI void phase_gate(const Params& P, int L, char* lds) {
  const int tid = opq(threadIdx.x), lane = tid & 63, w = tid >> 6, hh = lane >> 5, r = lane & 31;
  const int wm = w >> 1, wn = w & 1;
  const int nmt = NTOK >> 8, ntile = nmt * 4;
  for (int rd = 0; rd * 256 < ntile; ++rd) {
    int mt, nt;
    if (!xcd_tile(rd, nmt, 4, mt, nt)) continue;
    const int m0 = mt << 8, n0 = nt << 8;
    const int colw = n0 + wn * 128 + 4 * hh;
    f32x16 acc[2][4];
    gemm_mainloop(P.R1, DM, P.WGATE + (size_t)L * DM * DM, DM, DM, m0, n0, lds, acc);
    const float* gbp = P.gate_b + L * DM + colw;
    const float* pnp = P.ple_norm + L * DM + colw;
#pragma unroll
    for (int mi = 0; mi < 2; ++mi) {
      const int row = m0 + wm * 64 + mi * 32 + r;
      float es = 0.f;
#pragma unroll
      for (int j = 0; j < 8; ++j) es += P.EPART[(size_t)j * NTOK + row];
      const float rse = rsqrtf(es * (1.f / DM) + 1e-6f);
      float* op = P.out + (size_t)row * DM + colw;
      const bf16_t* ep = P.R2 + (size_t)row * DM + colw;
#pragma unroll
      for (int ni = 0; ni < 4; ++ni)
#pragma unroll
        for (int q4 = 0; q4 < 4; ++q4) {
          const int co = ni * 32 + q4 * 8;
          const f32x4 gb = *(const f32x4*)(gbp + co), pn = *(const f32x4*)(pnp + co);
          const u32x2 ev = *(const u32x2*)(ep + co);
          f32x4 hv = *(const f32x4*)(op + co);
          hv[0] += sigmoidf_(acc[mi][ni][4 * q4] + gb[0]) * (bflo(ev[0]) * rse * pn[0]);
          hv[1] += sigmoidf_(acc[mi][ni][4 * q4 + 1] + gb[1]) * (bfhi(ev[0]) * rse * pn[1]);
          hv[2] += sigmoidf_(acc[mi][ni][4 * q4 + 2] + gb[2]) * (bflo(ev[1]) * rse * pn[2]);
          hv[3] += sigmoidf_(acc[mi][ni][4 * q4 + 3] + gb[3]) * (bfhi(ev[1]) * rse * pn[3]);
          *(f32x4*)(op + co) = hv;
        }
    }
  }
}

constexpr int TC = 32;
constexpr int CB_OP = TC * 64 * 4;
constexpr int CB_BYTES = 6 * CB_OP + 128 + 1024;
constexpr int PW_BYTES = 10 * 640 + 2 * 8 * 144;
constexpr int PW_BASE = 2 * CB_BYTES;

template <int N> DI void red64v(float (&x)[N]) {
#pragma unroll
  for (int i = 0; i < N; ++i) x[i] += dppf<0xB1>(x[i]);
#pragma unroll
  for (int i = 0; i < N; ++i) x[i] += dppf<0x4E>(x[i]);
#pragma unroll
  for (int i = 0; i < N; ++i) x[i] += dppf<0x141>(x[i]);
#pragma unroll
  for (int i = 0; i < N; ++i) x[i] += dppf<0x140>(x[i]);
#pragma unroll
  for (int i = 0; i < N; ++i) x[i] += __shfl_xor(x[i], 16);
#pragma unroll
  for (int i = 0; i < N; ++i) x[i] += __shfl_xor(x[i], 32);
}

struct ScanOps { f32x4 a0, a1, b0, b1, k0, k1, r0, r1; f32x2 v; };

DI ScanOps scan_load(const float* __restrict__ ob, int s, int coff, int row0) {
  ScanOps o;
  const float* p = ob + s * 64 + coff;
  o.a0 = *(const f32x4*)(p + TC * 64);       o.a1 = *(const f32x4*)(p + TC * 64 + 4);
  o.b0 = *(const f32x4*)(p + 2 * TC * 64);   o.b1 = *(const f32x4*)(p + 2 * TC * 64 + 4);
  o.k0 = *(const f32x4*)(p + 3 * TC * 64);   o.k1 = *(const f32x4*)(p + 3 * TC * 64 + 4);
  o.r0 = *(const f32x4*)(p + 4 * TC * 64);   o.r1 = *(const f32x4*)(p + 4 * TC * 64 + 4);
  o.v = *(const f32x2*)(ob + 5 * TC * 64 + s * 64 + row0);
  return o;
}

DI f32x2 lo2(f32x4 x) { return f32x2{x[0], x[1]}; }
DI f32x2 hi2(f32x4 x) { return f32x2{x[2], x[3]}; }

DI f32x2 scan_step(f32x2 (&st)[2][4], const ScanOps& o) {
  const f32x2 a[4] = {lo2(o.a0), hi2(o.a0), lo2(o.a1), hi2(o.a1)};
  const f32x2 bv[4] = {lo2(o.b0), hi2(o.b0), lo2(o.b1), hi2(o.b1)};
  const f32x2 kv[4] = {lo2(o.k0), hi2(o.k0), lo2(o.k1), hi2(o.k1)};
  const f32x2 rv[4] = {lo2(o.r0), hi2(o.r0), lo2(o.r1), hi2(o.r1)};
  f32x2 y;
#pragma unroll
  for (int rr = 0; rr < 2; ++rr) {
    f32x2 p = st[rr][0] * a[0];
    p = st[rr][1] * a[1] + p; p = st[rr][2] * a[2] + p; p = st[rr][3] * a[3] + p;
    const float sa = red8(p[0] + p[1]);
    const f32x2 sa2 = {sa, sa};
    const f32x2 v2 = {o.v[rr], o.v[rr]};
    f32x2 q = {0.f, 0.f};
#pragma unroll
    for (int j = 0; j < 4; ++j) {
      f32x2 x = sa2 * bv[j] + st[rr][j];
      x = v2 * kv[j] + x;
      st[rr][j] = x;
      q = x * rv[j] + q;
    }
    y[rr] = red8(q[0] + q[1]);
  }
  return y;
}

DI void scan_task(const Params& P, int L_, const Group& G, int task, char* lds) {
  const int L = opqs(__builtin_amdgcn_readfirstlane(L_));
  const int tid = opq(threadIdx.x), lane = tid & 63, w = tid >> 6;
  const int dir = task & 1, b = task >> 4, hd = (task >> 1) & 7;
  const int S = G.S, nc = S / TC;
  const int sg = dir ? -1 : 1;
  const bf16_t* crb = P.CR + (size_t)b * S * CRW;

  const int srow0 = (w & 3) * 16 + (lane >> 3) * 2, scs = lane & 7;
  f32x2 st[2][4];
#pragma unroll
  for (int rr = 0; rr < 2; ++rr)
#pragma unroll
    for (int j = 0; j < 4; ++j) st[rr][j] = f32x2{0.f, 0.f};

  const int pw = w & 3, ec = lane, hh = lane >> 5, r = lane & 31;
  char* pwb = lds + PW_BASE + pw * PW_BYTES;
  const int ch = hd * 64 + ec;
  const float c_kk = P.k_k[L * 512 + ch], c_ka = P.k_a[L * 512 + ch], c_rk = P.r_k[L * 512 + ch];
  const float* cw = P.conv_w + (size_t)L * 3 * 1728;
  const float* cb = P.conv_b + (size_t)L * 1728;
  const bf16_t* wsrcW = P.WUPT + (size_t)(L * 2 + dir) * 512 * 64 + (size_t)(hd * 64 + r) * 64 + hh * 8;
  const bf16_t* wsrcA = P.AUPT + (size_t)L * 512 * 64 + (size_t)(hd * 64 + r) * 64 + hh * 8;
  const float* w0p = P.w0 + (size_t)(L * 2 + dir) * 512 + hd * 64 + r;
  const float* a0p = P.a0 + (size_t)L * 512 + hd * 64 + r;

  auto prepare = [&](int cc, char* cbuf) {
    float* oW = (float*)cbuf; float* oA = (float*)(cbuf + CB_OP); float* oB = (float*)(cbuf + 2 * CB_OP);
    float* oK = (float*)(cbuf + 3 * CB_OP); float* oR = (float*)(cbuf + 4 * CB_OP); float* oV = (float*)(cbuf + 5 * CB_OP);
    float* oBon = (float*)(cbuf + 6 * CB_OP);
    const int ln = opq(lane);
    const int tbase = dir ? S - cc * TC - 8 * pw - 9 : cc * TC + 8 * pw - 1;
    {
      u32x4 rv[7];
#pragma unroll
      for (int it = 0; it < 7; ++it) {
        int id = ln + it * 64;
        id = id < 400 ? id : 399;
        const int rr = id / 40, cc8 = id % 40, q = cc8 >> 3, c8 = (cc8 & 7) * 8;
        const int tok = tbase + rr;
        const bool ok = tok >= 0 && tok < S;
        const int tokc = tok < 0 ? 0 : (tok >= S ? S - 1 : tok);
        const int col = (q == 0 ? hd * 64 : q == 1 ? 512 + hd * 64 : q == 2 ? 1024 + hd * 64 : q == 3 ? 1536 + dir * 64 : 1664) + c8;
        const u32x4 v = *(const u32x4*)(crb + (size_t)tokc * CRW + col);
        const u32x4 z = {0u, 0u, 0u, 0u};
        rv[it] = ok ? v : z;
      }
#pragma unroll
      for (int it = 0; it < 7; ++it) {
        int id = ln + it * 64;
        id = id < 400 ? id : 399;
        *(u32x4*)(pwb + (id / 40) * 640 + (id % 40) * 16) = rv[it];
      }
    }
    asm volatile("" ::: "memory");
    float cwp[5], cwc[5], cwn[5], cbb[5];
#pragma unroll
    for (int q = 0; q < 5; ++q) {
      const int cqq = (q == 0 ? hd * 64 : q == 1 ? 512 + hd * 64 : q == 2 ? 1024 + hd * 64 : q == 3 ? 1536 + dir * 64 : 1664) + ln;
      const float w0 = cw[cqq], w1 = cw[1728 + cqq], w2 = cw[2 * 1728 + cqq];
      cwp[q] = dir ? w2 : w0; cwc[q] = w1; cwn[q] = dir ? w0 : w2; cbb[q] = cb[cqq];
    }
    bf16x8 lf[2][2][4];
#pragma unroll
    for (int nb = 0; nb < 2; ++nb)
#pragma unroll
      for (int ks = 0; ks < 4; ++ks) {
        lf[0][nb][ks] = *(const bf16x8*)(wsrcW + nb * 32 * 64 + ks * 16);
        lf[1][nb][ks] = *(const bf16x8*)(wsrcA + nb * 32 * 64 + ks * 16);
      }
    const bf16_t* raw = (const bf16_t*)pwb;
    bf16_t* zt = (bf16_t*)(pwb + 6400); bf16_t* za = (bf16_t*)(pwb + 6400 + 8 * 144);
    float kreg[8];
#pragma unroll
    for (int hf = 0; hf < 2; ++hf) {
      float xr[6][5];
#pragma unroll
      for (int j = 0; j < 6; ++j) {
        const int vi = hf * 4 + j - 1;
        const int jj = dir ? 8 - vi : vi + 1;
#pragma unroll
        for (int q = 0; q < 5; ++q) xr[j][q] = bf2f(raw[jj * 320 + q * 64 + ln]);
      }
#pragma unroll
      for (int i = 0; i < 4; ++i) {
        float v[5];
#pragma unroll
        for (int q = 0; q < 5; ++q) v[q] = cbb[q] + cwp[q] * xr[i][q] + cwc[q] * xr[i + 1][q] + cwn[q] * xr[i + 2][q];
        const int ti = hf * 4 + i, s = 8 * pw + ti;
        oR[s * 64 + ln] = v[0];
        kreg[ti] = v[1];
        oV[s * 64 + ln] = v[2];
        zt[ti * 72 + ln] = f2bf(tanhf_(v[3]));
        za[ti * 72 + ln] = f2bf(v[4]);
      }
    }
    asm volatile("" ::: "memory");
    {
      const char* az = (const char*)zt + (r & 7) * 144 + hh * 16;
      const char* aa = (const char*)za + (r & 7) * 144 + hh * 16;
#pragma unroll
      for (int nb = 0; nb < 2; ++nb) {
        f32x16 accw, acca;
#pragma unroll
        for (int i = 0; i < 16; ++i) { accw[i] = 0.f; acca[i] = 0.f; }
#pragma unroll
        for (int ks = 0; ks < 4; ++ks) {
          const bf16x8 fz = *(const bf16x8*)(az + ks * 32);
          const bf16x8 fa = *(const bf16x8*)(aa + ks * 32);
          accw = MFMA(fz, lf[0][nb][ks], accw);
          acca = MFMA(fa, lf[1][nb][ks], acca);
        }
        const float w0v = w0p[nb * 32], a0v = a0p[nb * 32];
#pragma unroll
        for (int i = 0; i < 4; ++i) {
          const int s = 8 * pw + 4 * hh + i;
          oW[s * 64 + nb * 32 + r] = __expf(-0.6065306597126334f * sigmoidf_(w0v + accw[i]));
          oA[s * 64 + nb * 32 + r] = sigmoidf_(a0v + acca[i]);
        }
      }
    }
    asm volatile("" ::: "memory");
    {
      float ag[8], kk[8], ss[8], km[8], bn[8];
#pragma unroll
      for (int i = 0; i < 8; ++i) {
        const int s = 8 * pw + i;
        ag[i] = oA[s * 64 + ln];
        kk[i] = kreg[i] * c_kk;
        ss[i] = kk[i] * kk[i];
        km[i] = kreg[i] * (1.f + (ag[i] - 1.f) * c_ka);
        bn[i] = oR[s * 64 + ln] * km[i] * c_rk;
      }
      red64v<8>(ss);
      red64v<8>(bn);
      float g = 1.f;
#pragma unroll
      for (int i = 0; i < 8; ++i) {
        const int s = 8 * pw + i;
        const float kn = kk[i] * rsqrtf(ss[i] + 1e-12f);
        const float gprev = g;
        g *= oW[s * 64 + ln];
        const float ginv = __builtin_amdgcn_rcpf(g);
        oK[s * 64 + ln] = km[i] * ginv;
        oA[s * 64 + ln] = -kn * gprev;
        oB[s * 64 + ln] = kn * ag[i] * ginv;
        oR[s * 64 + ln] = oR[s * 64 + ln] * g;
        if (ln == 0) oBon[s] = bn[i];
      }
      ((float*)(cbuf + 6 * CB_OP + 128))[pw * 64 + ln] = g;
    }
  };

  __syncthreads();
  if (w >= 4) prepare(0, lds);
  __syncthreads();
  if (__builtin_amdgcn_readfirstlane(w) < 4) __builtin_amdgcn_s_setprio(2);

  for (int c = 0; c < nc; ++c) {
    char* cbuf = lds + (c & 1) * CB_BYTES;
    if (w < 4) {
      const float* sb = (const float*)cbuf;
      const float* oBon = (const float*)(cbuf + 6 * CB_OP);
      ScanOps cur = scan_load(sb, 0, scs * 8, srow0);
#pragma unroll 1
      for (int s8 = 0; s8 < TC; s8 += 8) {
        f32x2 ykeep = {0.f, 0.f};
#pragma unroll
        for (int u = 0; u < 8; ++u) {
          const int s = s8 + u;
          const ScanOps nxt = scan_load(sb, s + 1 < TC ? s + 1 : s, scs * 8, srow0);
          const f32x2 y = scan_step(st, cur);
          if (u == scs) ykeep = y;
          cur = nxt;
        }
        {
          const float* g8 = (const float*)(cbuf + 6 * CB_OP + 128) + (s8 >> 3) * 64 + scs * 8;
          const f32x4 ga = *(const f32x4*)g8, gb = *(const f32x4*)(g8 + 4);
          const f32x2 gg[4] = {lo2(ga), hi2(ga), lo2(gb), hi2(gb)};
#pragma unroll
          for (int rr = 0; rr < 2; ++rr)
#pragma unroll
            for (int j = 0; j < 4; ++j) st[rr][j] = st[rr][j] * gg[j];
        }
        const int s = s8 + scs;
        const int ts = dir ? S - 1 - (c * TC + s) : c * TC + s;
        const size_t lt = (size_t)b * S + ts;
        const unsigned yv = pack2(ykeep[0], ykeep[1]);
        if (dir == 0) {
          *(unsigned*)(P.X + ((size_t)G.tok0 + lt) * DM + hd * 64 + srow0) = yv;
          const float bon = oBon[s];
          const f32x2 vv = *(const f32x2*)(sb + 5 * TC * 64 + s * 64 + srow0);
          *(unsigned*)(P.BV + lt * 512 + hd * 64 + srow0) = pack2(bon * vv[0], bon * vv[1]);
        } else {
          *(unsigned*)(P.YB + lt * 512 + hd * 64 + srow0) = yv;
        }
      }
    } else if (c + 1 < nc) {
      prepare(c + 1, lds + ((c + 1) & 1) * CB_BYTES);
    }
    __syncthreads();
  }
  __builtin_amdgcn_s_setprio(0);
}

DI void phase_rwkv_final(const Params& P, int L, const Group& G) {
  const int tidp = opq(threadIdx.x);
  const int lane = tidp & 63;
  const int gw = blockIdx.x * (NTHREADS / 64) + (tidp >> 6), nw = gridDim.x * (NTHREADS / 64);
  const f32x4 g0 = *(const f32x4*)(P.ln_g + L * 512 + lane * 8), g1 = *(const f32x4*)(P.ln_g + L * 512 + lane * 8 + 4);
  const f32x4 b0 = *(const f32x4*)(P.ln_b + L * 512 + lane * 8), b1 = *(const f32x4*)(P.ln_b + L * 512 + lane * 8 + 4);
  const float lg[8] = {g0[0], g0[1], g0[2], g0[3], g1[0], g1[1], g1[2], g1[3]};
  const float lb[8] = {b0[0], b0[1], b0[2], b0[3], b1[0], b1[1], b1[2], b1[3]};
  for (int lt = gw; lt < G.ntok; lt += nw) {
    bf16_t* xp = P.X + ((size_t)G.tok0 + lt) * DM + lane * 8;
    const u32x4 yf = *(const u32x4*)xp;
    const u32x4 yb = *(const u32x4*)(P.YB + (size_t)lt * 512 + lane * 8);
    const u32x4 bv = *(const u32x4*)(P.BV + (size_t)lt * 512 + lane * 8);
    const u32x4 gt = *(const u32x4*)(P.GRW + (size_t)lt * 512 + lane * 8);
    float y[8];
    float sum = 0.f;
#pragma unroll
    for (int j = 0; j < 4; ++j) {
      y[2 * j] = bflo(yf[j]) + bflo(yb[j]); y[2 * j + 1] = bfhi(yf[j]) + bfhi(yb[j]);
      sum += y[2 * j] + y[2 * j + 1];
    }
    const float mu = red8(sum) * (1.f / 64.f);
    float vs = 0.f;
#pragma unroll
    for (int j = 0; j < 8; ++j) { y[j] -= mu; vs += y[j] * y[j]; }
    const float rstd = rsqrtf(red8(vs) * (1.f / 64.f) + 64e-5f);
    u32x4 o;
#pragma unroll
    for (int j = 0; j < 4; ++j) {
      const float o0 = (y[2 * j] * rstd * lg[2 * j] + lb[2 * j] + bflo(bv[j])) * bflo(gt[j]);
      const float o1 = (y[2 * j + 1] * rstd * lg[2 * j + 1] + lb[2 * j + 1] + bfhi(bv[j])) * bfhi(gt[j]);
      o[j] = pack2(o0, o1);
    }
    *(u32x4*)xp = o;
  }
}

constexpr int AT_K = 64 * GSTR;
constexpr int AT_STAGE = 2 * AT_K + 128 * GSTR;

DI void attn_item(const Params& P, int L_, const Group& G, int item, char* lds) {
  const int L = opqs(__builtin_amdgcn_readfirstlane(L_));
  const int tid = opq(threadIdx.x), lane = tid & 63, w = tid >> 6, hh = lane >> 5, r = lane & 31;
  const int S = G.S, nqb = S >> 7;
  const int qblk = item % nqb, bh = item / nqb, hd = bh & 3, b = bh >> 2;
  const int map = w & 1, qb = w >> 1;
  const int q0 = qblk * 128 + qb * 32;
  const size_t ltq = (size_t)b * S + q0 + r;
  bf16x8 qf[4];
  {
    const bf16_t* qp = P.Q + ltq * 512 + hd * 128 + map * 64 + hh * 8;
#pragma unroll
    for (int ks = 0; ks < 4; ++ks) qf[ks] = *(const bf16x8*)(qp + ks * 16);
  }
  f32x16 o[4];
#pragma unroll
  for (int d = 0; d < 4; ++d)
#pragma unroll
    for (int i = 0; i < 16; ++i) o[d][i] = 0.f;
  f32x16 accl;
#pragma unroll
  for (int i = 0; i < 16; ++i) accl[i] = 0.f;
  const float slope2 = exp2f(-2.f * (float)(hd + 1)) * LOG2E;
  float so[16];
#pragma unroll
  for (int i = 0; i < 16; ++i) so[i] = slope2 * (float)(16 * (i >> 3) + (i & 7));
  bf16x8 ones;
#pragma unroll
  for (int j = 0; j < 8; ++j) ones[j] = (short)0x3F80;
  const float lam = P.consts[L * 4 + 0], C2 = P.consts[L * 4 + 1], lam_init = P.consts[L * 4 + 2];
  const float qposf = (float)(q0 + r);
  const int Dz = (int)ceilf(150.f / slope2);
  const int Q0 = qblk * 128;
  const int tlo = (Q0 - 63 - Dz) < 0 ? 0 : (Q0 - 63 - Dz) / 64 + 1;
  const int thx = min(S >> 6, (Q0 + 127 + Dz + 63) / 64);
  const int nt = thx - tlo;
  const int lrow = tid >> 3, lck = tid & 7;
  const bf16_t* k0p = P.KB + ((size_t)b * S + tlo * 64 + lrow) * 512 + hd * 128 + lck * 8;
  const bf16_t* v0p = P.VT + ((size_t)((b * 4 + hd) * 128 + lrow)) * S + tlo * 64 + lck * 8;
  u32x4 ra0, ra1, ra2, ra3, rb0, rb1, rb2, rb3;
  auto ldtile = [&](int tt, u32x4& x0, u32x4& x1, u32x4& x2, u32x4& x3) {
    const int tc = tt < nt ? tt : nt - 1;
    x0 = *(const u32x4*)(k0p + (size_t)tc * 64 * 512); x1 = *(const u32x4*)(k0p + (size_t)tc * 64 * 512 + 64);
    x2 = *(const u32x4*)(v0p + tc * 64); x3 = *(const u32x4*)(v0p + (size_t)64 * S + tc * 64);
  };
  auto sttile = [&](int slot, const u32x4& x0, const u32x4& x1, const u32x4& x2, const u32x4& x3) {
    char* d = lds + slot * AT_STAGE;
    *(u32x4*)(d + lrow * GSTR + lck * 16) = x0;
    *(u32x4*)(d + AT_K + lrow * GSTR + lck * 16) = x1;
    *(u32x4*)(d + 2 * AT_K + lrow * GSTR + lck * 16) = x2;
    *(u32x4*)(d + 2 * AT_K + (lrow + 64) * GSTR + lck * 16) = x3;
  };
  ldtile(0, ra0, ra1, ra2, ra3);
  ldtile(1, rb0, rb1, rb2, rb3);
  __syncthreads();
  sttile(0, ra0, ra1, ra2, ra3);
  ldtile(2, ra0, ra1, ra2, ra3);
  __syncthreads();
  const int krow = (r & ~12) | ((r & 4) << 1) | ((r & 8) >> 1);
  auto compute = [&](int t) {
    const char* kbuf = lds + (t & 1) * AT_STAGE + map * AT_K;
    const char* vbuf = lds + (t & 1) * AT_STAGE + 2 * AT_K;
    f32x16 s0, s1;
    const int kt0 = (tlo + t) * 64;
    const float base = (float)(kt0 + 8 * hh) - qposf;
    if (kt0 + 63 < q0) {
      const float bl = fmaf(slope2, base, -C2), bl2 = bl + 32.f * slope2;
#pragma unroll
      for (int i = 0; i < 16; ++i) { s0[i] = bl + so[i]; s1[i] = bl2 + so[i]; }
    } else if (kt0 > q0 + 31) {
      const float br = fmaf(-slope2, base, -C2), br2 = br - 32.f * slope2;
#pragma unroll
      for (int i = 0; i < 16; ++i) { s0[i] = br - so[i]; s1[i] = br2 - so[i]; }
    } else {
#pragma unroll
      for (int i = 0; i < 16; ++i) {
        const float d0 = base + (float)(16 * (i >> 3) + (i & 7));
        s0[i] = fmaf(fabsf(d0), -slope2, -C2);
        s1[i] = fmaf(fabsf(d0 + 32.f), -slope2, -C2);
      }
    }
#pragma unroll
    for (int ks = 0; ks < 4; ++ks) {
      const bf16x8 a0 = *(const bf16x8*)(kbuf + krow * GSTR + ks * 32 + hh * 16);
      const bf16x8 a1 = *(const bf16x8*)(kbuf + (32 + krow) * GSTR + ks * 32 + hh * 16);
      s0 = MFMA(a0, qf[ks], s0);
      s1 = MFMA(a1, qf[ks], s1);
    }
    bf16x8 pf[4];
    {
      u32x4 pk[4];
#pragma unroll
      for (int i = 0; i < 16; i += 2) {
        const float e0 = __builtin_amdgcn_exp2f(s0[i]), e1 = __builtin_amdgcn_exp2f(s0[i + 1]);
        const float e2 = __builtin_amdgcn_exp2f(s1[i]), e3 = __builtin_amdgcn_exp2f(s1[i + 1]);
        pk[i >> 3][(i & 7) >> 1] = pack2(e0, e1);
        pk[2 + (i >> 3)][(i & 7) >> 1] = pack2(e2, e3);
      }
#pragma unroll
      for (int j = 0; j < 4; ++j) pf[j] = __builtin_bit_cast(bf16x8, pk[j]);
    }
#pragma unroll
    for (int j = 0; j < 4; ++j) accl = MFMA(ones, pf[j], accl);
#pragma unroll
    for (int dvb = 0; dvb < 4; ++dvb)
#pragma unroll
      for (int j = 0; j < 4; ++j) {
        const bf16x8 va = *(const bf16x8*)(vbuf + (dvb * 32 + r) * GSTR + (16 * j + 8 * hh) * 2);
        o[dvb] = MFMA(va, pf[j], o[dvb]);
      }
  };
  for (int t = 0; t < nt; t += 2) {
    compute(t);
    sttile(1, rb0, rb1, rb2, rb3);
    __builtin_amdgcn_sched_barrier(0);
    ldtile(t + 3, rb0, rb1, rb2, rb3);
    __builtin_amdgcn_sched_barrier(0);
    __syncthreads();
    if (t + 1 >= nt) break;
    compute(t + 1);
    sttile(0, ra0, ra1, ra2, ra3);
    __builtin_amdgcn_sched_barrier(0);
    ldtile(t + 4, ra0, ra1, ra2, ra3);
    __builtin_amdgcn_sched_barrier(0);
    __syncthreads();
  }
  const float linv = 1.f / accl[0];
  float* comb = (float*)lds;
  if (map == 1) {
#pragma unroll
    for (int dvb = 0; dvb < 4; ++dvb)
#pragma unroll
      for (int i = 0; i < 16; ++i) comb[(qb * 64 + dvb * 16 + i) * 64 + lane] = o[dvb][i] * linv;
  }
  __syncthreads();
  if (map == 0) {
    float ss = 0.f;
#pragma unroll
    for (int dvb = 0; dvb < 4; ++dvb)
#pragma unroll
      for (int i = 0; i < 16; ++i) {
        const float v = o[dvb][i] * linv - lam * comb[(qb * 64 + dvb * 16 + i) * 64 + lane];
        o[dvb][i] = v; ss += v * v;
      }
    ss += __shfl_xor(ss, 32);
    const float sc = rsqrtf(ss * (1.f / 128.f) + 1e-6f) * (1.f - lam_init);
    const bf16_t* gp = P.GDA + ltq * 512 + hd * 128;
    bf16_t* yp = P.X + ((size_t)G.tok0 + ltq) * DM + 512 + hd * 128;
    const float* sl = P.subln + L * 128;
#pragma unroll
    for (int dvb = 0; dvb < 4; ++dvb)
#pragma unroll
      for (int q4 = 0; q4 < 4; ++q4) {
        const int dv = dvb * 32 + 8 * q4 + 4 * hh;
        const u32x2 g = *(const u32x2*)(gp + dv);
        const f32x4 s4 = *(const f32x4*)(sl + dv);
        u32x2 ov = {pack2(o[dvb][4 * q4] * sc * s4[0] * bflo(g[0]), o[dvb][4 * q4 + 1] * sc * s4[1] * bfhi(g[0])),
                    pack2(o[dvb][4 * q4 + 2] * sc * s4[2] * bflo(g[1]), o[dvb][4 * q4 + 3] * sc * s4[3] * bfhi(g[1]))};
        *(u32x2*)(yp + dv) = ov;
      }
  }
}

DI void phase_mixers(const Params& P, int L, const Group& G, int* ctr, char* lds, int* s_item, int mode = 0) {
  const int nscan = mode == 2 ? 0 : G.B * 16;
  const int nattn = mode == 1 ? 0 : G.B * 4 * (G.S >> 7);
  const int total = nscan + nattn;
  for (;;) {
    __syncthreads();
    if (threadIdx.x == 0) *s_item = atomicAdd(ctr, 1);
    __syncthreads();
    const int it = *s_item;
    if (it >= total) break;
    if (it < nscan) scan_task(P, L, G, it, lds);
    else attn_item(P, L, G, it - nscan, lds);
  }
}

__global__ void __launch_bounds__(NTHREADS) fwd_megakernel(Params P) {
  __shared__ __attribute__((aligned(16))) char lds[LDS_BYTES];
  __shared__ int s_item;
  cg::grid_group grid = cg::this_grid();
  phase_weights(P, lds);
  for (int ph = 0; ph < 18; ++ph) {
    const int L = ph / 9, k = ph % 9;
    const int g = (k >= 4 && k <= 6) ? 1 : 0;
    Group G;
    G.tok0 = g ? NP : 0; G.B = g ? 8 : 16; G.S = g ? 8192 : 2048; G.ntok = g ? NS : NP;
#ifdef PROBE_SCAN
    if (k == 2 || k == 5) { phase_mixers(P, L, G, P.ctr + 64 + (L * 2 + g) * 16, lds, &s_item, 1); grid.sync(); }
#endif
#ifdef PROBE_ATTN
    if (k == 2 || k == 5) { phase_mixers(P, L, G, P.ctr + 128 + (L * 2 + g) * 16, lds, &s_item, 2); grid.sync(); }
#endif
#ifdef PROBE_INPROJ
    if (k == 1 || k == 4) { phase_inproj(P, L, G, lds); grid.sync(); }
#endif
    if (k == 0) phase_prep(P, L);
    else if (k == 1 || k == 4) phase_inproj(P, L, G, lds);
    else if (k == 2 || k == 5) phase_mixers(P, L, G, P.ctr + (L * 2 + g) * 16, lds, &s_item);
    else if (k == 3 || k == 6) phase_rwkv_final(P, L, G);
    else if (k == 7) phase_outproj(P, L, lds);
    else phase_gate(P, L, lds);
    grid.sync();
  }
}

extern "C" void kernel_launch(void* const* d_in, const int* in_sizes, int n_in, void* d_out, int out_size, void* d_ws,
                              size_t ws_size, hipStream_t stream) {
  Params P{};
  const float* const* in = (const float* const*)d_in;
  P.x_prompt = in[0]; P.x_sample = in[1]; P.p_prompt = in[2]; P.p_sample = in[3];
  P.norm_pre = in[4]; P.w_in = in[5]; P.w_out = in[6]; P.conv_w = in[7]; P.conv_b = in[8];
  P.w0 = in[9]; P.w_up = in[10]; P.a0 = in[11]; P.a_up = in[12]; P.k_k = in[13]; P.k_a = in[14];
  P.r_k = in[15]; P.ln_g = in[16]; P.ln_b = in[17]; P.q_norm = in[18]; P.k_norm = in[19];
  P.lam_vec = in[20]; P.subln = in[21]; P.ple_proj = in[22]; P.ple_norm = in[23];
  P.gate_w = in[24]; P.gate_b = in[25];
  P.out = (float*)d_out;
  char* ws = (char*)d_ws;
  size_t off = 0;
  auto take = [&](size_t bytes) { char* p = ws + off; off += (bytes + 255) & ~(size_t)255; return p; };
  P.ctr = (int*)take(1024);
  P.consts = (float*)take(1024);
  P.X = (bf16_t*)take((size_t)NTOK * DM * 2);
  P.PB = (bf16_t*)take((size_t)NTOK * DPLE * 2);
  P.RS = (float*)take((size_t)NTOK * 4);
  P.WIN = (bf16_t*)take((size_t)2 * NIN * DM * 2);
  P.WOUT = (bf16_t*)take((size_t)2 * DM * DM * 2);
  P.WPLE = (bf16_t*)take((size_t)2 * DM * DPLE * 2);
  P.WGATE = (bf16_t*)take((size_t)2 * DM * DM * 2);
  P.WUPT = (bf16_t*)take((size_t)4 * 512 * 64 * 2);
  P.AUPT = (bf16_t*)take((size_t)2 * 512 * 64 * 2);
  P.CR = (bf16_t*)take((size_t)GS * CRW * 2);
  P.GRW = (bf16_t*)take((size_t)GS * 512 * 2);
  P.Q = (bf16_t*)take((size_t)GS * 512 * 2);
  P.KB = (bf16_t*)take((size_t)GS * 512 * 2);
  P.VT = (bf16_t*)take((size_t)GS * 512 * 2);
  P.GDA = (bf16_t*)take((size_t)GS * 512 * 2);
  P.YB = (bf16_t*)take((size_t)GS * 512 * 2);
  P.BV = (bf16_t*)take((size_t)GS * 512 * 2);
  P.R1 = P.CR;
  P.R2 = P.GRW;
  P.EPART = (float*)P.VT;
  if (off > ws_size) { fprintf(stderr, "workspace too small: need %zu have %zu\n", off, ws_size); return; }
  hipMemsetAsync(P.ctr, 0, 1024, stream);
  static int grid_blocks = 0;
  if (!grid_blocks) {
    int dev = 0, cus = 0, per_cu = 0;
    hipGetDevice(&dev);
    hipDeviceGetAttribute(&cus, hipDeviceAttributeMultiprocessorCount, dev);
    hipOccupancyMaxActiveBlocksPerMultiprocessor(&per_cu, fwd_megakernel, NTHREADS, 0);
    if (per_cu < 1) { fprintf(stderr, "occupancy query returned %d\n", per_cu); per_cu = 1; }
    grid_blocks = 256;
    if (cus < 256) fprintf(stderr, "unexpected CU count %d\n", cus);
  }
  void* args[] = {&P};
  hipError_t e = hipLaunchCooperativeKernel((void*)fwd_megakernel, dim3(grid_blocks), dim3(NTHREADS), args, 0, stream);
  if (e != hipSuccess) fprintf(stderr, "cooperative launch failed: %s (grid %d)\n", hipGetErrorString(e), grid_blocks);
}
```

```cpp
#include <hip/hip_runtime.h>
#include <hip/hip_cooperative_groups.h>
#include <cstdio>
namespace cg = cooperative_groups;

#define DI __device__ __forceinline__
typedef __attribute__((ext_vector_type(8))) short bf16x8;
typedef __attribute__((ext_vector_type(16))) float f32x16;
typedef __attribute__((ext_vector_type(4))) float f32x4;
typedef __attribute__((ext_vector_type(2))) float f32x2;
typedef __attribute__((ext_vector_type(4))) unsigned u32x4;
typedef __attribute__((ext_vector_type(2))) unsigned u32x2;
typedef unsigned short bf16_t;
#define MFMA(a, b, c) __builtin_amdgcn_mfma_f32_32x32x16_bf16((a), (b), (c), 0, 0, 0)

constexpr int DM = 1024;
constexpr int NP = 16 * 2048;
constexpr int NS = 8 * 8192;
constexpr int NTOK = NP + NS;
constexpr int DPLE = 256;
constexpr int IN_COLS = 4288;
constexpr int NIN = 4352;
constexpr int CRW = 1792;
constexpr int GS = NS;
constexpr float LOG2E = 1.4426950408889634f;
constexpr int NTHREADS = 512;
constexpr int LDS_BYTES = 147456;

struct Params {
  const float* x_prompt; const float* x_sample; const float* p_prompt; const float* p_sample;
  const float* norm_pre; const float* w_in; const float* w_out; const float* conv_w; const float* conv_b;
  const float* w0; const float* w_up; const float* a0; const float* a_up; const float* k_k; const float* k_a;
  const float* r_k; const float* ln_g; const float* ln_b; const float* q_norm; const float* k_norm;
  const float* lam_vec; const float* subln; const float* ple_proj; const float* ple_norm;
  const float* gate_w; const float* gate_b;
  float* out;
  bf16_t* X; bf16_t* PB; float* RS;
  bf16_t* CR; bf16_t* GRW; bf16_t* Q; bf16_t* KB; bf16_t* VT; bf16_t* GDA;
  bf16_t* R1; bf16_t* R2; float* EPART; bf16_t* YB; bf16_t* BV;
  bf16_t* WIN; bf16_t* WOUT; bf16_t* WPLE; bf16_t* WGATE; bf16_t* WUPT; bf16_t* AUPT;
  float* consts; int* ctr;
};

struct Group { int tok0, B, S, ntok; };

DI unsigned pack2(float a, float b) {
  typedef __attribute__((ext_vector_type(2))) __bf16 bf2;
  f32x2 v = {a, b};
  bf2 r = __builtin_convertvector(v, bf2);
  return __builtin_bit_cast(unsigned, r);
}
DI bf16_t f2bf(float a) { return (bf16_t)(pack2(a, 0.f) & 0xffffu); }
DI float bf2f(unsigned short u) { return __uint_as_float(((unsigned)u) << 16); }
DI float bflo(unsigned u) { return __uint_as_float(u << 16); }
DI float bfhi(unsigned u) { return __uint_as_float(u & 0xffff0000u); }
template <int CTRL> DI float dppf(float x) {
  return __int_as_float(__builtin_amdgcn_update_dpp(0, __float_as_int(x), CTRL, 0xF, 0xF, true));
}
DI float red4(float x) { x += dppf<0xB1>(x); x += dppf<0x4E>(x); return x; }
DI float red8(float x) { x = red4(x); x += dppf<0x141>(x); return x; }
DI float red32(float x) {
  x += __shfl_xor(x, 1); x += __shfl_xor(x, 2); x += __shfl_xor(x, 4); x += __shfl_xor(x, 8); x += __shfl_xor(x, 16);
  return x;
}
DI float sigmoidf_(float x) { return __builtin_amdgcn_rcpf(1.f + __expf(-x)); }
DI float siluf_(float x) { return x * __builtin_amdgcn_rcpf(1.f + __expf(-x)); }
DI float tanhf_(float x) { return 1.f - 2.f * __builtin_amdgcn_rcpf(1.f + __expf(2.f * x)); }
DI int opq(int x) { asm volatile("" : "+v"(x)); return x; }
DI int opqs(int x) { asm volatile("" : "+s"(x)); return x; }
DI int crow(int i, int h) { return (i & 3) + 8 * (i >> 2) + 4 * h; }

DI void transpose_convert(const float* __restrict__ src, int K, int N, bf16_t* __restrict__ dst, int Nd, int mode,
                          const float* __restrict__ rowscale, float* lds) {
  const int tid = opq(threadIdx.x);
  const int tk = K >> 6, tn = Nd >> 6;
  for (int t = blockIdx.x; t < tk * tn; t += gridDim.x) {
    const int k0 = (t % tk) << 6, n0 = (t / tk) << 6;
    int sn0 = n0;
    if (mode == 1) sn0 = (n0 < 1728) ? n0 : (n0 < 1792 ? -1 : n0 - 64);
    __syncthreads();
#pragma unroll
    for (int it = 0; it < 2; ++it) {
      const int kk = (tid >> 4) + 32 * it, n4 = (tid & 15) * 4;
      f32x4 v = {0.f, 0.f, 0.f, 0.f};
      if (sn0 >= 0) v = *(const f32x4*)(src + (size_t)(k0 + kk) * N + sn0 + n4);
      const float sc = rowscale ? rowscale[k0 + kk] : 1.f;
      lds[kk * 65 + n4 + 0] = v[0] * sc; lds[kk * 65 + n4 + 1] = v[1] * sc;
      lds[kk * 65 + n4 + 2] = v[2] * sc; lds[kk * 65 + n4 + 3] = v[3] * sc;
    }
    __syncthreads();
    const int nn = tid >> 3, k8 = (tid & 7) * 8;
    u32x4 o;
    o[0] = pack2(lds[(k8 + 0) * 65 + nn], lds[(k8 + 1) * 65 + nn]);
    o[1] = pack2(lds[(k8 + 2) * 65 + nn], lds[(k8 + 3) * 65 + nn]);
    o[2] = pack2(lds[(k8 + 4) * 65 + nn], lds[(k8 + 5) * 65 + nn]);
    o[3] = pack2(lds[(k8 + 6) * 65 + nn], lds[(k8 + 7) * 65 + nn]);
    *(u32x4*)(dst + (size_t)(n0 + nn) * K + k0 + k8) = o;
  }
}

DI void phase_weights(const Params& P, char* lds) {
  float* l = (float*)lds;
  for (int L = 0; L < 2; ++L) {
    transpose_convert(P.w_in + (size_t)L * DM * IN_COLS, DM, IN_COLS, P.WIN + (size_t)L * NIN * DM, NIN, 1, P.norm_pre + L * DM, l);
    transpose_convert(P.w_out + (size_t)L * DM * DM, DM, DM, P.WOUT + (size_t)L * DM * DM, DM, 0, nullptr, l);
    transpose_convert(P.ple_proj + (size_t)L * DPLE * DM, DPLE, DM, P.WPLE + (size_t)L * DM * DPLE, DM, 0, nullptr, l);
    transpose_convert(P.gate_w + (size_t)L * DM * DM, DM, DM, P.WGATE + (size_t)L * DM * DM, DM, 0, nullptr, l);
    for (int d = 0; d < 2; ++d)
      transpose_convert(P.w_up + (size_t)(L * 2 + d) * 64 * 512, 64, 512, P.WUPT + (size_t)(L * 2 + d) * 512 * 64, 512, 0, nullptr, l);
    transpose_convert(P.a_up + (size_t)L * 64 * 512, 64, 512, P.AUPT + (size_t)L * 512 * 64, 512, 0, nullptr, l);
  }
  if (blockIdx.x == 0 && threadIdx.x < 128) {
    const int L = threadIdx.x >> 6, lane = threadIdx.x & 63;
    const float* lv = P.lam_vec + L * 256;
    float s01 = lv[lane] * lv[64 + lane], s23 = lv[128 + lane] * lv[192 + lane];
    float mq = fmaxf(fabsf(P.q_norm[L * 128 + lane]), fabsf(P.q_norm[L * 128 + 64 + lane]));
    float mk = fmaxf(fabsf(P.k_norm[L * 128 + lane]), fabsf(P.k_norm[L * 128 + 64 + lane]));
    for (int o = 32; o >= 1; o >>= 1) {
      s01 += __shfl_xor(s01, o); s23 += __shfl_xor(s23, o);
      mq = fmaxf(mq, __shfl_xor(mq, o)); mk = fmaxf(mk, __shfl_xor(mk, o));
    }
    if (lane == 0) {
      const float lam_init = 0.8f - 0.6f * expf(-0.3f * (float)L);
      P.consts[L * 4 + 0] = expf(s01) - expf(s23) + lam_init;
      P.consts[L * 4 + 1] = 8.25f * mq * mk * LOG2E;
      P.consts[L * 4 + 2] = lam_init;
    }
  }
}

DI void phase_prep(const Params& P, int L) {
  const float* h0 = L == 0 ? P.x_prompt : P.out;
  const float* h1 = L == 0 ? P.x_sample : P.out + (size_t)NP * DM;
  const float* p0 = P.p_prompt + (size_t)L * NP * DPLE;
  const float* p1 = P.p_sample + (size_t)L * NS * DPLE;
  const int tidp = opq(threadIdx.x);
  const int lane = tidp & 63;
  const int gw = blockIdx.x * (NTHREADS / 64) + (tidp >> 6), nw = gridDim.x * (NTHREADS / 64);
  for (int tok = gw; tok < NTOK; tok += nw) {
    const float* hr = tok < NP ? h0 + (size_t)tok * DM : h1 + (size_t)(tok - NP) * DM;
    float ss = 0.f;
#pragma unroll
    for (int i = 0; i < 4; ++i) {
      f32x4 v = *(const f32x4*)(hr + i * 256 + lane * 4);
      ss += v[0] * v[0] + v[1] * v[1] + v[2] * v[2] + v[3] * v[3];
      u32x2 o = {pack2(v[0], v[1]), pack2(v[2], v[3])};
      *(u32x2*)(P.X + (size_t)tok * DM + i * 256 + lane * 4) = o;
    }
    for (int o = 32; o >= 1; o >>= 1) ss += __shfl_xor(ss, o);
    if (lane == 0) P.RS[tok] = rsqrtf(ss * (1.f / DM) + 1e-6f);
    const float* pr = tok < NP ? p0 + (size_t)tok * DPLE : p1 + (size_t)(tok - NP) * DPLE;
    f32x4 v = *(const f32x4*)(pr + lane * 4);
    u32x2 o = {pack2(v[0], v[1]), pack2(v[2], v[3])};
    *(u32x2*)(P.PB + (size_t)tok * DPLE + lane * 4) = o;
  }
}

constexpr int GSTR = 144;
constexpr int GA_BYTES = 256 * GSTR;
constexpr int GSTAGE = 2 * GA_BYTES;

DI void gemm_mainloop(const bf16_t* __restrict__ A, int lda, const bf16_t* __restrict__ Bw, int ldb, int K,
                      int m0, int n0, char* lds, f32x16 (&acc)[2][4]) {
  const int tid = opq(threadIdx.x), lane = tid & 63, w = tid >> 6, hh = lane >> 5, r = lane & 31;
  const int wm = w >> 1, wn = w & 1;
#pragma unroll
  for (int mi = 0; mi < 2; ++mi)
#pragma unroll
    for (int ni = 0; ni < 4; ++ni)
#pragma unroll
      for (int i = 0; i < 16; ++i) acc[mi][ni][i] = 0.f;
  const int lrow = tid >> 3, lkc = tid & 7;
  const bf16_t* ap = A + (size_t)(m0 + lrow) * lda + lkc * 8;
  const bf16_t* bp = Bw + (size_t)(n0 + lrow) * ldb + lkc * 8;
  const int nk = K >> 6;
  u32x4 ra[4], rb[4];
#pragma unroll
  for (int i = 0; i < 4; ++i) {
    ra[i] = *(const u32x4*)(ap + (size_t)(64 * i) * lda);
    rb[i] = *(const u32x4*)(bp + (size_t)(64 * i) * ldb);
  }
  __syncthreads();
#pragma unroll
  for (int i = 0; i < 4; ++i) {
    *(u32x4*)(lds + (lrow + 64 * i) * GSTR + lkc * 16) = ra[i];
    *(u32x4*)(lds + GA_BYTES + (lrow + 64 * i) * GSTR + lkc * 16) = rb[i];
  }
  __syncthreads();
  for (int kt = 0; kt < nk; ++kt) {
    const bool more = kt + 1 < nk;
    if (more) {
#pragma unroll
      for (int i = 0; i < 4; ++i) {
        ra[i] = *(const u32x4*)(ap + (size_t)(64 * i) * lda + (kt + 1) * 64);
        rb[i] = *(const u32x4*)(bp + (size_t)(64 * i) * ldb + (kt + 1) * 64);
      }
    }
    __builtin_amdgcn_sched_barrier(0);
    const char* sa = lds + (kt & 1) * GSTAGE + (wm * 64 + r) * GSTR + hh * 16;
    const char* sb = lds + (kt & 1) * GSTAGE + GA_BYTES + (wn * 128 + r) * GSTR + hh * 16;
    bf16x8 fa[2][2], fb[2][4];
#pragma unroll
    for (int mi = 0; mi < 2; ++mi) fa[0][mi] = *(const bf16x8*)(sa + mi * 32 * GSTR);
#pragma unroll
    for (int ni = 0; ni < 4; ++ni) fb[0][ni] = *(const bf16x8*)(sb + ni * 32 * GSTR);
#pragma unroll
    for (int ks = 0; ks < 4; ++ks) {
      if (ks < 3) {
#pragma unroll
        for (int mi = 0; mi < 2; ++mi) fa[(ks + 1) & 1][mi] = *(const bf16x8*)(sa + mi * 32 * GSTR + (ks + 1) * 32);
#pragma unroll
        for (int ni = 0; ni < 4; ++ni) fb[(ks + 1) & 1][ni] = *(const bf16x8*)(sb + ni * 32 * GSTR + (ks + 1) * 32);
      }
      __builtin_amdgcn_sched_barrier(0);
#pragma unroll
      for (int mi = 0; mi < 2; ++mi)
#pragma unroll
        for (int ni = 0; ni < 4; ++ni) acc[mi][ni] = MFMA(fb[ks & 1][ni], fa[ks & 1][mi], acc[mi][ni]);
      __builtin_amdgcn_sched_barrier(0);
    }
    if (more) {
      char* d = lds + ((kt + 1) & 1) * GSTAGE;
#pragma unroll
      for (int i = 0; i < 4; ++i) {
        *(u32x4*)(d + (lrow + 64 * i) * GSTR + lkc * 16) = ra[i];
        *(u32x4*)(d + GA_BYTES + (lrow + 64 * i) * GSTR + lkc * 16) = rb[i];
      }
    }
    __syncthreads();
  }
}

DI bool xcd_tile(int rd, int nM, int nN, int& mt, int& nt) {
  const int xcd = blockIdx.x & 7, j = blockIdx.x >> 3;
  const int u = (rd * 8 + xcd) * 32 + j;
  if (u >= nM * nN) return false;
  const int band = u / (8 * nN), rem = u % (8 * nN);
  nt = rem >> 3; mt = band * 8 + (rem & 7);
  return true;
}

namespace pg8 {
#define PG8_LAS __attribute__((address_space(3)))
constexpr int BM = 256, BK = 64, HALF = 128, HTB = HALF * BK * 2  , STAGE_BYTES = 8 * HTB, NXCD = 8, WGM = 8;
__host__ __device__ __forceinline__ int lds_byte(int r, int c) { const int st = (r >> 4) * 2 + (c >> 5), rr = r & 15, cc = c & 31, ob = rr * 64 + cc * 2; return st * 1024 + (ob ^ (((ob >> 9) & 1) << 5)); }
__host__ __device__ __forceinline__ void stage_rc(int b, int& R, int& C) { const int st = b / 1024, sb = b % 1024, swz = sb ^ (((sb >> 9) & 1) << 5); R = (st >> 1) * 16 + swz / 64; C = (st & 1) * 32 + (swz % 64) / 2; }
__host__ __device__ __forceinline__ int perm32(int rho) { const int n = rho >> 4, i = rho & 15; return 8 * (i >> 2) + 4 * n + (i & 3); }

struct Unit { int pm, pn; };
struct Gemm { const bf16_t* A; const bf16_t* Bt; int M, N, K; };
template <class Epi, class Sched, bool ALIGN_EPI = false, bool SP2 = false>
__device__ __forceinline__ void gemm_phase(PG8_LAS unsigned char* lds, const Gemm g, const Sched& S, const Epi& E) {
    const int tid = opq(threadIdx.x), wid = __builtin_amdgcn_readfirstlane(tid >> 6), lane = tid & 63, wr = wid >> 2, wc = wid & 3, fr = lane & 15, fq = lane >> 4;
    const int K = g.K, nt = K / BK;
    unsigned voffA[2], voffB[2];
#pragma unroll
    for (int i = 0; i < 2; ++i) { int R, C; stage_rc(tid * 16 + i * 8192, R, C); const int Rb = Epi::PERM ? ((R & ~31) + perm32(R & 31)) : R;
        voffA[i] = (unsigned)(R * K + C) * 2u; voffB[i] = (unsigned)(Rb * K + C) * 2u; }
    const size_t kstep = (size_t)(BK * 2);
    const size_t hstep = (size_t)HALF * K * 2;
    const size_t tstep = 2 * hstep;
    const unsigned ldsw = (unsigned)wid * 1024u;
    const int aoff = lds_byte(wr * 64 + fr, fq * 8), boff = lds_byte(wc * 32 + fr, fq * 8);
#define PG8_SA(b, h) (((b) * 2 + (h)) * HTB)
#define PG8_SB(b, h) ((4 + (b) * 2 + (h)) * HTB)
#define PG8_STAGE(bufoff, gbase, voff) do { _Pragma("unroll") for (int _i = 0; _i < 2; ++_i) \
        __builtin_amdgcn_global_load_lds((const unsigned*)((const char*)(gbase) + (voff)[_i]), (PG8_LAS unsigned*)(lds + (bufoff) + ldsw + _i * 8192), 16, 0, 0); } while (0)
#define PG8_LDA(dst, b, h) do { _Pragma("unroll") for (int m = 0; m < 4; ++m) _Pragma("unroll") for (int k = 0; k < 2; ++k) dst[m][k] = *(const PG8_LAS bf16x8*)(lds + PG8_SA(b, h) + aoff + m * 2048 + k * 1024); } while (0)
#define PG8_LDB(dst, b, h) do { _Pragma("unroll") for (int n = 0; n < 2; ++n) _Pragma("unroll") for (int k = 0; k < 2; ++k) dst[n][k] = *(const PG8_LAS bf16x8*)(lds + PG8_SB(b, h) + boff + n * 2048 + k * 1024); } while (0)
#define PG8_MMA(ai, bj, At, Bt) do { __builtin_amdgcn_s_setprio(1); _Pragma("unroll") for (int m = 0; m < 4; ++m) _Pragma("unroll") for (int n = 0; n < 2; ++n) _Pragma("unroll") for (int k = 0; k < 2; ++k) \
        acc[ai][bj][m][n] = __builtin_amdgcn_mfma_f32_16x16x32_bf16(Bt[n][k], At[m][k], acc[ai][bj][m][n], 0, 0, 0); __builtin_amdgcn_s_setprio(0); } while (0)
#define PG8_WAIT_V(n) asm volatile("s_waitcnt vmcnt(" #n ")" ::: "memory")
#define PG8_WAIT_L(n) asm volatile("s_waitcnt lgkmcnt(" #n ")" ::: "memory")
#define PG8_BAR __builtin_amdgcn_s_barrier()
#define PG8_SCHED __builtin_amdgcn_sched_barrier(0)
    Unit cur, nxt; int ui = 0;
    if (!S.next(0, cur)) return;
    f32x4 acc[2][2][4][2];
#pragma unroll
    for (int a = 0; a < 2; ++a)
#pragma unroll
        for (int b = 0; b < 2; ++b)
#pragma unroll
            for (int m = 0; m < 4; ++m)
#pragma unroll
                for (int n = 0; n < 2; ++n) acc[a][b][m][n] = (f32x4){0.f, 0.f, 0.f, 0.f};
    bf16x8 At[4][2], B0[2][2], B1[2][2];
    const char* cA = (const char*)g.A + (size_t)cur.pm * tstep; const char* cB = (const char*)g.Bt + (size_t)cur.pn * tstep;
    S.a_ready(cur);
    if constexpr (SP2) {
        PG8_STAGE(PG8_SB(0, 0), cB, voffB); PG8_STAGE(PG8_SB(0, 1), cB + hstep, voffB); PG8_STAGE(PG8_SA(0, 0), cA, voffA); PG8_STAGE(PG8_SA(0, 1), cA + hstep, voffA);
        if (wr == 1) PG8_BAR;
        PG8_WAIT_V(2); PG8_BAR;
        PG8_STAGE(PG8_SB(1, 0), cB + kstep, voffB); PG8_STAGE(PG8_SA(1, 0), cA + kstep, voffA); PG8_STAGE(PG8_SB(1, 1), cB + hstep + kstep, voffB);
        PG8_WAIT_V(6); PG8_BAR;
    } else {
        PG8_STAGE(PG8_SB(0, 0), cB, voffB); PG8_STAGE(PG8_SA(0, 0), cA, voffA); PG8_STAGE(PG8_SB(0, 1), cB + hstep, voffB); PG8_STAGE(PG8_SA(0, 1), cA + hstep, voffA);
        if (wr == 1) PG8_BAR;
        PG8_WAIT_V(4); PG8_BAR;
        PG8_STAGE(PG8_SB(1, 0), cB + kstep, voffB); PG8_STAGE(PG8_SA(1, 0), cA + kstep, voffA); PG8_STAGE(PG8_SB(1, 1), cB + hstep + kstep, voffB);
        PG8_WAIT_V(6); PG8_BAR;
    }
    for (;;) {
        const bool has_next = S.next(ui + 1, nxt);
        const char* nA = has_next ? (const char*)g.A + (size_t)nxt.pm * tstep : cA; const char* nB = has_next ? (const char*)g.Bt + (size_t)nxt.pn * tstep : cB;
        for (int t = 0; t < nt; t += 2) {
            const bool last = (t == nt - 2);
            const char* a1 = cA + (size_t)(t + 1) * kstep;
            const char* a2 = last ? nA : cA + (size_t)(t + 2) * kstep; const char* b2 = last ? nB : cB + (size_t)(t + 2) * kstep;
            const char* a3 = a2 + kstep; const char* b3 = b2 + kstep;
            if (last && has_next) S.a_ready(nxt);
            if constexpr (SP2) {
            PG8_LDB(B0, 0, 0); PG8_LDB(B1, 0, 1); PG8_SCHED; PG8_LDA(At, 0, 0); PG8_STAGE(PG8_SA(1, 1), a1 + hstep, voffA);
            PG8_WAIT_V(8); PG8_WAIT_L(0); PG8_BAR; PG8_MMA(0, 0, At, B0); PG8_MMA(0, 1, At, B1); PG8_BAR; PG8_SCHED;
            PG8_LDA(At, 0, 1); PG8_STAGE(PG8_SB(0, 0), b2, voffB); PG8_STAGE(PG8_SB(0, 1), b2 + hstep, voffB); PG8_STAGE(PG8_SA(0, 0), a2, voffA);
            PG8_WAIT_V(8); PG8_WAIT_L(0); PG8_BAR; PG8_MMA(1, 0, At, B0); PG8_MMA(1, 1, At, B1); PG8_BAR; PG8_SCHED;
            PG8_LDB(B0, 1, 0); PG8_LDB(B1, 1, 1); PG8_SCHED; PG8_LDA(At, 1, 0); PG8_STAGE(PG8_SA(0, 1), a2 + hstep, voffA);
            PG8_WAIT_V(8); PG8_WAIT_L(0); PG8_BAR; PG8_MMA(0, 0, At, B0); PG8_MMA(0, 1, At, B1); PG8_BAR; PG8_SCHED;
            PG8_LDA(At, 1, 1); PG8_STAGE(PG8_SB(1, 0), b3, voffB); PG8_STAGE(PG8_SB(1, 1), b3 + hstep, voffB); PG8_STAGE(PG8_SA(1, 0), a3, voffA);
            PG8_WAIT_V(8); PG8_WAIT_L(0); PG8_BAR; PG8_MMA(1, 0, At, B0); PG8_MMA(1, 1, At, B1); PG8_BAR; PG8_SCHED;
            } else {
            PG8_LDB(B0, 0, 0); PG8_SCHED; PG8_LDA(At, 0, 0); PG8_STAGE(PG8_SA(1, 1), a1 + hstep, voffA);
            PG8_WAIT_L(8); PG8_BAR; PG8_WAIT_L(0); PG8_MMA(0, 0, At, B0); PG8_BAR; PG8_SCHED;
            PG8_LDB(B1, 0, 1); PG8_STAGE(PG8_SB(0, 0), b2, voffB);
            PG8_BAR; PG8_WAIT_L(0); PG8_MMA(0, 1, At, B1); PG8_BAR;
            PG8_LDA(At, 0, 1); PG8_STAGE(PG8_SA(0, 0), a2, voffA);
            PG8_BAR; PG8_WAIT_L(0); PG8_MMA(1, 0, At, B0); PG8_BAR; PG8_SCHED;
            PG8_STAGE(PG8_SB(0, 1), b2 + hstep, voffB);
            PG8_WAIT_V(6); PG8_BAR; PG8_MMA(1, 1, At, B1); PG8_BAR;
            PG8_LDB(B0, 1, 0); PG8_SCHED; PG8_LDA(At, 1, 0); PG8_STAGE(PG8_SA(0, 1), a2 + hstep, voffA);
            PG8_WAIT_L(8); PG8_BAR; PG8_WAIT_L(0); PG8_MMA(0, 0, At, B0); PG8_BAR; PG8_SCHED;
            PG8_LDB(B1, 1, 1); PG8_STAGE(PG8_SB(1, 0), b3, voffB);
            PG8_BAR; PG8_WAIT_L(0); PG8_MMA(0, 1, At, B1); PG8_BAR;
            PG8_LDA(At, 1, 1); PG8_STAGE(PG8_SA(1, 0), a3, voffA);
            PG8_BAR; PG8_WAIT_L(0); PG8_MMA(1, 0, At, B0); PG8_BAR; PG8_SCHED;
            PG8_STAGE(PG8_SB(1, 1), b3 + hstep, voffB);
            PG8_WAIT_V(6); PG8_BAR; PG8_MMA(1, 1, At, B1); PG8_BAR;
            }
        }
        if constexpr (ALIGN_EPI) { if (wr == 0) PG8_BAR; }
        if constexpr (!Epi::AFTER_DRAIN) { E(acc, cur, wr, wc, fr, fq); S.done(cur); }
        if (!has_next) break;
#pragma unroll
        for (int a = 0; a < 2; ++a)
#pragma unroll
            for (int b = 0; b < 2; ++b)
#pragma unroll
                for (int m = 0; m < 4; ++m)
#pragma unroll
                    for (int n = 0; n < 2; ++n) acc[a][b][m][n] = (f32x4){0.f, 0.f, 0.f, 0.f};
        cur = nxt; cA = nA; cB = nB; ++ui;
        if constexpr (ALIGN_EPI) { if (wr == 1) PG8_BAR; }
    }
    PG8_WAIT_V(0);
    if constexpr (!ALIGN_EPI) { if (wr == 0) PG8_BAR; }
    PG8_BAR;
    if constexpr (Epi::AFTER_DRAIN) { E.fused(acc, cur, wr, wc, fr, fq, lds, wid, lane); S.done(cur); }
#undef PG8_SA
#undef PG8_SB
#undef PG8_STAGE
#undef PG8_LDA
#undef PG8_LDB
#undef PG8_MMA
#undef PG8_WAIT_V
#undef PG8_WAIT_L
#undef PG8_BAR
#undef PG8_SCHED
}
}

struct TileSched {
  int nM, nN, skip_lo, skip_hi;
  DI bool next(int i, pg8::Unit& u) const {
    const int nNe = nN - (skip_hi - skip_lo);
    const int t = blockIdx.x + i * gridDim.x;
    if (t >= nM * nNe) return false;
    int pn = t % nNe; const int pm = t / nNe;
    if (pn >= skip_lo) pn += skip_hi - skip_lo;
    u.pm = pm; u.pn = pn; return true;
  }
  DI void a_ready(const pg8::Unit&) const {}
  DI void done(const pg8::Unit&) const {}
};

DI u32x4 pack8(f32x4 a, f32x4 b) { u32x4 w = {pack2(a[0], a[1]), pack2(a[2], a[3]), pack2(b[0], b[1]), pack2(b[2], b[3])}; return w; }

struct InProjEpi {
  static constexpr bool PERM = true, AFTER_DRAIN = false;
  const float* RS; bf16_t* CR; bf16_t* GRW; bf16_t* GDA; bf16_t* VT; int tok0, S;
  DI void operator()(const f32x4 (&acc)[2][2][4][2], const pg8::Unit& u, int wr, int wc, int fr, int fq) const {
    const int row0 = u.pm * 256 + wr * 64 + fr, col0 = u.pn * 256 + wc * 32 + 8 * fq;
#pragma unroll
    for (int ai = 0; ai < 2; ++ai)
#pragma unroll
      for (int m = 0; m < 4; ++m) {
        const int row = row0 + ai * 128 + m * 16;
        const float rsv = RS[tok0 + row];
#pragma unroll
        for (int bj = 0; bj < 2; ++bj) {
          const int col = col0 + bj * 128;
          const f32x4 v0 = acc[ai][bj][m][0] * rsv, v1 = acc[ai][bj][m][1] * rsv;
          if (u.pn < 7) {
            *(u32x4*)(CR + (size_t)row * CRW + col) = pack8(v0, v1);
          } else if (u.pn < 9 || u.pn >= 15) {
            bf16_t* dst = (u.pn < 9 ? GRW + (col - 1792) : GDA + (col - 3840)) + (size_t)row * 512;
            const f32x4 s0 = {siluf_(v0[0]), siluf_(v0[1]), siluf_(v0[2]), siluf_(v0[3])};
            const f32x4 s1 = {siluf_(v1[0]), siluf_(v1[1]), siluf_(v1[2]), siluf_(v1[3])};
            *(u32x4*)dst = pack8(s0, s1);
          } else {
            const int cv = col - 3328, hd = cv >> 7, dv = cv & 127;
            const int b = row / S, s = row % S;
            bf16_t* dst = VT + ((size_t)((b * 4 + hd) * 128 + dv)) * S + s;
            const size_t Sz = (size_t)S;
            dst[0] = f2bf(v0[0]); dst[Sz] = f2bf(v0[1]); dst[2 * Sz] = f2bf(v0[2]); dst[3 * Sz] = f2bf(v0[3]);
            dst[4 * Sz] = f2bf(v1[0]); dst[5 * Sz] = f2bf(v1[1]); dst[6 * Sz] = f2bf(v1[2]); dst[7 * Sz] = f2bf(v1[3]);
          }
        }
        __builtin_amdgcn_sched_barrier(0);
      }
  }
};

struct OutProjEpi {
  static constexpr bool PERM = true, AFTER_DRAIN = false;
  const float* h0; const float* h1; float* out; bf16_t* R1;
  DI void operator()(const f32x4 (&acc)[2][2][4][2], const pg8::Unit& u, int wr, int wc, int fr, int fq) const {
    const int row0 = u.pm * 256 + wr * 64 + fr, col0 = u.pn * 256 + wc * 32 + 8 * fq;
#pragma unroll
    for (int ai = 0; ai < 2; ++ai)
#pragma unroll
      for (int m = 0; m < 4; ++m) {
        const int row = row0 + ai * 128 + m * 16;
        const float* hr = (row < NP ? h0 + (size_t)row * DM : h1 + (size_t)(row - NP) * DM);
#pragma unroll
        for (int bj = 0; bj < 2; ++bj) {
          const int col = col0 + bj * 128;
          const f32x4 a0 = *(const f32x4*)(hr + col) + acc[ai][bj][m][0];
          const f32x4 a1 = *(const f32x4*)(hr + col + 4) + acc[ai][bj][m][1];
          *(f32x4*)(out + (size_t)row * DM + col) = a0;
          *(f32x4*)(out + (size_t)row * DM + col + 4) = a1;
          *(u32x4*)(R1 + (size_t)row * DM + col) = pack8(a0, a1);
        }
        __builtin_amdgcn_sched_barrier(0);
      }
  }
};

struct EEpi {
  static constexpr bool PERM = true, AFTER_DRAIN = false;
  bf16_t* R2; float* EPART;
  DI void operator()(const f32x4 (&acc)[2][2][4][2], const pg8::Unit& u, int wr, int wc, int fr, int fq) const {
    const int row0 = u.pm * 256 + wr * 64 + fr, col0 = u.pn * 256 + wc * 32 + 8 * fq;
#pragma unroll
    for (int ai = 0; ai < 2; ++ai)
#pragma unroll
      for (int m = 0; m < 4; ++m) {
        const int row = row0 + ai * 128 + m * 16;
        float ss = 0.f;
#pragma unroll
        for (int bj = 0; bj < 2; ++bj) {
          const f32x4 v0 = acc[ai][bj][m][0], v1 = acc[ai][bj][m][1];
          ss += v0[0] * v0[0] + v0[1] * v0[1] + v0[2] * v0[2] + v0[3] * v0[3] + v1[0] * v1[0] + v1[1] * v1[1] + v1[2] * v1[2] + v1[3] * v1[3];
          *(u32x4*)(R2 + (size_t)row * DM + col0 + bj * 128) = pack8(v0, v1);
        }
        ss += __shfl_xor(ss, 16); ss += __shfl_xor(ss, 32);
        if (fq == 0) EPART[(size_t)(u.pn * 4 + wc) * NTOK + row] = ss;
        __builtin_amdgcn_sched_barrier(0);
      }
  }
};

struct GateEpi {
  static constexpr bool PERM = true, AFTER_DRAIN = false;
  float* out; const bf16_t* R2; const float* EPART; const float* gate_b; const float* ple_norm;
  DI void operator()(const f32x4 (&acc)[2][2][4][2], const pg8::Unit& u, int wr, int wc, int fr, int fq) const {
    const int row0 = u.pm * 256 + wr * 64 + fr, col0 = u.pn * 256 + wc * 32 + 8 * fq;
#pragma unroll
    for (int ai = 0; ai < 2; ++ai)
#pragma unroll
      for (int m = 0; m < 4; ++m) {
        const int row = row0 + ai * 128 + m * 16;
        float es = 0.f;
#pragma unroll
        for (int j = 0; j < 8; ++j) es += EPART[(size_t)j * NTOK + row];
        const float rse = rsqrtf(es * (1.f / DM) + 1e-6f);
#pragma unroll
        for (int bj = 0; bj < 2; ++bj) {
          const int col = col0 + bj * 128;
          const u32x4 ev = *(const u32x4*)(R2 + (size_t)row * DM + col);
          float* op = out + (size_t)row * DM + col;
#pragma unroll
          for (int n = 0; n < 2; ++n) {
            const f32x4 gb = *(const f32x4*)(gate_b + col + 4 * n), pn = *(const f32x4*)(ple_norm + col + 4 * n);
            f32x4 hv = *(const f32x4*)(op + 4 * n);
            const f32x4 a = acc[ai][bj][m][n];
            hv[0] += sigmoidf_(a[0] + gb[0]) * (bflo(ev[2 * n]) * rse * pn[0]);
            hv[1] += sigmoidf_(a[1] + gb[1]) * (bfhi(ev[2 * n]) * rse * pn[1]);
            hv[2] += sigmoidf_(a[2] + gb[2]) * (bflo(ev[2 * n + 1]) * rse * pn[2]);
            hv[3] += sigmoidf_(a[3] + gb[3]) * (bfhi(ev[2 * n + 1]) * rse * pn[3]);
            *(f32x4*)(op + 4 * n) = hv;
          }
        }
        __builtin_amdgcn_sched_barrier(0);
      }
  }
};

DI void phase_inproj(const Params& P, int L, const Group& G, char* lds) {
  const int tid = opq(threadIdx.x), lane = tid & 63, w = tid >> 6, hh = lane >> 5, r = lane & 31;
  const int wm = w >> 1, wn = w & 1;
  const int nmt = G.ntok >> 8, ntile = nmt * 17;
  const bf16_t* A = P.X + (size_t)G.tok0 * DM;
  const bf16_t* Bw = P.WIN + (size_t)L * NIN * DM;
  {
    const pg8::Gemm g = {A, Bw, G.ntok, NIN, DM};
    const TileSched sch = {nmt, 17, 9, 13};
    const InProjEpi epi = {P.RS, P.CR, P.GRW, P.GDA, P.VT, G.tok0, G.S};
    pg8::gemm_phase<InProjEpi, TileSched, true, true>((PG8_LAS unsigned char*)lds, g, sch, epi);
  }
  for (int t = blockIdx.x; t < nmt * 4; t += gridDim.x) {
    const int mt = t >> 2, nt = 9 + (t & 3);
    const int m0 = mt << 8, n0 = nt << 8;
    f32x16 acc[2][4];
    gemm_mainloop(A, DM, Bw, DM, DM, m0, n0, lds, acc);
    const int colw = n0 + wn * 128 + 4 * hh;
    if (nt < 7) {
#pragma unroll
      for (int mi = 0; mi < 2; ++mi) {
        const int row = m0 + wm * 64 + mi * 32 + r;
        const float rsv = P.RS[G.tok0 + row];
        bf16_t* dst = P.CR + (size_t)row * CRW + colw;
#pragma unroll
        for (int ni = 0; ni < 4; ++ni)
#pragma unroll
          for (int q4 = 0; q4 < 4; ++q4) {
            u32x2 o = {pack2(acc[mi][ni][4 * q4] * rsv, acc[mi][ni][4 * q4 + 1] * rsv),
                       pack2(acc[mi][ni][4 * q4 + 2] * rsv, acc[mi][ni][4 * q4 + 3] * rsv)};
            *(u32x2*)(dst + ni * 32 + q4 * 8) = o;
          }
      }
    } else if (nt < 9 || nt >= 15) {
      bf16_t* dbase = nt < 9 ? P.GRW : P.GDA;
      const int c0 = colw - (nt < 9 ? 1792 : 3840);
#pragma unroll
      for (int mi = 0; mi < 2; ++mi) {
        const int row = m0 + wm * 64 + mi * 32 + r;
        const float rsv = P.RS[G.tok0 + row];
        bf16_t* dst = dbase + (size_t)row * 512 + c0;
#pragma unroll
        for (int ni = 0; ni < 4; ++ni)
#pragma unroll
          for (int q4 = 0; q4 < 4; ++q4) {
            u32x2 o = {pack2(siluf_(acc[mi][ni][4 * q4] * rsv), siluf_(acc[mi][ni][4 * q4 + 1] * rsv)),
                       pack2(siluf_(acc[mi][ni][4 * q4 + 2] * rsv), siluf_(acc[mi][ni][4 * q4 + 3] * rsv))};
            *(u32x2*)(dst + ni * 32 + q4 * 8) = o;
          }
      }
    } else if (nt < 13) {
      const bool isq = nt < 11;
      bf16_t* dbase = isq ? P.Q : P.KB;
      const int c0 = colw - (isq ? 2304 : 2816);
      const float* g = (isq ? P.q_norm : P.k_norm) + L * 128 + 4 * hh;
      const float osc = isq ? 0.125f * LOG2E : 1.f;
#pragma unroll
      for (int mi = 0; mi < 2; ++mi) {
        const int row = m0 + wm * 64 + mi * 32 + r;
        const float rsv = P.RS[G.tok0 + row];
        bf16_t* dst = dbase + (size_t)row * 512 + c0;
#pragma unroll
        for (int gi = 0; gi < 2; ++gi) {
          float ss = 0.f;
#pragma unroll
          for (int t2 = 0; t2 < 2; ++t2)
#pragma unroll
            for (int i = 0; i < 16; ++i) { const float v = acc[mi][2 * gi + t2][i] * rsv; ss += v * v; }
          ss += __shfl_xor(ss, 32);
          const float sc = rsqrtf(ss * (1.f / 64.f) + 1e-6f) * rsv * osc;
#pragma unroll
          for (int t2 = 0; t2 < 2; ++t2)
#pragma unroll
            for (int q4 = 0; q4 < 4; ++q4) {
              const f32x4 gv = *(const f32x4*)(g + gi * 64 + t2 * 32 + q4 * 8);
              u32x2 o = {pack2(acc[mi][2 * gi + t2][4 * q4] * sc * gv[0], acc[mi][2 * gi + t2][4 * q4 + 1] * sc * gv[1]),
                         pack2(acc[mi][2 * gi + t2][4 * q4 + 2] * sc * gv[2], acc[mi][2 * gi + t2][4 * q4 + 3] * sc * gv[3])};
              *(u32x2*)(dst + (2 * gi + t2) * 32 + q4 * 8) = o;
            }
        }
      }
    } else {
      const int hd = (n0 + wn * 128 - 3328) >> 7;
      const int row0 = m0 + wm * 64;
      const int b = row0 / G.S, s0 = row0 % G.S;
#pragma unroll
      for (int mi = 0; mi < 2; ++mi) {
        const int s = s0 + mi * 32 + r;
        const float rsv = P.RS[G.tok0 + b * G.S + s];
        bf16_t* dst = P.VT + ((size_t)((b * 4 + hd) * 128 + 4 * hh)) * G.S + s;
        const size_t Sz = (size_t)G.S;
#pragma unroll
        for (int ni = 0; ni < 4; ++ni)
#pragma unroll
          for (int q4 = 0; q4 < 4; ++q4) {
            bf16_t* pq = dst + (size_t)(ni * 32 + 8 * q4) * Sz;
            pq[0] = f2bf(acc[mi][ni][4 * q4] * rsv);
            pq[Sz] = f2bf(acc[mi][ni][4 * q4 + 1] * rsv);
            pq[2 * Sz] = f2bf(acc[mi][ni][4 * q4 + 2] * rsv);
            pq[3 * Sz] = f2bf(acc[mi][ni][4 * q4 + 3] * rsv);
            __builtin_amdgcn_sched_barrier(0);
          }
      }
    }
  }
}

DI void phase_outproj(const Params& P, int L, char* lds) {
  const float* h0 = L == 0 ? P.x_prompt : P.out;
  const float* h1 = L == 0 ? P.x_sample : P.out + (size_t)NP * DM;
  {
    const pg8::Gemm g = {P.X, P.WOUT + (size_t)L * DM * DM, NTOK, DM, DM};
    const TileSched sch = {NTOK >> 8, 4, 0, 0};
    const OutProjEpi epi = {h0, h1, P.out, P.R1};
    pg8::gemm_phase<OutProjEpi, TileSched, true, true>((PG8_LAS unsigned char*)lds, g, sch, epi);
  }
  {
    const int tid = opq(threadIdx.x), lane = tid & 63, w = tid >> 6, hh = lane >> 5, r = lane & 31;
    const int wm = w >> 1, wn = w & 1;
    const int ntile = (NTOK >> 8) * 4;
    for (int tt = blockIdx.x; tt < ntile; tt += gridDim.x) {
      const int mt = tt >> 2, nt = tt & 3;
      const int m0 = mt << 8, n0 = nt << 8;
      const int colw = n0 + wn * 128 + 4 * hh;
      f32x16 acc[2][4];
      gemm_mainloop(P.PB, DPLE, P.WPLE + (size_t)L * DM * DPLE, DPLE, DPLE, m0, n0, lds, acc);
#pragma unroll
      for (int mi = 0; mi < 2; ++mi) {
        const int row = m0 + wm * 64 + mi * 32 + r;
        bf16_t* rp = P.R2 + (size_t)row * DM + colw;
        float ss = 0.f;
#pragma unroll
        for (int ni = 0; ni < 4; ++ni)
#pragma unroll
          for (int q4 = 0; q4 < 4; ++q4) {
            const float v0 = acc[mi][ni][4 * q4], v1 = acc[mi][ni][4 * q4 + 1], v2 = acc[mi][ni][4 * q4 + 2], v3 = acc[mi][ni][4 * q4 + 3];
            ss += v0 * v0 + v1 * v1 + v2 * v2 + v3 * v3;
            u32x2 o = {pack2(v0, v1), pack2(v2, v3)};
            *(u32x2*)(rp + ni * 32 + q4 * 8) = o;
          }
        ss += __shfl_xor(ss, 32);
        if (hh == 0) P.EPART[(size_t)(nt * 2 + wn) * NTOK + row] = ss;
      }
    }
  }
}

DI void phase_gate(const Params& P, int L, char* lds) {
  const pg8::Gemm g = {P.R1, P.WGATE + (size_t)L * DM * DM, NTOK, DM, DM};
  const TileSched sch = {NTOK >> 8, 4, 0, 0};
  const GateEpi epi = {P.out, P.R2, P.EPART, P.gate_b + L * DM, P.ple_norm + L * DM};
  pg8::gemm_phase<GateEpi, TileSched, true, true>((PG8_LAS unsigned char*)lds, g, sch, epi);
}

constexpr int TC = 32;
constexpr int CB_OP = TC * 64 * 4;
constexpr int CB_BYTES = 6 * CB_OP + 128 + 1024;
constexpr int PW_BYTES = 10 * 640 + 2 * 8 * 144;
constexpr int PW_BASE = 2 * CB_BYTES;

template <int N> DI void red64v(float (&x)[N]) {
#pragma unroll
  for (int i = 0; i < N; ++i) x[i] += dppf<0xB1>(x[i]);
#pragma unroll
  for (int i = 0; i < N; ++i) x[i] += dppf<0x4E>(x[i]);
#pragma unroll
  for (int i = 0; i < N; ++i) x[i] += dppf<0x141>(x[i]);
#pragma unroll
  for (int i = 0; i < N; ++i) x[i] += dppf<0x140>(x[i]);
#pragma unroll
  for (int i = 0; i < N; ++i) x[i] += __shfl_xor(x[i], 16);
#pragma unroll
  for (int i = 0; i < N; ++i) x[i] += __shfl_xor(x[i], 32);
}

struct ScanOps { f32x4 a0, a1, b0, b1, k0, k1, r0, r1; f32x2 v; };

DI ScanOps scan_load(const float* __restrict__ ob, int s, int coff, int row0) {
  ScanOps o;
  const float* p = ob + s * 64 + coff;
  o.a0 = *(const f32x4*)(p + TC * 64);       o.a1 = *(const f32x4*)(p + TC * 64 + 4);
  o.b0 = *(const f32x4*)(p + 2 * TC * 64);   o.b1 = *(const f32x4*)(p + 2 * TC * 64 + 4);
  o.k0 = *(const f32x4*)(p + 3 * TC * 64);   o.k1 = *(const f32x4*)(p + 3 * TC * 64 + 4);
  o.r0 = *(const f32x4*)(p + 4 * TC * 64);   o.r1 = *(const f32x4*)(p + 4 * TC * 64 + 4);
  o.v = *(const f32x2*)(ob + 5 * TC * 64 + s * 64 + row0);
  return o;
}

DI f32x2 lo2(f32x4 x) { return f32x2{x[0], x[1]}; }
DI f32x2 hi2(f32x4 x) { return f32x2{x[2], x[3]}; }

DI f32x2 scan_step(f32x2 (&st)[2][4], const ScanOps& o) {
  const f32x2 a[4] = {lo2(o.a0), hi2(o.a0), lo2(o.a1), hi2(o.a1)};
  const f32x2 bv[4] = {lo2(o.b0), hi2(o.b0), lo2(o.b1), hi2(o.b1)};
  const f32x2 kv[4] = {lo2(o.k0), hi2(o.k0), lo2(o.k1), hi2(o.k1)};
  const f32x2 rv[4] = {lo2(o.r0), hi2(o.r0), lo2(o.r1), hi2(o.r1)};
  f32x2 y;
#pragma unroll
  for (int rr = 0; rr < 2; ++rr) {
    f32x2 p = st[rr][0] * a[0];
    p = st[rr][1] * a[1] + p; p = st[rr][2] * a[2] + p; p = st[rr][3] * a[3] + p;
    const float sa = red8(p[0] + p[1]);
    const f32x2 sa2 = {sa, sa};
    const f32x2 v2 = {o.v[rr], o.v[rr]};
    f32x2 q = {0.f, 0.f};
#pragma unroll
    for (int j = 0; j < 4; ++j) {
      f32x2 x = sa2 * bv[j] + st[rr][j];
      x = v2 * kv[j] + x;
      st[rr][j] = x;
      q = x * rv[j] + q;
    }
    y[rr] = red8(q[0] + q[1]);
  }
  return y;
}

DI void scan_task(const Params& P, int L_, const Group& G, int task, char* lds) {
  const int L = opqs(__builtin_amdgcn_readfirstlane(L_));
  const int tid = opq(threadIdx.x), lane = tid & 63, w = tid >> 6;
  const int dir = task & 1, b = task >> 4, hd = (task >> 1) & 7;
  const int S = G.S, nc = S / TC;
  const int sg = dir ? -1 : 1;
  const bf16_t* crb = P.CR + (size_t)b * S * CRW;

  const int srow0 = (w & 3) * 16 + (lane >> 3) * 2, scs = lane & 7;
  f32x2 st[2][4];
#pragma unroll
  for (int rr = 0; rr < 2; ++rr)
#pragma unroll
    for (int j = 0; j < 4; ++j) st[rr][j] = f32x2{0.f, 0.f};

  const int pw = w & 3, ec = lane, hh = lane >> 5, r = lane & 31;
  char* pwb = lds + PW_BASE + pw * PW_BYTES;
  const int ch = hd * 64 + ec;
  const float c_kk = P.k_k[L * 512 + ch], c_ka = P.k_a[L * 512 + ch], c_rk = P.r_k[L * 512 + ch];
  const float* cw = P.conv_w + (size_t)L * 3 * 1728;
  const float* cb = P.conv_b + (size_t)L * 1728;
  const bf16_t* wsrcW = P.WUPT + (size_t)(L * 2 + dir) * 512 * 64 + (size_t)(hd * 64 + r) * 64 + hh * 8;
  const bf16_t* wsrcA = P.AUPT + (size_t)L * 512 * 64 + (size_t)(hd * 64 + r) * 64 + hh * 8;
  const float* w0p = P.w0 + (size_t)(L * 2 + dir) * 512 + hd * 64 + r;
  const float* a0p = P.a0 + (size_t)L * 512 + hd * 64 + r;

  auto prepare = [&](int cc, char* cbuf) {
    float* oW = (float*)cbuf; float* oA = (float*)(cbuf + CB_OP); float* oB = (float*)(cbuf + 2 * CB_OP);
    float* oK = (float*)(cbuf + 3 * CB_OP); float* oR = (float*)(cbuf + 4 * CB_OP); float* oV = (float*)(cbuf + 5 * CB_OP);
    float* oBon = (float*)(cbuf + 6 * CB_OP);
    const int ln = opq(lane);
    const int tbase = dir ? S - cc * TC - 8 * pw - 9 : cc * TC + 8 * pw - 1;
    {
      u32x4 rv[7];
#pragma unroll
      for (int it = 0; it < 7; ++it) {
        int id = ln + it * 64;
        id = id < 400 ? id : 399;
        const int rr = id / 40, cc8 = id % 40, q = cc8 >> 3, c8 = (cc8 & 7) * 8;
        const int tok = tbase + rr;
        const bool ok = tok >= 0 && tok < S;
        const int tokc = tok < 0 ? 0 : (tok >= S ? S - 1 : tok);
        const int col = (q == 0 ? hd * 64 : q == 1 ? 512 + hd * 64 : q == 2 ? 1024 + hd * 64 : q == 3 ? 1536 + dir * 64 : 1664) + c8;
        const u32x4 v = *(const u32x4*)(crb + (size_t)tokc * CRW + col);
        const u32x4 z = {0u, 0u, 0u, 0u};
        rv[it] = ok ? v : z;
      }
#pragma unroll
      for (int it = 0; it < 7; ++it) {
        int id = ln + it * 64;
        id = id < 400 ? id : 399;
        *(u32x4*)(pwb + (id / 40) * 640 + (id % 40) * 16) = rv[it];
      }
    }
    asm volatile("" ::: "memory");
    float cwp[5], cwc[5], cwn[5], cbb[5];
#pragma unroll
    for (int q = 0; q < 5; ++q) {
      const int cqq = (q == 0 ? hd * 64 : q == 1 ? 512 + hd * 64 : q == 2 ? 1024 + hd * 64 : q == 3 ? 1536 + dir * 64 : 1664) + ln;
      const float w0 = cw[cqq], w1 = cw[1728 + cqq], w2 = cw[2 * 1728 + cqq];
      cwp[q] = dir ? w2 : w0; cwc[q] = w1; cwn[q] = dir ? w0 : w2; cbb[q] = cb[cqq];
    }
    bf16x8 lf[2][2][4];
#pragma unroll
    for (int nb = 0; nb < 2; ++nb)
#pragma unroll
      for (int ks = 0; ks < 4; ++ks) {
        lf[0][nb][ks] = *(const bf16x8*)(wsrcW + nb * 32 * 64 + ks * 16);
        lf[1][nb][ks] = *(const bf16x8*)(wsrcA + nb * 32 * 64 + ks * 16);
      }
    const bf16_t* raw = (const bf16_t*)pwb;
    bf16_t* zt = (bf16_t*)(pwb + 6400); bf16_t* za = (bf16_t*)(pwb + 6400 + 8 * 144);
    float kreg[8];
#pragma unroll
    for (int hf = 0; hf < 2; ++hf) {
      float xr[6][5];
#pragma unroll
      for (int j = 0; j < 6; ++j) {
        const int vi = hf * 4 + j - 1;
        const int jj = dir ? 8 - vi : vi + 1;
#pragma unroll
        for (int q = 0; q < 5; ++q) xr[j][q] = bf2f(raw[jj * 320 + q * 64 + ln]);
      }
#pragma unroll
      for (int i = 0; i < 4; ++i) {
        float v[5];
#pragma unroll
        for (int q = 0; q < 5; ++q) v[q] = cbb[q] + cwp[q] * xr[i][q] + cwc[q] * xr[i + 1][q] + cwn[q] * xr[i + 2][q];
        const int ti = hf * 4 + i, s = 8 * pw + ti;
        oR[s * 64 + ln] = v[0];
        kreg[ti] = v[1];
        oV[s * 64 + ln] = v[2];
        zt[ti * 72 + ln] = f2bf(tanhf_(v[3]));
        za[ti * 72 + ln] = f2bf(v[4]);
      }
    }
    asm volatile("" ::: "memory");
    {
      const char* az = (const char*)zt + (r & 7) * 144 + hh * 16;
      const char* aa = (const char*)za + (r & 7) * 144 + hh * 16;
#pragma unroll
      for (int nb = 0; nb < 2; ++nb) {
        f32x16 accw, acca;
#pragma unroll
        for (int i = 0; i < 16; ++i) { accw[i] = 0.f; acca[i] = 0.f; }
#pragma unroll
        for (int ks = 0; ks < 4; ++ks) {
          const bf16x8 fz = *(const bf16x8*)(az + ks * 32);
          const bf16x8 fa = *(const bf16x8*)(aa + ks * 32);
          accw = MFMA(fz, lf[0][nb][ks], accw);
          acca = MFMA(fa, lf[1][nb][ks], acca);
        }
        const float w0v = w0p[nb * 32], a0v = a0p[nb * 32];
#pragma unroll
        for (int i = 0; i < 4; ++i) {
          const int s = 8 * pw + 4 * hh + i;
          oW[s * 64 + nb * 32 + r] = __expf(-0.6065306597126334f * sigmoidf_(w0v + accw[i]));
          oA[s * 64 + nb * 32 + r] = sigmoidf_(a0v + acca[i]);
        }
      }
    }
    asm volatile("" ::: "memory");
    {
      float ag[8], kk[8], ss[8], km[8], bn[8];
#pragma unroll
      for (int i = 0; i < 8; ++i) {
        const int s = 8 * pw + i;
        ag[i] = oA[s * 64 + ln];
        kk[i] = kreg[i] * c_kk;
        ss[i] = kk[i] * kk[i];
        km[i] = kreg[i] * (1.f + (ag[i] - 1.f) * c_ka);
        bn[i] = oR[s * 64 + ln] * km[i] * c_rk;
      }
      red64v<8>(ss);
      red64v<8>(bn);
      float g = 1.f;
#pragma unroll
      for (int i = 0; i < 8; ++i) {
        const int s = 8 * pw + i;
        const float kn = kk[i] * rsqrtf(ss[i] + 1e-12f);
        const float gprev = g;
        g *= oW[s * 64 + ln];
        const float ginv = __builtin_amdgcn_rcpf(g);
        oK[s * 64 + ln] = km[i] * ginv;
        oA[s * 64 + ln] = -kn * gprev;
        oB[s * 64 + ln] = kn * ag[i] * ginv;
        oR[s * 64 + ln] = oR[s * 64 + ln] * g;
        if (ln == 0) oBon[s] = bn[i];
      }
      ((float*)(cbuf + 6 * CB_OP + 128))[pw * 64 + ln] = g;
    }
  };

  __syncthreads();
  if (w >= 4) prepare(0, lds);
  __syncthreads();
  if (__builtin_amdgcn_readfirstlane(w) < 4) __builtin_amdgcn_s_setprio(2);

  for (int c = 0; c < nc; ++c) {
    char* cbuf = lds + (c & 1) * CB_BYTES;
    if (w < 4) {
      const float* sb = (const float*)cbuf;
      const float* oBon = (const float*)(cbuf + 6 * CB_OP);
      ScanOps cur = scan_load(sb, 0, scs * 8, srow0);
#pragma unroll 1
      for (int s8 = 0; s8 < TC; s8 += 8) {
        f32x2 ykeep = {0.f, 0.f};
#pragma unroll
        for (int u = 0; u < 8; ++u) {
          const int s = s8 + u;
          const ScanOps nxt = scan_load(sb, s + 1 < TC ? s + 1 : s, scs * 8, srow0);
          const f32x2 y = scan_step(st, cur);
          if (u == scs) ykeep = y;
          cur = nxt;
        }
        {
          const float* g8 = (const float*)(cbuf + 6 * CB_OP + 128) + (s8 >> 3) * 64 + scs * 8;
          const f32x4 ga = *(const f32x4*)g8, gb = *(const f32x4*)(g8 + 4);
          const f32x2 gg[4] = {lo2(ga), hi2(ga), lo2(gb), hi2(gb)};
#pragma unroll
          for (int rr = 0; rr < 2; ++rr)
#pragma unroll
            for (int j = 0; j < 4; ++j) st[rr][j] = st[rr][j] * gg[j];
        }
        const int s = s8 + scs;
        const int ts = dir ? S - 1 - (c * TC + s) : c * TC + s;
        const size_t lt = (size_t)b * S + ts;
        const unsigned yv = pack2(ykeep[0], ykeep[1]);
        if (dir == 0) {
          *(unsigned*)(P.X + ((size_t)G.tok0 + lt) * DM + hd * 64 + srow0) = yv;
          const float bon = oBon[s];
          const f32x2 vv = *(const f32x2*)(sb + 5 * TC * 64 + s * 64 + srow0);
          *(unsigned*)(P.BV + lt * 512 + hd * 64 + srow0) = pack2(bon * vv[0], bon * vv[1]);
        } else {
          *(unsigned*)(P.YB + lt * 512 + hd * 64 + srow0) = yv;
        }
      }
    } else if (c + 1 < nc) {
      prepare(c + 1, lds + ((c + 1) & 1) * CB_BYTES);
    }
    __syncthreads();
  }
  __builtin_amdgcn_s_setprio(0);
}

DI void phase_rwkv_final(const Params& P, int L, const Group& G) {
  const int tidp = opq(threadIdx.x);
  const int lane = tidp & 63;
  const int gw = blockIdx.x * (NTHREADS / 64) + (tidp >> 6), nw = gridDim.x * (NTHREADS / 64);
  const f32x4 g0 = *(const f32x4*)(P.ln_g + L * 512 + lane * 8), g1 = *(const f32x4*)(P.ln_g + L * 512 + lane * 8 + 4);
  const f32x4 b0 = *(const f32x4*)(P.ln_b + L * 512 + lane * 8), b1 = *(const f32x4*)(P.ln_b + L * 512 + lane * 8 + 4);
  const float lg[8] = {g0[0], g0[1], g0[2], g0[3], g1[0], g1[1], g1[2], g1[3]};
  const float lb[8] = {b0[0], b0[1], b0[2], b0[3], b1[0], b1[1], b1[2], b1[3]};
  for (int lt = gw; lt < G.ntok; lt += nw) {
    bf16_t* xp = P.X + ((size_t)G.tok0 + lt) * DM + lane * 8;
    const u32x4 yf = *(const u32x4*)xp;
    const u32x4 yb = *(const u32x4*)(P.YB + (size_t)lt * 512 + lane * 8);
    const u32x4 bv = *(const u32x4*)(P.BV + (size_t)lt * 512 + lane * 8);
    const u32x4 gt = *(const u32x4*)(P.GRW + (size_t)lt * 512 + lane * 8);
    float y[8];
    float sum = 0.f;
#pragma unroll
    for (int j = 0; j < 4; ++j) {
      y[2 * j] = bflo(yf[j]) + bflo(yb[j]); y[2 * j + 1] = bfhi(yf[j]) + bfhi(yb[j]);
      sum += y[2 * j] + y[2 * j + 1];
    }
    const float mu = red8(sum) * (1.f / 64.f);
    float vs = 0.f;
#pragma unroll
    for (int j = 0; j < 8; ++j) { y[j] -= mu; vs += y[j] * y[j]; }
    const float rstd = rsqrtf(red8(vs) * (1.f / 64.f) + 64e-5f);
    u32x4 o;
#pragma unroll
    for (int j = 0; j < 4; ++j) {
      const float o0 = (y[2 * j] * rstd * lg[2 * j] + lb[2 * j] + bflo(bv[j])) * bflo(gt[j]);
      const float o1 = (y[2 * j + 1] * rstd * lg[2 * j + 1] + lb[2 * j + 1] + bfhi(bv[j])) * bfhi(gt[j]);
      o[j] = pack2(o0, o1);
    }
    *(u32x4*)xp = o;
  }
}

constexpr int AT_K = 64 * GSTR;
constexpr int AT_STAGE = 2 * AT_K + 128 * GSTR;

DI void attn_item(const Params& P, int L_, const Group& G, int item, char* lds) {
  const int L = opqs(__builtin_amdgcn_readfirstlane(L_));
  const int tid = opq(threadIdx.x), lane = tid & 63, w = tid >> 6, hh = lane >> 5, r = lane & 31;
  const int S = G.S, nqb = S >> 7;
  const int qblk = item % nqb, bh = item / nqb, hd = bh & 3, b = bh >> 2;
  const int map = w & 1, qb = w >> 1;
  const int q0 = qblk * 128 + qb * 32;
  const size_t ltq = (size_t)b * S + q0 + r;
  bf16x8 qf[4];
  {
    const bf16_t* qp = P.Q + ltq * 512 + hd * 128 + map * 64 + hh * 8;
#pragma unroll
    for (int ks = 0; ks < 4; ++ks) qf[ks] = *(const bf16x8*)(qp + ks * 16);
  }
  f32x16 o[4];
#pragma unroll
  for (int d = 0; d < 4; ++d)
#pragma unroll
    for (int i = 0; i < 16; ++i) o[d][i] = 0.f;
  f32x16 accl;
#pragma unroll
  for (int i = 0; i < 16; ++i) accl[i] = 0.f;
  const float slope2 = exp2f(-2.f * (float)(hd + 1)) * LOG2E;
  float so[16];
#pragma unroll
  for (int i = 0; i < 16; ++i) so[i] = slope2 * (float)(16 * (i >> 3) + (i & 7));
  bf16x8 ones;
#pragma unroll
  for (int j = 0; j < 8; ++j) ones[j] = (short)0x3F80;
  const float lam = P.consts[L * 4 + 0], C2 = P.consts[L * 4 + 1], lam_init = P.consts[L * 4 + 2];
  const float qposf = (float)(q0 + r);
  const int Dz = (int)ceilf(150.f / slope2);
  const int Q0 = qblk * 128;
  const int tlo = (Q0 - 63 - Dz) < 0 ? 0 : (Q0 - 63 - Dz) / 64 + 1;
  const int thx = min(S >> 6, (Q0 + 127 + Dz + 63) / 64);
  const int nt = thx - tlo;
  const int lrow = tid >> 3, lck = tid & 7;
  const bf16_t* k0p = P.KB + ((size_t)b * S + tlo * 64 + lrow) * 512 + hd * 128 + lck * 8;
  const bf16_t* v0p = P.VT + ((size_t)((b * 4 + hd) * 128 + lrow)) * S + tlo * 64 + lck * 8;
  u32x4 ra0, ra1, ra2, ra3, rb0, rb1, rb2, rb3;
  auto ldtile = [&](int tt, u32x4& x0, u32x4& x1, u32x4& x2, u32x4& x3) {
    const int tc = tt < nt ? tt : nt - 1;
    x0 = *(const u32x4*)(k0p + (size_t)tc * 64 * 512); x1 = *(const u32x4*)(k0p + (size_t)tc * 64 * 512 + 64);
    x2 = *(const u32x4*)(v0p + tc * 64); x3 = *(const u32x4*)(v0p + (size_t)64 * S + tc * 64);
  };
  auto sttile = [&](int slot, const u32x4& x0, const u32x4& x1, const u32x4& x2, const u32x4& x3) {
    char* d = lds + slot * AT_STAGE;
    *(u32x4*)(d + lrow * GSTR + lck * 16) = x0;
    *(u32x4*)(d + AT_K + lrow * GSTR + lck * 16) = x1;
    *(u32x4*)(d + 2 * AT_K + lrow * GSTR + lck * 16) = x2;
    *(u32x4*)(d + 2 * AT_K + (lrow + 64) * GSTR + lck * 16) = x3;
  };
  ldtile(0, ra0, ra1, ra2, ra3);
  ldtile(1, rb0, rb1, rb2, rb3);
  __syncthreads();
  sttile(0, ra0, ra1, ra2, ra3);
  ldtile(2, ra0, ra1, ra2, ra3);
  __syncthreads();
  const int krow = (r & ~12) | ((r & 4) << 1) | ((r & 8) >> 1);
  auto compute = [&](int t) {
    const char* kbuf = lds + (t & 1) * AT_STAGE + map * AT_K;
    const char* vbuf = lds + (t & 1) * AT_STAGE + 2 * AT_K;
    f32x16 s0, s1;
    const int kt0 = (tlo + t) * 64;
    const float base = (float)(kt0 + 8 * hh) - qposf;
    if (kt0 + 63 < q0) {
      const float bl = fmaf(slope2, base, -C2), bl2 = bl + 32.f * slope2;
#pragma unroll
      for (int i = 0; i < 16; ++i) { s0[i] = bl + so[i]; s1[i] = bl2 + so[i]; }
    } else if (kt0 > q0 + 31) {
      const float br = fmaf(-slope2, base, -C2), br2 = br - 32.f * slope2;
#pragma unroll
      for (int i = 0; i < 16; ++i) { s0[i] = br - so[i]; s1[i] = br2 - so[i]; }
    } else {
#pragma unroll
      for (int i = 0; i < 16; ++i) {
        const float d0 = base + (float)(16 * (i >> 3) + (i & 7));
        s0[i] = fmaf(fabsf(d0), -slope2, -C2);
        s1[i] = fmaf(fabsf(d0 + 32.f), -slope2, -C2);
      }
    }
#pragma unroll
    for (int ks = 0; ks < 4; ++ks) {
      const bf16x8 a0 = *(const bf16x8*)(kbuf + krow * GSTR + ks * 32 + hh * 16);
      const bf16x8 a1 = *(const bf16x8*)(kbuf + (32 + krow) * GSTR + ks * 32 + hh * 16);
      s0 = MFMA(a0, qf[ks], s0);
      s1 = MFMA(a1, qf[ks], s1);
    }
    bf16x8 pf[4];
    {
      u32x4 pk[4];
#pragma unroll
      for (int i = 0; i < 16; i += 2) {
        const float e0 = __builtin_amdgcn_exp2f(s0[i]), e1 = __builtin_amdgcn_exp2f(s0[i + 1]);
        const float e2 = __builtin_amdgcn_exp2f(s1[i]), e3 = __builtin_amdgcn_exp2f(s1[i + 1]);
        pk[i >> 3][(i & 7) >> 1] = pack2(e0, e1);
        pk[2 + (i >> 3)][(i & 7) >> 1] = pack2(e2, e3);
      }
#pragma unroll
      for (int j = 0; j < 4; ++j) pf[j] = __builtin_bit_cast(bf16x8, pk[j]);
    }
#pragma unroll
    for (int j = 0; j < 4; ++j) accl = MFMA(ones, pf[j], accl);
#pragma unroll
    for (int dvb = 0; dvb < 4; ++dvb)
#pragma unroll
      for (int j = 0; j < 4; ++j) {
        const bf16x8 va = *(const bf16x8*)(vbuf + (dvb * 32 + r) * GSTR + (16 * j + 8 * hh) * 2);
        o[dvb] = MFMA(va, pf[j], o[dvb]);
      }
  };
  for (int t = 0; t < nt; t += 2) {
    compute(t);
    sttile(1, rb0, rb1, rb2, rb3);
    __builtin_amdgcn_sched_barrier(0);
    ldtile(t + 3, rb0, rb1, rb2, rb3);
    __builtin_amdgcn_sched_barrier(0);
    __syncthreads();
    if (t + 1 >= nt) break;
    compute(t + 1);
    sttile(0, ra0, ra1, ra2, ra3);
    __builtin_amdgcn_sched_barrier(0);
    ldtile(t + 4, ra0, ra1, ra2, ra3);
    __builtin_amdgcn_sched_barrier(0);
    __syncthreads();
  }
  const float linv = 1.f / accl[0];
  float* comb = (float*)lds;
  if (map == 1) {
#pragma unroll
    for (int dvb = 0; dvb < 4; ++dvb)
#pragma unroll
      for (int i = 0; i < 16; ++i) comb[(qb * 64 + dvb * 16 + i) * 64 + lane] = o[dvb][i] * linv;
  }
  __syncthreads();
  if (map == 0) {
    float ss = 0.f;
#pragma unroll
    for (int dvb = 0; dvb < 4; ++dvb)
#pragma unroll
      for (int i = 0; i < 16; ++i) {
        const float v = o[dvb][i] * linv - lam * comb[(qb * 64 + dvb * 16 + i) * 64 + lane];
        o[dvb][i] = v; ss += v * v;
      }
    ss += __shfl_xor(ss, 32);
    const float sc = rsqrtf(ss * (1.f / 128.f) + 1e-6f) * (1.f - lam_init);
    const bf16_t* gp = P.GDA + ltq * 512 + hd * 128;
    bf16_t* yp = P.X + ((size_t)G.tok0 + ltq) * DM + 512 + hd * 128;
    const float* sl = P.subln + L * 128;
#pragma unroll
    for (int dvb = 0; dvb < 4; ++dvb)
#pragma unroll
      for (int q4 = 0; q4 < 4; ++q4) {
        const int dv = dvb * 32 + 8 * q4 + 4 * hh;
        const u32x2 g = *(const u32x2*)(gp + dv);
        const f32x4 s4 = *(const f32x4*)(sl + dv);
        u32x2 ov = {pack2(o[dvb][4 * q4] * sc * s4[0] * bflo(g[0]), o[dvb][4 * q4 + 1] * sc * s4[1] * bfhi(g[0])),
                    pack2(o[dvb][4 * q4 + 2] * sc * s4[2] * bflo(g[1]), o[dvb][4 * q4 + 3] * sc * s4[3] * bfhi(g[1]))};
        *(u32x2*)(yp + dv) = ov;
      }
  }
}

DI void phase_mixers(const Params& P, int L, const Group& G, int* ctr, char* lds, int* s_item, int mode = 0) {
  const int nscan = mode == 2 ? 0 : G.B * 16;
  const int nattn = mode == 1 ? 0 : G.B * 4 * (G.S >> 7);
  const int total = nscan + nattn;
  for (;;) {
    __syncthreads();
    if (threadIdx.x == 0) *s_item = atomicAdd(ctr, 1);
    __syncthreads();
    const int it = *s_item;
    if (it >= total) break;
    if (it < nscan) scan_task(P, L, G, it, lds);
    else attn_item(P, L, G, it - nscan, lds);
  }
}

__global__ void __launch_bounds__(NTHREADS) fwd_megakernel(Params P) {
  __shared__ __attribute__((aligned(16))) char lds[LDS_BYTES];
  __shared__ int s_item;
  cg::grid_group grid = cg::this_grid();
  phase_weights(P, lds);
  for (int ph = 0; ph < 18; ++ph) {
    const int L = ph / 9, k = ph % 9;
    const int g = (k >= 4 && k <= 6) ? 1 : 0;
    Group G;
    G.tok0 = g ? NP : 0; G.B = g ? 8 : 16; G.S = g ? 8192 : 2048; G.ntok = g ? NS : NP;
#ifdef PROBE_SCAN
    if (k == 2 || k == 5) { phase_mixers(P, L, G, P.ctr + 64 + (L * 2 + g) * 16, lds, &s_item, 1); grid.sync(); }
#endif
#ifdef PROBE_ATTN
    if (k == 2 || k == 5) { phase_mixers(P, L, G, P.ctr + 128 + (L * 2 + g) * 16, lds, &s_item, 2); grid.sync(); }
#endif
#ifdef PROBE_INPROJ
    if (k == 1 || k == 4) { phase_inproj(P, L, G, lds); grid.sync(); }
#endif
    if (k == 0) phase_prep(P, L);
    else if (k == 1 || k == 4) phase_inproj(P, L, G, lds);
    else if (k == 2 || k == 5) phase_mixers(P, L, G, P.ctr + (L * 2 + g) * 16, lds, &s_item);
    else if (k == 3 || k == 6) phase_rwkv_final(P, L, G);
    else if (k == 7) phase_outproj(P, L, lds);
    else phase_gate(P, L, lds);
    grid.sync();
  }
}

extern "C" void kernel_launch(void* const* d_in, const int* in_sizes, int n_in, void* d_out, int out_size, void* d_ws,
                              size_t ws_size, hipStream_t stream) {
  Params P{};
  const float* const* in = (const float* const*)d_in;
  P.x_prompt = in[0]; P.x_sample = in[1]; P.p_prompt = in[2]; P.p_sample = in[3];
  P.norm_pre = in[4]; P.w_in = in[5]; P.w_out = in[6]; P.conv_w = in[7]; P.conv_b = in[8];
  P.w0 = in[9]; P.w_up = in[10]; P.a0 = in[11]; P.a_up = in[12]; P.k_k = in[13]; P.k_a = in[14];
  P.r_k = in[15]; P.ln_g = in[16]; P.ln_b = in[17]; P.q_norm = in[18]; P.k_norm = in[19];
  P.lam_vec = in[20]; P.subln = in[21]; P.ple_proj = in[22]; P.ple_norm = in[23];
  P.gate_w = in[24]; P.gate_b = in[25];
  P.out = (float*)d_out;
  char* ws = (char*)d_ws;
  size_t off = 0;
  auto take = [&](size_t bytes) { char* p = ws + off; off += (bytes + 255) & ~(size_t)255; return p; };
  P.ctr = (int*)take(1024);
  P.consts = (float*)take(1024);
  P.X = (bf16_t*)take((size_t)NTOK * DM * 2);
  P.PB = (bf16_t*)take((size_t)NTOK * DPLE * 2);
  P.RS = (float*)take((size_t)NTOK * 4);
  P.WIN = (bf16_t*)take((size_t)2 * NIN * DM * 2);
  P.WOUT = (bf16_t*)take((size_t)2 * DM * DM * 2);
  P.WPLE = (bf16_t*)take((size_t)2 * DM * DPLE * 2);
  P.WGATE = (bf16_t*)take((size_t)2 * DM * DM * 2);
  P.WUPT = (bf16_t*)take((size_t)4 * 512 * 64 * 2);
  P.AUPT = (bf16_t*)take((size_t)2 * 512 * 64 * 2);
  P.CR = (bf16_t*)take((size_t)GS * CRW * 2);
  P.GRW = (bf16_t*)take((size_t)GS * 512 * 2);
  P.Q = (bf16_t*)take((size_t)GS * 512 * 2);
  P.KB = (bf16_t*)take((size_t)GS * 512 * 2);
  P.VT = (bf16_t*)take((size_t)GS * 512 * 2);
  P.GDA = (bf16_t*)take((size_t)GS * 512 * 2);
  P.YB = (bf16_t*)take((size_t)GS * 512 * 2);
  P.BV = (bf16_t*)take((size_t)GS * 512 * 2);
  P.R1 = P.CR;
  P.R2 = P.GRW;
  P.EPART = (float*)P.VT;
  if (off > ws_size) { fprintf(stderr, "workspace too small: need %zu have %zu\n", off, ws_size); return; }
  hipMemsetAsync(P.ctr, 0, 1024, stream);
  static int grid_blocks = 0;
  if (!grid_blocks) {
    int dev = 0, cus = 0, per_cu = 0;
    hipGetDevice(&dev);
    hipDeviceGetAttribute(&cus, hipDeviceAttributeMultiprocessorCount, dev);
    hipOccupancyMaxActiveBlocksPerMultiprocessor(&per_cu, fwd_megakernel, NTHREADS, 0);
    if (per_cu < 1) { fprintf(stderr, "occupancy query returned %d\n", per_cu); per_cu = 1; }
    grid_blocks = 256;
    if (cus < 256) fprintf(stderr, "unexpected CU count %d\n", cus);
  }
  void* args[] = {&P};
  hipError_t e = hipLaunchCooperativeKernel((void*)fwd_megakernel, dim3(grid_blocks), dim3(NTHREADS), args, 0, stream);
  if (e != hipSuccess) fprintf(stderr, "cooperative launch failed: %s (grid %d)\n", hipGetErrorString(e), grid_blocks);
}
```

```cpp
#include <hip/hip_runtime.h>
#include <hip/hip_cooperative_groups.h>
#include <cstdio>
namespace cg = cooperative_groups;

#define DI __device__ __forceinline__
typedef __attribute__((ext_vector_type(8))) short bf16x8;
typedef __attribute__((ext_vector_type(16))) float f32x16;
typedef __attribute__((ext_vector_type(4))) float f32x4;
typedef __attribute__((ext_vector_type(2))) float f32x2;
typedef __attribute__((ext_vector_type(4))) unsigned u32x4;
typedef __attribute__((ext_vector_type(2))) unsigned u32x2;
typedef unsigned short bf16_t;
#define MFMA(a, b, c) __builtin_amdgcn_mfma_f32_32x32x16_bf16((a), (b), (c), 0, 0, 0)

constexpr int DM = 1024;
constexpr int NP = 16 * 2048;
constexpr int NS = 8 * 8192;
constexpr int NTOK = NP + NS;
constexpr int DPLE = 256;
constexpr int IN_COLS = 4288;
constexpr int NIN = 4352;
constexpr int CRW = 1792;
constexpr int GS = NS;
constexpr float LOG2E = 1.4426950408889634f;
constexpr int NTHREADS = 512;
constexpr int LDS_BYTES = 147456;

struct Params {
  const float* x_prompt; const float* x_sample; const float* p_prompt; const float* p_sample;
  const float* norm_pre; const float* w_in; const float* w_out; const float* conv_w; const float* conv_b;
  const float* w0; const float* w_up; const float* a0; const float* a_up; const float* k_k; const float* k_a;
  const float* r_k; const float* ln_g; const float* ln_b; const float* q_norm; const float* k_norm;
  const float* lam_vec; const float* subln; const float* ple_proj; const float* ple_norm;
  const float* gate_w; const float* gate_b;
  float* out;
  bf16_t* X; bf16_t* PB; float* RS;
  bf16_t* CR; bf16_t* GRW; bf16_t* Q; bf16_t* KB; bf16_t* VT; bf16_t* GDA;
  bf16_t* R1; bf16_t* R2; float* EPART; bf16_t* YB; bf16_t* BV;
  bf16_t* WIN; bf16_t* WOUT; bf16_t* WPLE; bf16_t* WGATE; bf16_t* WUPT; bf16_t* AUPT;
  float* consts; int* ctr;
};

struct Group { int tok0, B, S, ntok; };

DI unsigned pack2(float a, float b) {
  typedef __attribute__((ext_vector_type(2))) __bf16 bf2;
  f32x2 v = {a, b};
  bf2 r = __builtin_convertvector(v, bf2);
  return __builtin_bit_cast(unsigned, r);
}
DI bf16_t f2bf(float a) { return (bf16_t)(pack2(a, 0.f) & 0xffffu); }
DI float bf2f(unsigned short u) { return __uint_as_float(((unsigned)u) << 16); }
DI float bflo(unsigned u) { return __uint_as_float(u << 16); }
DI float bfhi(unsigned u) { return __uint_as_float(u & 0xffff0000u); }
template <int CTRL> DI float dppf(float x) {
  return __int_as_float(__builtin_amdgcn_update_dpp(0, __float_as_int(x), CTRL, 0xF, 0xF, true));
}
DI float red4(float x) { x += dppf<0xB1>(x); x += dppf<0x4E>(x); return x; }
DI float red8(float x) { x = red4(x); x += dppf<0x141>(x); return x; }
DI float red32(float x) {
  x += __shfl_xor(x, 1); x += __shfl_xor(x, 2); x += __shfl_xor(x, 4); x += __shfl_xor(x, 8); x += __shfl_xor(x, 16);
  return x;
}
DI float sigmoidf_(float x) { return __builtin_amdgcn_rcpf(1.f + __expf(-x)); }
DI float siluf_(float x) { return x * __builtin_amdgcn_rcpf(1.f + __expf(-x)); }
DI float tanhf_(float x) { return 1.f - 2.f * __builtin_amdgcn_rcpf(1.f + __expf(2.f * x)); }
DI int opq(int x) { asm volatile("" : "+v"(x)); return x; }
DI int opqs(int x) { asm volatile("" : "+s"(x)); return x; }
DI int crow(int i, int h) { return (i & 3) + 8 * (i >> 2) + 4 * h; }

DI void transpose_convert(const float* __restrict__ src, int K, int N, bf16_t* __restrict__ dst, int Nd, int mode,
                          const float* __restrict__ rowscale, float* lds) {
  const int tid = opq(threadIdx.x);
  const int tk = K >> 6, tn = Nd >> 6;
  for (int t = blockIdx.x; t < tk * tn; t += gridDim.x) {
    const int k0 = (t % tk) << 6, n0 = (t / tk) << 6;
    int sn0 = n0;
    if (mode == 1) sn0 = (n0 < 1728) ? n0 : (n0 < 1792 ? -1 : n0 - 64);
    __syncthreads();
#pragma unroll
    for (int it = 0; it < 2; ++it) {
      const int kk = (tid >> 4) + 32 * it, n4 = (tid & 15) * 4;
      f32x4 v = {0.f, 0.f, 0.f, 0.f};
      if (sn0 >= 0) v = *(const f32x4*)(src + (size_t)(k0 + kk) * N + sn0 + n4);
      const float sc = rowscale ? rowscale[k0 + kk] : 1.f;
      lds[kk * 65 + n4 + 0] = v[0] * sc; lds[kk * 65 + n4 + 1] = v[1] * sc;
      lds[kk * 65 + n4 + 2] = v[2] * sc; lds[kk * 65 + n4 + 3] = v[3] * sc;
    }
    __syncthreads();
    const int nn = tid >> 3, k8 = (tid & 7) * 8;
    u32x4 o;
    o[0] = pack2(lds[(k8 + 0) * 65 + nn], lds[(k8 + 1) * 65 + nn]);
    o[1] = pack2(lds[(k8 + 2) * 65 + nn], lds[(k8 + 3) * 65 + nn]);
    o[2] = pack2(lds[(k8 + 4) * 65 + nn], lds[(k8 + 5) * 65 + nn]);
    o[3] = pack2(lds[(k8 + 6) * 65 + nn], lds[(k8 + 7) * 65 + nn]);
    *(u32x4*)(dst + (size_t)(n0 + nn) * K + k0 + k8) = o;
  }
}

DI void phase_weights(const Params& P, char* lds) {
  float* l = (float*)lds;
  for (int L = 0; L < 2; ++L) {
    transpose_convert(P.w_in + (size_t)L * DM * IN_COLS, DM, IN_COLS, P.WIN + (size_t)L * NIN * DM, NIN, 1, P.norm_pre + L * DM, l);
    transpose_convert(P.w_out + (size_t)L * DM * DM, DM, DM, P.WOUT + (size_t)L * DM * DM, DM, 0, nullptr, l);
    transpose_convert(P.ple_proj + (size_t)L * DPLE * DM, DPLE, DM, P.WPLE + (size_t)L * DM * DPLE, DM, 0, nullptr, l);
    transpose_convert(P.gate_w + (size_t)L * DM * DM, DM, DM, P.WGATE + (size_t)L * DM * DM, DM, 0, nullptr, l);
    for (int d = 0; d < 2; ++d)
      transpose_convert(P.w_up + (size_t)(L * 2 + d) * 64 * 512, 64, 512, P.WUPT + (size_t)(L * 2 + d) * 512 * 64, 512, 0, nullptr, l);
    transpose_convert(P.a_up + (size_t)L * 64 * 512, 64, 512, P.AUPT + (size_t)L * 512 * 64, 512, 0, nullptr, l);
  }
  if (blockIdx.x == 0 && threadIdx.x < 128) {
    const int L = threadIdx.x >> 6, lane = threadIdx.x & 63;
    const float* lv = P.lam_vec + L * 256;
    float s01 = lv[lane] * lv[64 + lane], s23 = lv[128 + lane] * lv[192 + lane];
    float mq = fmaxf(fabsf(P.q_norm[L * 128 + lane]), fabsf(P.q_norm[L * 128 + 64 + lane]));
    float mk = fmaxf(fabsf(P.k_norm[L * 128 + lane]), fabsf(P.k_norm[L * 128 + 64 + lane]));
    for (int o = 32; o >= 1; o >>= 1) {
      s01 += __shfl_xor(s01, o); s23 += __shfl_xor(s23, o);
      mq = fmaxf(mq, __shfl_xor(mq, o)); mk = fmaxf(mk, __shfl_xor(mk, o));
    }
    if (lane == 0) {
      const float lam_init = 0.8f - 0.6f * expf(-0.3f * (float)L);
      P.consts[L * 4 + 0] = expf(s01) - expf(s23) + lam_init;
      P.consts[L * 4 + 1] = 8.25f * mq * mk * LOG2E;
      P.consts[L * 4 + 2] = lam_init;
    }
  }
}

DI void phase_prep(const Params& P, int L) {
  const float* h0 = L == 0 ? P.x_prompt : P.out;
  const float* h1 = L == 0 ? P.x_sample : P.out + (size_t)NP * DM;
  const float* p0 = P.p_prompt + (size_t)L * NP * DPLE;
  const float* p1 = P.p_sample + (size_t)L * NS * DPLE;
  const int tidp = opq(threadIdx.x);
  const int lane = tidp & 63;
  const int gw = blockIdx.x * (NTHREADS / 64) + (tidp >> 6), nw = gridDim.x * (NTHREADS / 64);
  for (int tok = gw; tok < NTOK; tok += nw) {
    const float* hr = tok < NP ? h0 + (size_t)tok * DM : h1 + (size_t)(tok - NP) * DM;
    float ss = 0.f;
#pragma unroll
    for (int i = 0; i < 4; ++i) {
      f32x4 v = *(const f32x4*)(hr + i * 256 + lane * 4);
      ss += v[0] * v[0] + v[1] * v[1] + v[2] * v[2] + v[3] * v[3];
      u32x2 o = {pack2(v[0], v[1]), pack2(v[2], v[3])};
      *(u32x2*)(P.X + (size_t)tok * DM + i * 256 + lane * 4) = o;
    }
    for (int o = 32; o >= 1; o >>= 1) ss += __shfl_xor(ss, o);
    if (lane == 0) P.RS[tok] = rsqrtf(ss * (1.f / DM) + 1e-6f);
    const float* pr = tok < NP ? p0 + (size_t)tok * DPLE : p1 + (size_t)(tok - NP) * DPLE;
    f32x4 v = *(const f32x4*)(pr + lane * 4);
    u32x2 o = {pack2(v[0], v[1]), pack2(v[2], v[3])};
    *(u32x2*)(P.PB + (size_t)tok * DPLE + lane * 4) = o;
  }
}

constexpr int GSTR = 144;
constexpr int GA_BYTES = 256 * GSTR;
constexpr int GSTAGE = 2 * GA_BYTES;

DI void gemm_mainloop(const bf16_t* __restrict__ A, int lda, const bf16_t* __restrict__ Bw, int ldb, int K,
                      int m0, int n0, char* lds, f32x16 (&acc)[2][4]) {
  const int tid = opq(threadIdx.x), lane = tid & 63, w = tid >> 6, hh = lane >> 5, r = lane & 31;
  const int wm = w >> 1, wn = w & 1;
#pragma unroll
  for (int mi = 0; mi < 2; ++mi)
#pragma unroll
    for (int ni = 0; ni < 4; ++ni)
#pragma unroll
      for (int i = 0; i < 16; ++i) acc[mi][ni][i] = 0.f;
  const int lrow = tid >> 3, lkc = tid & 7;
  const bf16_t* ap = A + (size_t)(m0 + lrow) * lda + lkc * 8;
  const bf16_t* bp = Bw + (size_t)(n0 + lrow) * ldb + lkc * 8;
  const int nk = K >> 6;
  u32x4 ra[4], rb[4];
#pragma unroll
  for (int i = 0; i < 4; ++i) {
    ra[i] = *(const u32x4*)(ap + (size_t)(64 * i) * lda);
    rb[i] = *(const u32x4*)(bp + (size_t)(64 * i) * ldb);
  }
  __syncthreads();
#pragma unroll
  for (int i = 0; i < 4; ++i) {
    *(u32x4*)(lds + (lrow + 64 * i) * GSTR + lkc * 16) = ra[i];
    *(u32x4*)(lds + GA_BYTES + (lrow + 64 * i) * GSTR + lkc * 16) = rb[i];
  }
  __syncthreads();
  for (int kt = 0; kt < nk; ++kt) {
    const bool more = kt + 1 < nk;
    if (more) {
#pragma unroll
      for (int i = 0; i < 4; ++i) {
        ra[i] = *(const u32x4*)(ap + (size_t)(64 * i) * lda + (kt + 1) * 64);
        rb[i] = *(const u32x4*)(bp + (size_t)(64 * i) * ldb + (kt + 1) * 64);
      }
    }
    __builtin_amdgcn_sched_barrier(0);
    const char* sa = lds + (kt & 1) * GSTAGE + (wm * 64 + r) * GSTR + hh * 16;
    const char* sb = lds + (kt & 1) * GSTAGE + GA_BYTES + (wn * 128 + r) * GSTR + hh * 16;
    bf16x8 fa[2][2], fb[2][4];
#pragma unroll
    for (int mi = 0; mi < 2; ++mi) fa[0][mi] = *(const bf16x8*)(sa + mi * 32 * GSTR);
#pragma unroll
    for (int ni = 0; ni < 4; ++ni) fb[0][ni] = *(const bf16x8*)(sb + ni * 32 * GSTR);
#pragma unroll
    for (int ks = 0; ks < 4; ++ks) {
      if (ks < 3) {
#pragma unroll
        for (int mi = 0; mi < 2; ++mi) fa[(ks + 1) & 1][mi] = *(const bf16x8*)(sa + mi * 32 * GSTR + (ks + 1) * 32);
#pragma unroll
        for (int ni = 0; ni < 4; ++ni) fb[(ks + 1) & 1][ni] = *(const bf16x8*)(sb + ni * 32 * GSTR + (ks + 1) * 32);
      }
      __builtin_amdgcn_sched_barrier(0);
#pragma unroll
      for (int mi = 0; mi < 2; ++mi)
#pragma unroll
        for (int ni = 0; ni < 4; ++ni) acc[mi][ni] = MFMA(fb[ks & 1][ni], fa[ks & 1][mi], acc[mi][ni]);
      __builtin_amdgcn_sched_barrier(0);
    }
    if (more) {
      char* d = lds + ((kt + 1) & 1) * GSTAGE;
#pragma unroll
      for (int i = 0; i < 4; ++i) {
        *(u32x4*)(d + (lrow + 64 * i) * GSTR + lkc * 16) = ra[i];
        *(u32x4*)(d + GA_BYTES + (lrow + 64 * i) * GSTR + lkc * 16) = rb[i];
      }
    }
    __syncthreads();
  }
}

DI bool xcd_tile(int rd, int nM, int nN, int& mt, int& nt) {
  const int xcd = blockIdx.x & 7, j = blockIdx.x >> 3;
  const int u = (rd * 8 + xcd) * 32 + j;
  if (u >= nM * nN) return false;
  const int band = u / (8 * nN), rem = u % (8 * nN);
  nt = rem >> 3; mt = band * 8 + (rem & 7);
  return true;
}

namespace pg8 {
#define PG8_LAS __attribute__((address_space(3)))
constexpr int BM = 256, BK = 64, HALF = 128, HTB = HALF * BK * 2  , STAGE_BYTES = 8 * HTB, NXCD = 8, WGM = 8;
__host__ __device__ __forceinline__ int lds_byte(int r, int c) { const int st = (r >> 4) * 2 + (c >> 5), rr = r & 15, cc = c & 31, ob = rr * 64 + cc * 2; return st * 1024 + (ob ^ (((ob >> 9) & 1) << 5)); }
__host__ __device__ __forceinline__ void stage_rc(int b, int& R, int& C) { const int st = b / 1024, sb = b % 1024, swz = sb ^ (((sb >> 9) & 1) << 5); R = (st >> 1) * 16 + swz / 64; C = (st & 1) * 32 + (swz % 64) / 2; }
__host__ __device__ __forceinline__ int perm32(int rho) { const int n = rho >> 4, i = rho & 15; return 8 * (i >> 2) + 4 * n + (i & 3); }

struct Unit { int pm, pn; };
struct Gemm { const bf16_t* A; const bf16_t* Bt; int M, N, K; };
template <class Epi, class Sched, bool ALIGN_EPI = false, bool SP2 = false>
__device__ __forceinline__ void gemm_phase(PG8_LAS unsigned char* lds, const Gemm g, const Sched& S, const Epi& E) {
    const int tid = opq(threadIdx.x), wid = __builtin_amdgcn_readfirstlane(tid >> 6), lane = tid & 63, wr = wid >> 2, wc = wid & 3, fr = lane & 15, fq = lane >> 4;
    const int K = g.K, nt = K / BK;
    unsigned voffA[2], voffB[2];
#pragma unroll
    for (int i = 0; i < 2; ++i) { int R, C; stage_rc(tid * 16 + i * 8192, R, C); const int Rb = Epi::PERM ? ((R & ~31) + perm32(R & 31)) : R;
        voffA[i] = (unsigned)(R * K + C) * 2u; voffB[i] = (unsigned)(Rb * K + C) * 2u; }
    const size_t kstep = (size_t)(BK * 2);
    const size_t hstep = (size_t)HALF * K * 2;
    const size_t tstep = 2 * hstep;
    const unsigned ldsw = (unsigned)wid * 1024u;
    const int aoff = lds_byte(wr * 64 + fr, fq * 8), boff = lds_byte(wc * 32 + fr, fq * 8);
#define PG8_SA(b, h) (((b) * 2 + (h)) * HTB)
#define PG8_SB(b, h) ((4 + (b) * 2 + (h)) * HTB)
#define PG8_STAGE(bufoff, gbase, voff) do { _Pragma("unroll") for (int _i = 0; _i < 2; ++_i) \
        __builtin_amdgcn_global_load_lds((const unsigned*)((const char*)(gbase) + (voff)[_i]), (PG8_LAS unsigned*)(lds + (bufoff) + ldsw + _i * 8192), 16, 0, 0); } while (0)
#define PG8_LDA(dst, b, h) do { _Pragma("unroll") for (int m = 0; m < 4; ++m) _Pragma("unroll") for (int k = 0; k < 2; ++k) dst[m][k] = *(const PG8_LAS bf16x8*)(lds + PG8_SA(b, h) + aoff + m * 2048 + k * 1024); } while (0)
#define PG8_LDB(dst, b, h) do { _Pragma("unroll") for (int n = 0; n < 2; ++n) _Pragma("unroll") for (int k = 0; k < 2; ++k) dst[n][k] = *(const PG8_LAS bf16x8*)(lds + PG8_SB(b, h) + boff + n * 2048 + k * 1024); } while (0)
#define PG8_MMA(ai, bj, At, Bt) do { __builtin_amdgcn_s_setprio(1); _Pragma("unroll") for (int m = 0; m < 4; ++m) _Pragma("unroll") for (int n = 0; n < 2; ++n) _Pragma("unroll") for (int k = 0; k < 2; ++k) \
        acc[ai][bj][m][n] = __builtin_amdgcn_mfma_f32_16x16x32_bf16(Bt[n][k], At[m][k], acc[ai][bj][m][n], 0, 0, 0); __builtin_amdgcn_s_setprio(0); } while (0)
#define PG8_WAIT_V(n) asm volatile("s_waitcnt vmcnt(" #n ")" ::: "memory")
#define PG8_WAIT_L(n) asm volatile("s_waitcnt lgkmcnt(" #n ")" ::: "memory")
#define PG8_BAR __builtin_amdgcn_s_barrier()
#define PG8_SCHED __builtin_amdgcn_sched_barrier(0)
    Unit cur, nxt; int ui = 0;
    if (!S.next(0, cur)) return;
    f32x4 acc[2][2][4][2];
#pragma unroll
    for (int a = 0; a < 2; ++a)
#pragma unroll
        for (int b = 0; b < 2; ++b)
#pragma unroll
            for (int m = 0; m < 4; ++m)
#pragma unroll
                for (int n = 0; n < 2; ++n) acc[a][b][m][n] = (f32x4){0.f, 0.f, 0.f, 0.f};
    bf16x8 At[4][2], B0[2][2], B1[2][2];
    const char* cA = (const char*)g.A + (size_t)cur.pm * tstep; const char* cB = (const char*)g.Bt + (size_t)cur.pn * tstep;
    S.a_ready(cur);
    if constexpr (SP2) {
        PG8_STAGE(PG8_SB(0, 0), cB, voffB); PG8_STAGE(PG8_SB(0, 1), cB + hstep, voffB); PG8_STAGE(PG8_SA(0, 0), cA, voffA); PG8_STAGE(PG8_SA(0, 1), cA + hstep, voffA);
        if (wr == 1) PG8_BAR;
        PG8_WAIT_V(2); PG8_BAR;
        PG8_STAGE(PG8_SB(1, 0), cB + kstep, voffB); PG8_STAGE(PG8_SA(1, 0), cA + kstep, voffA); PG8_STAGE(PG8_SB(1, 1), cB + hstep + kstep, voffB);
        PG8_WAIT_V(6); PG8_BAR;
    } else {
        PG8_STAGE(PG8_SB(0, 0), cB, voffB); PG8_STAGE(PG8_SA(0, 0), cA, voffA); PG8_STAGE(PG8_SB(0, 1), cB + hstep, voffB); PG8_STAGE(PG8_SA(0, 1), cA + hstep, voffA);
        if (wr == 1) PG8_BAR;
        PG8_WAIT_V(4); PG8_BAR;
        PG8_STAGE(PG8_SB(1, 0), cB + kstep, voffB); PG8_STAGE(PG8_SA(1, 0), cA + kstep, voffA); PG8_STAGE(PG8_SB(1, 1), cB + hstep + kstep, voffB);
        PG8_WAIT_V(6); PG8_BAR;
    }
    for (;;) {
        const bool has_next = S.next(ui + 1, nxt);
        const char* nA = has_next ? (const char*)g.A + (size_t)nxt.pm * tstep : cA; const char* nB = has_next ? (const char*)g.Bt + (size_t)nxt.pn * tstep : cB;
        for (int t = 0; t < nt; t += 2) {
            const bool last = (t == nt - 2);
            const char* a1 = cA + (size_t)(t + 1) * kstep;
            const char* a2 = last ? nA : cA + (size_t)(t + 2) * kstep; const char* b2 = last ? nB : cB + (size_t)(t + 2) * kstep;
            const char* a3 = a2 + kstep; const char* b3 = b2 + kstep;
            if (last && has_next) S.a_ready(nxt);
            if constexpr (SP2) {
            PG8_LDB(B0, 0, 0); PG8_LDB(B1, 0, 1); PG8_SCHED; PG8_LDA(At, 0, 0); PG8_STAGE(PG8_SA(1, 1), a1 + hstep, voffA);
            PG8_WAIT_V(8); PG8_WAIT_L(0); PG8_BAR; PG8_MMA(0, 0, At, B0); PG8_MMA(0, 1, At, B1); PG8_BAR; PG8_SCHED;
            PG8_LDA(At, 0, 1); PG8_STAGE(PG8_SB(0, 0), b2, voffB); PG8_STAGE(PG8_SB(0, 1), b2 + hstep, voffB); PG8_STAGE(PG8_SA(0, 0), a2, voffA);
            PG8_WAIT_V(8); PG8_WAIT_L(0); PG8_BAR; PG8_MMA(1, 0, At, B0); PG8_MMA(1, 1, At, B1); PG8_BAR; PG8_SCHED;
            PG8_LDB(B0, 1, 0); PG8_LDB(B1, 1, 1); PG8_SCHED; PG8_LDA(At, 1, 0); PG8_STAGE(PG8_SA(0, 1), a2 + hstep, voffA);
            PG8_WAIT_V(8); PG8_WAIT_L(0); PG8_BAR; PG8_MMA(0, 0, At, B0); PG8_MMA(0, 1, At, B1); PG8_BAR; PG8_SCHED;
            PG8_LDA(At, 1, 1); PG8_STAGE(PG8_SB(1, 0), b3, voffB); PG8_STAGE(PG8_SB(1, 1), b3 + hstep, voffB); PG8_STAGE(PG8_SA(1, 0), a3, voffA);
            PG8_WAIT_V(8); PG8_WAIT_L(0); PG8_BAR; PG8_MMA(1, 0, At, B0); PG8_MMA(1, 1, At, B1); PG8_BAR; PG8_SCHED;
            } else {
            PG8_LDB(B0, 0, 0); PG8_SCHED; PG8_LDA(At, 0, 0); PG8_STAGE(PG8_SA(1, 1), a1 + hstep, voffA);
            PG8_WAIT_L(8); PG8_BAR; PG8_WAIT_L(0); PG8_MMA(0, 0, At, B0); PG8_BAR; PG8_SCHED;
            PG8_LDB(B1, 0, 1); PG8_STAGE(PG8_SB(0, 0), b2, voffB);
            PG8_BAR; PG8_WAIT_L(0); PG8_MMA(0, 1, At, B1); PG8_BAR;
            PG8_LDA(At, 0, 1); PG8_STAGE(PG8_SA(0, 0), a2, voffA);
            PG8_BAR; PG8_WAIT_L(0); PG8_MMA(1, 0, At, B0); PG8_BAR; PG8_SCHED;
            PG8_STAGE(PG8_SB(0, 1), b2 + hstep, voffB);
            PG8_WAIT_V(6); PG8_BAR; PG8_MMA(1, 1, At, B1); PG8_BAR;
            PG8_LDB(B0, 1, 0); PG8_SCHED; PG8_LDA(At, 1, 0); PG8_STAGE(PG8_SA(0, 1), a2 + hstep, voffA);
            PG8_WAIT_L(8); PG8_BAR; PG8_WAIT_L(0); PG8_MMA(0, 0, At, B0); PG8_BAR; PG8_SCHED;
            PG8_LDB(B1, 1, 1); PG8_STAGE(PG8_SB(1, 0), b3, voffB);
            PG8_BAR; PG8_WAIT_L(0); PG8_MMA(0, 1, At, B1); PG8_BAR;
            PG8_LDA(At, 1, 1); PG8_STAGE(PG8_SA(1, 0), a3, voffA);
            PG8_BAR; PG8_WAIT_L(0); PG8_MMA(1, 0, At, B0); PG8_BAR; PG8_SCHED;
            PG8_STAGE(PG8_SB(1, 1), b3 + hstep, voffB);
            PG8_WAIT_V(6); PG8_BAR; PG8_MMA(1, 1, At, B1); PG8_BAR;
            }
        }
        if constexpr (ALIGN_EPI) { if (wr == 0) PG8_BAR; }
        if constexpr (!Epi::AFTER_DRAIN) { E(acc, cur, wr, wc, fr, fq); S.done(cur); }
        if (!has_next) break;
#pragma unroll
        for (int a = 0; a < 2; ++a)
#pragma unroll
            for (int b = 0; b < 2; ++b)
#pragma unroll
                for (int m = 0; m < 4; ++m)
#pragma unroll
                    for (int n = 0; n < 2; ++n) acc[a][b][m][n] = (f32x4){0.f, 0.f, 0.f, 0.f};
        cur = nxt; cA = nA; cB = nB; ++ui;
        if constexpr (ALIGN_EPI) { if (wr == 1) PG8_BAR; }
    }
    PG8_WAIT_V(0);
    if constexpr (!ALIGN_EPI) { if (wr == 0) PG8_BAR; }
    PG8_BAR;
    if constexpr (Epi::AFTER_DRAIN) { E.fused(acc, cur, wr, wc, fr, fq, lds, wid, lane); S.done(cur); }
#undef PG8_SA
#undef PG8_SB
#undef PG8_STAGE
#undef PG8_LDA
#undef PG8_LDB
#undef PG8_MMA
#undef PG8_WAIT_V
#undef PG8_WAIT_L
#undef PG8_BAR
#undef PG8_SCHED
}
}

struct TileSched {
  int nM, nN, skip_lo, skip_hi;
  DI bool next(int i, pg8::Unit& u) const {
    const int nNe = nN - (skip_hi - skip_lo);
    const int xcd = blockIdx.x & 7, j = blockIdx.x >> 3;
    const int t = (i * 8 + xcd) * 32 + j;
    if (t >= nM * nNe) return false;
    const int band = t / (8 * nNe), rem = t % (8 * nNe);
    int pn = rem >> 3; const int pm = band * 8 + (rem & 7);
    if (pn >= skip_lo) pn += skip_hi - skip_lo;
    u.pm = pm; u.pn = pn; return true;
  }
  DI void a_ready(const pg8::Unit&) const {}
  DI void done(const pg8::Unit&) const {}
};

DI u32x4 pack8(f32x4 a, f32x4 b) { u32x4 w = {pack2(a[0], a[1]), pack2(a[2], a[3]), pack2(b[0], b[1]), pack2(b[2], b[3])}; return w; }

struct InProjEpi {
  static constexpr bool PERM = true, AFTER_DRAIN = false;
  const float* RS; bf16_t* CR; bf16_t* GRW; bf16_t* GDA; bf16_t* VT; int tok0, S;
  DI void operator()(const f32x4 (&acc)[2][2][4][2], const pg8::Unit& u, int wr, int wc, int fr, int fq) const {
    const int row0 = u.pm * 256 + wr * 64 + fr, col0 = u.pn * 256 + wc * 32 + 8 * fq;
#pragma unroll
    for (int ai = 0; ai < 2; ++ai)
#pragma unroll
      for (int m = 0; m < 4; ++m) {
        const int row = row0 + ai * 128 + m * 16;
        const float rsv = RS[tok0 + row];
#pragma unroll
        for (int bj = 0; bj < 2; ++bj) {
          const int col = col0 + bj * 128;
          const f32x4 v0 = acc[ai][bj][m][0] * rsv, v1 = acc[ai][bj][m][1] * rsv;
          if (u.pn < 7) {
            *(u32x4*)(CR + (size_t)row * CRW + col) = pack8(v0, v1);
          } else if (u.pn < 9 || u.pn >= 15) {
            bf16_t* dst = (u.pn < 9 ? GRW + (col - 1792) : GDA + (col - 3840)) + (size_t)row * 512;
            const f32x4 s0 = {siluf_(v0[0]), siluf_(v0[1]), siluf_(v0[2]), siluf_(v0[3])};
            const f32x4 s1 = {siluf_(v1[0]), siluf_(v1[1]), siluf_(v1[2]), siluf_(v1[3])};
            *(u32x4*)dst = pack8(s0, s1);
          } else {
            const int cv = col - 3328, hd = cv >> 7, dv = cv & 127;
            const int b = row / S, s = row % S;
            bf16_t* dst = VT + ((size_t)((b * 4 + hd) * 128 + dv)) * S + s;
            const size_t Sz = (size_t)S;
            dst[0] = f2bf(v0[0]); dst[Sz] = f2bf(v0[1]); dst[2 * Sz] = f2bf(v0[2]); dst[3 * Sz] = f2bf(v0[3]);
            dst[4 * Sz] = f2bf(v1[0]); dst[5 * Sz] = f2bf(v1[1]); dst[6 * Sz] = f2bf(v1[2]); dst[7 * Sz] = f2bf(v1[3]);
          }
        }
        __builtin_amdgcn_sched_barrier(0);
      }
  }
};

struct OutProjEpi {
  static constexpr bool PERM = true, AFTER_DRAIN = false;
  const float* h0; const float* h1; float* out; bf16_t* R1;
  DI void operator()(const f32x4 (&acc)[2][2][4][2], const pg8::Unit& u, int wr, int wc, int fr, int fq) const {
    const int row0 = u.pm * 256 + wr * 64 + fr, col0 = u.pn * 256 + wc * 32 + 8 * fq;
#pragma unroll
    for (int ai = 0; ai < 2; ++ai)
#pragma unroll
      for (int m = 0; m < 4; ++m) {
        const int row = row0 + ai * 128 + m * 16;
        const float* hr = (row < NP ? h0 + (size_t)row * DM : h1 + (size_t)(row - NP) * DM);
#pragma unroll
        for (int bj = 0; bj < 2; ++bj) {
          const int col = col0 + bj * 128;
          const f32x4 a0 = *(const f32x4*)(hr + col) + acc[ai][bj][m][0];
          const f32x4 a1 = *(const f32x4*)(hr + col + 4) + acc[ai][bj][m][1];
          *(f32x4*)(out + (size_t)row * DM + col) = a0;
          *(f32x4*)(out + (size_t)row * DM + col + 4) = a1;
          *(u32x4*)(R1 + (size_t)row * DM + col) = pack8(a0, a1);
        }
        __builtin_amdgcn_sched_barrier(0);
      }
  }
};

struct EEpi {
  static constexpr bool PERM = true, AFTER_DRAIN = false;
  bf16_t* R2; float* EPART;
  DI void operator()(const f32x4 (&acc)[2][2][4][2], const pg8::Unit& u, int wr, int wc, int fr, int fq) const {
    const int row0 = u.pm * 256 + wr * 64 + fr, col0 = u.pn * 256 + wc * 32 + 8 * fq;
#pragma unroll
    for (int ai = 0; ai < 2; ++ai)
#pragma unroll
      for (int m = 0; m < 4; ++m) {
        const int row = row0 + ai * 128 + m * 16;
        float ss = 0.f;
#pragma unroll
        for (int bj = 0; bj < 2; ++bj) {
          const f32x4 v0 = acc[ai][bj][m][0], v1 = acc[ai][bj][m][1];
          ss += v0[0] * v0[0] + v0[1] * v0[1] + v0[2] * v0[2] + v0[3] * v0[3] + v1[0] * v1[0] + v1[1] * v1[1] + v1[2] * v1[2] + v1[3] * v1[3];
          *(u32x4*)(R2 + (size_t)row * DM + col0 + bj * 128) = pack8(v0, v1);
        }
        ss += __shfl_xor(ss, 16); ss += __shfl_xor(ss, 32);
        if (fq == 0) EPART[(size_t)(u.pn * 4 + wc) * NTOK + row] = ss;
        __builtin_amdgcn_sched_barrier(0);
      }
  }
};

struct GateEpi {
  static constexpr bool PERM = true, AFTER_DRAIN = false;
  float* out; const bf16_t* R2; const float* EPART; const float* gate_b; const float* ple_norm;
  DI void operator()(const f32x4 (&acc)[2][2][4][2], const pg8::Unit& u, int wr, int wc, int fr, int fq) const {
    const int row0 = u.pm * 256 + wr * 64 + fr, col0 = u.pn * 256 + wc * 32 + 8 * fq;
#pragma unroll
    for (int ai = 0; ai < 2; ++ai)
#pragma unroll
      for (int m = 0; m < 4; ++m) {
        const int row = row0 + ai * 128 + m * 16;
        float es = 0.f;
#pragma unroll
        for (int j = 0; j < 8; ++j) es += EPART[(size_t)j * NTOK + row];
        const float rse = rsqrtf(es * (1.f / DM) + 1e-6f);
#pragma unroll
        for (int bj = 0; bj < 2; ++bj) {
          const int col = col0 + bj * 128;
          const u32x4 ev = *(const u32x4*)(R2 + (size_t)row * DM + col);
          float* op = out + (size_t)row * DM + col;
#pragma unroll
          for (int n = 0; n < 2; ++n) {
            const f32x4 gb = *(const f32x4*)(gate_b + col + 4 * n), pn = *(const f32x4*)(ple_norm + col + 4 * n);
            f32x4 hv = *(const f32x4*)(op + 4 * n);
            const f32x4 a = acc[ai][bj][m][n];
            hv[0] += sigmoidf_(a[0] + gb[0]) * (bflo(ev[2 * n]) * rse * pn[0]);
            hv[1] += sigmoidf_(a[1] + gb[1]) * (bfhi(ev[2 * n]) * rse * pn[1]);
            hv[2] += sigmoidf_(a[2] + gb[2]) * (bflo(ev[2 * n + 1]) * rse * pn[2]);
            hv[3] += sigmoidf_(a[3] + gb[3]) * (bfhi(ev[2 * n + 1]) * rse * pn[3]);
            *(f32x4*)(op + 4 * n) = hv;
          }
        }
        __builtin_amdgcn_sched_barrier(0);
      }
  }
};

DI void phase_inproj(const Params& P, int L, const Group& G, char* lds) {
  const int tid = opq(threadIdx.x), lane = tid & 63, w = tid >> 6, hh = lane >> 5, r = lane & 31;
  const int wm = w >> 1, wn = w & 1;
  const int nmt = G.ntok >> 8, ntile = nmt * 17;
  const bf16_t* A = P.X + (size_t)G.tok0 * DM;
  const bf16_t* Bw = P.WIN + (size_t)L * NIN * DM;
  {
    const pg8::Gemm g = {A, Bw, G.ntok, NIN, DM};
    const TileSched sch = {nmt, 17, 9, 13};
    const InProjEpi epi = {P.RS, P.CR, P.GRW, P.GDA, P.VT, G.tok0, G.S};
    pg8::gemm_phase<InProjEpi, TileSched, true, true>((PG8_LAS unsigned char*)lds, g, sch, epi);
  }
  for (int t = blockIdx.x; t < nmt * 4; t += gridDim.x) {
    const int mt = t >> 2, nt = 9 + (t & 3);
    const int m0 = mt << 8, n0 = nt << 8;
    f32x16 acc[2][4];
    gemm_mainloop(A, DM, Bw, DM, DM, m0, n0, lds, acc);
    const int colw = n0 + wn * 128 + 4 * hh;
    if (nt < 7) {
#pragma unroll
      for (int mi = 0; mi < 2; ++mi) {
        const int row = m0 + wm * 64 + mi * 32 + r;
        const float rsv = P.RS[G.tok0 + row];
        bf16_t* dst = P.CR + (size_t)row * CRW + colw;
#pragma unroll
        for (int ni = 0; ni < 4; ++ni)
#pragma unroll
          for (int q4 = 0; q4 < 4; ++q4) {
            u32x2 o = {pack2(acc[mi][ni][4 * q4] * rsv, acc[mi][ni][4 * q4 + 1] * rsv),
                       pack2(acc[mi][ni][4 * q4 + 2] * rsv, acc[mi][ni][4 * q4 + 3] * rsv)};
            *(u32x2*)(dst + ni * 32 + q4 * 8) = o;
          }
      }
    } else if (nt < 9 || nt >= 15) {
      bf16_t* dbase = nt < 9 ? P.GRW : P.GDA;
      const int c0 = colw - (nt < 9 ? 1792 : 3840);
#pragma unroll
      for (int mi = 0; mi < 2; ++mi) {
        const int row = m0 + wm * 64 + mi * 32 + r;
        const float rsv = P.RS[G.tok0 + row];
        bf16_t* dst = dbase + (size_t)row * 512 + c0;
#pragma unroll
        for (int ni = 0; ni < 4; ++ni)
#pragma unroll
          for (int q4 = 0; q4 < 4; ++q4) {
            u32x2 o = {pack2(siluf_(acc[mi][ni][4 * q4] * rsv), siluf_(acc[mi][ni][4 * q4 + 1] * rsv)),
                       pack2(siluf_(acc[mi][ni][4 * q4 + 2] * rsv), siluf_(acc[mi][ni][4 * q4 + 3] * rsv))};
            *(u32x2*)(dst + ni * 32 + q4 * 8) = o;
          }
      }
    } else if (nt < 13) {
      const bool isq = nt < 11;
      bf16_t* dbase = isq ? P.Q : P.KB;
      const int c0 = colw - (isq ? 2304 : 2816);
      const float* g = (isq ? P.q_norm : P.k_norm) + L * 128 + 4 * hh;
      const float osc = isq ? 0.125f * LOG2E : 1.f;
#pragma unroll
      for (int mi = 0; mi < 2; ++mi) {
        const int row = m0 + wm * 64 + mi * 32 + r;
        const float rsv = P.RS[G.tok0 + row];
        bf16_t* dst = dbase + (size_t)row * 512 + c0;
#pragma unroll
        for (int gi = 0; gi < 2; ++gi) {
          float ss = 0.f;
#pragma unroll
          for (int t2 = 0; t2 < 2; ++t2)
#pragma unroll
            for (int i = 0; i < 16; ++i) { const float v = acc[mi][2 * gi + t2][i] * rsv; ss += v * v; }
          ss += __shfl_xor(ss, 32);
          const float sc = rsqrtf(ss * (1.f / 64.f) + 1e-6f) * rsv * osc;
#pragma unroll
          for (int t2 = 0; t2 < 2; ++t2)
#pragma unroll
            for (int q4 = 0; q4 < 4; ++q4) {
              const f32x4 gv = *(const f32x4*)(g + gi * 64 + t2 * 32 + q4 * 8);
              u32x2 o = {pack2(acc[mi][2 * gi + t2][4 * q4] * sc * gv[0], acc[mi][2 * gi + t2][4 * q4 + 1] * sc * gv[1]),
                         pack2(acc[mi][2 * gi + t2][4 * q4 + 2] * sc * gv[2], acc[mi][2 * gi + t2][4 * q4 + 3] * sc * gv[3])};
              *(u32x2*)(dst + (2 * gi + t2) * 32 + q4 * 8) = o;
            }
        }
      }
    } else {
      const int hd = (n0 + wn * 128 - 3328) >> 7;
      const int row0 = m0 + wm * 64;
      const int b = row0 / G.S, s0 = row0 % G.S;
#pragma unroll
      for (int mi = 0; mi < 2; ++mi) {
        const int s = s0 + mi * 32 + r;
        const float rsv = P.RS[G.tok0 + b * G.S + s];
        bf16_t* dst = P.VT + ((size_t)((b * 4 + hd) * 128 + 4 * hh)) * G.S + s;
        const size_t Sz = (size_t)G.S;
#pragma unroll
        for (int ni = 0; ni < 4; ++ni)
#pragma unroll
          for (int q4 = 0; q4 < 4; ++q4) {
            bf16_t* pq = dst + (size_t)(ni * 32 + 8 * q4) * Sz;
            pq[0] = f2bf(acc[mi][ni][4 * q4] * rsv);
            pq[Sz] = f2bf(acc[mi][ni][4 * q4 + 1] * rsv);
            pq[2 * Sz] = f2bf(acc[mi][ni][4 * q4 + 2] * rsv);
            pq[3 * Sz] = f2bf(acc[mi][ni][4 * q4 + 3] * rsv);
            __builtin_amdgcn_sched_barrier(0);
          }
      }
    }
  }
}

DI void phase_outproj(const Params& P, int L, char* lds) {
  const float* h0 = L == 0 ? P.x_prompt : P.out;
  const float* h1 = L == 0 ? P.x_sample : P.out + (size_t)NP * DM;
  {
    const pg8::Gemm g = {P.X, P.WOUT + (size_t)L * DM * DM, NTOK, DM, DM};
    const TileSched sch = {NTOK >> 8, 4, 0, 0};
    const OutProjEpi epi = {h0, h1, P.out, P.R1};
    pg8::gemm_phase<OutProjEpi, TileSched, true, true>((PG8_LAS unsigned char*)lds, g, sch, epi);
  }
  {
    const int tid = opq(threadIdx.x), lane = tid & 63, w = tid >> 6, hh = lane >> 5, r = lane & 31;
    const int wm = w >> 1, wn = w & 1;
    const int ntile = (NTOK >> 8) * 4;
    for (int tt = blockIdx.x; tt < ntile; tt += gridDim.x) {
      const int mt = tt >> 2, nt = tt & 3;
      const int m0 = mt << 8, n0 = nt << 8;
      const int colw = n0 + wn * 128 + 4 * hh;
      f32x16 acc[2][4];
      gemm_mainloop(P.PB, DPLE, P.WPLE + (size_t)L * DM * DPLE, DPLE, DPLE, m0, n0, lds, acc);
#pragma unroll
      for (int mi = 0; mi < 2; ++mi) {
        const int row = m0 + wm * 64 + mi * 32 + r;
        bf16_t* rp = P.R2 + (size_t)row * DM + colw;
        float ss = 0.f;
#pragma unroll
        for (int ni = 0; ni < 4; ++ni)
#pragma unroll
          for (int q4 = 0; q4 < 4; ++q4) {
            const float v0 = acc[mi][ni][4 * q4], v1 = acc[mi][ni][4 * q4 + 1], v2 = acc[mi][ni][4 * q4 + 2], v3 = acc[mi][ni][4 * q4 + 3];
            ss += v0 * v0 + v1 * v1 + v2 * v2 + v3 * v3;
            u32x2 o = {pack2(v0, v1), pack2(v2, v3)};
            *(u32x2*)(rp + ni * 32 + q4 * 8) = o;
          }
        ss += __shfl_xor(ss, 32);
        if (hh == 0) P.EPART[(size_t)(nt * 2 + wn) * NTOK + row] = ss;
      }
    }
  }
}

DI void phase_gate(const Params& P, int L, char* lds) {
  const pg8::Gemm g = {P.R1, P.WGATE + (size_t)L * DM * DM, NTOK, DM, DM};
  const TileSched sch = {NTOK >> 8, 4, 0, 0};
  const GateEpi epi = {P.out, P.R2, P.EPART, P.gate_b + L * DM, P.ple_norm + L * DM};
  pg8::gemm_phase<GateEpi, TileSched, true, true>((PG8_LAS unsigned char*)lds, g, sch, epi);
}

constexpr int TC = 32;
constexpr int CB_OP = TC * 64 * 4;
constexpr int CB_BYTES = 6 * CB_OP + 128 + 1024;
constexpr int PW_BYTES = 10 * 640 + 2 * 8 * 144;
constexpr int PW_BASE = 2 * CB_BYTES;

template <int N> DI void red64v(float (&x)[N]) {
#pragma unroll
  for (int i = 0; i < N; ++i) x[i] += dppf<0xB1>(x[i]);
#pragma unroll
  for (int i = 0; i < N; ++i) x[i] += dppf<0x4E>(x[i]);
#pragma unroll
  for (int i = 0; i < N; ++i) x[i] += dppf<0x141>(x[i]);
#pragma unroll
  for (int i = 0; i < N; ++i) x[i] += dppf<0x140>(x[i]);
#pragma unroll
  for (int i = 0; i < N; ++i) x[i] += __shfl_xor(x[i], 16);
#pragma unroll
  for (int i = 0; i < N; ++i) x[i] += __shfl_xor(x[i], 32);
}

struct ScanOps { f32x4 a0, a1, b0, b1, k0, k1, r0, r1; f32x2 v; };

DI ScanOps scan_load(const float* __restrict__ ob, int s, int coff, int row0) {
  ScanOps o;
  const float* p = ob + s * 64 + coff;
  o.a0 = *(const f32x4*)(p + TC * 64);       o.a1 = *(const f32x4*)(p + TC * 64 + 4);
  o.b0 = *(const f32x4*)(p + 2 * TC * 64);   o.b1 = *(const f32x4*)(p + 2 * TC * 64 + 4);
  o.k0 = *(const f32x4*)(p + 3 * TC * 64);   o.k1 = *(const f32x4*)(p + 3 * TC * 64 + 4);
  o.r0 = *(const f32x4*)(p + 4 * TC * 64);   o.r1 = *(const f32x4*)(p + 4 * TC * 64 + 4);
  o.v = *(const f32x2*)(ob + 5 * TC * 64 + s * 64 + row0);
  return o;
}

DI f32x2 lo2(f32x4 x) { return f32x2{x[0], x[1]}; }
DI f32x2 hi2(f32x4 x) { return f32x2{x[2], x[3]}; }

DI f32x2 scan_step(f32x2 (&st)[2][4], const ScanOps& o) {
  const f32x2 a[4] = {lo2(o.a0), hi2(o.a0), lo2(o.a1), hi2(o.a1)};
  const f32x2 bv[4] = {lo2(o.b0), hi2(o.b0), lo2(o.b1), hi2(o.b1)};
  const f32x2 kv[4] = {lo2(o.k0), hi2(o.k0), lo2(o.k1), hi2(o.k1)};
  const f32x2 rv[4] = {lo2(o.r0), hi2(o.r0), lo2(o.r1), hi2(o.r1)};
  f32x2 y;
#pragma unroll
  for (int rr = 0; rr < 2; ++rr) {
    f32x2 p = st[rr][0] * a[0];
    p = st[rr][1] * a[1] + p; p = st[rr][2] * a[2] + p; p = st[rr][3] * a[3] + p;
    const float sa = red8(p[0] + p[1]);
    const f32x2 sa2 = {sa, sa};
    const f32x2 v2 = {o.v[rr], o.v[rr]};
    f32x2 q = {0.f, 0.f};
#pragma unroll
    for (int j = 0; j < 4; ++j) {
      f32x2 x = sa2 * bv[j] + st[rr][j];
      x = v2 * kv[j] + x;
      st[rr][j] = x;
      q = x * rv[j] + q;
    }
    y[rr] = red8(q[0] + q[1]);
  }
  return y;
}

DI void scan_task(const Params& P, int L_, const Group& G, int task, char* lds) {
  const int L = opqs(__builtin_amdgcn_readfirstlane(L_));
  const int tid = opq(threadIdx.x), lane = tid & 63, w = tid >> 6;
  const int dir = task & 1, b = task >> 4, hd = (task >> 1) & 7;
  const int S = G.S, nc = S / TC;
  const int sg = dir ? -1 : 1;
  const bf16_t* crb = P.CR + (size_t)b * S * CRW;

  const int srow0 = (w & 3) * 16 + (lane >> 3) * 2, scs = lane & 7;
  f32x2 st[2][4];
#pragma unroll
  for (int rr = 0; rr < 2; ++rr)
#pragma unroll
    for (int j = 0; j < 4; ++j) st[rr][j] = f32x2{0.f, 0.f};

  const int pw = w & 3, ec = lane, hh = lane >> 5, r = lane & 31;
  char* pwb = lds + PW_BASE + pw * PW_BYTES;
  const int ch = hd * 64 + ec;
  const float c_kk = P.k_k[L * 512 + ch], c_ka = P.k_a[L * 512 + ch], c_rk = P.r_k[L * 512 + ch];
  const float* cw = P.conv_w + (size_t)L * 3 * 1728;
  const float* cb = P.conv_b + (size_t)L * 1728;
  const bf16_t* wsrcW = P.WUPT + (size_t)(L * 2 + dir) * 512 * 64 + (size_t)(hd * 64 + r) * 64 + hh * 8;
  const bf16_t* wsrcA = P.AUPT + (size_t)L * 512 * 64 + (size_t)(hd * 64 + r) * 64 + hh * 8;
  const float* w0p = P.w0 + (size_t)(L * 2 + dir) * 512 + hd * 64 + r;
  const float* a0p = P.a0 + (size_t)L * 512 + hd * 64 + r;

  auto prepare = [&](int cc, char* cbuf) {
    float* oW = (float*)cbuf; float* oA = (float*)(cbuf + CB_OP); float* oB = (float*)(cbuf + 2 * CB_OP);
    float* oK = (float*)(cbuf + 3 * CB_OP); float* oR = (float*)(cbuf + 4 * CB_OP); float* oV = (float*)(cbuf + 5 * CB_OP);
    float* oBon = (float*)(cbuf + 6 * CB_OP);
    const int ln = opq(lane);
    const int tbase = dir ? S - cc * TC - 8 * pw - 9 : cc * TC + 8 * pw - 1;
    {
      u32x4 rv[7];
#pragma unroll
      for (int it = 0; it < 7; ++it) {
        int id = ln + it * 64;
        id = id < 400 ? id : 399;
        const int rr = id / 40, cc8 = id % 40, q = cc8 >> 3, c8 = (cc8 & 7) * 8;
        const int tok = tbase + rr;
        const bool ok = tok >= 0 && tok < S;
        const int tokc = tok < 0 ? 0 : (tok >= S ? S - 1 : tok);
        const int col = (q == 0 ? hd * 64 : q == 1 ? 512 + hd * 64 : q == 2 ? 1024 + hd * 64 : q == 3 ? 1536 + dir * 64 : 1664) + c8;
        const u32x4 v = *(const u32x4*)(crb + (size_t)tokc * CRW + col);
        const u32x4 z = {0u, 0u, 0u, 0u};
        rv[it] = ok ? v : z;
      }
#pragma unroll
      for (int it = 0; it < 7; ++it) {
        int id = ln + it * 64;
        id = id < 400 ? id : 399;
        *(u32x4*)(pwb + (id / 40) * 640 + (id % 40) * 16) = rv[it];
      }
    }
    asm volatile("" ::: "memory");
    float cwp[5], cwc[5], cwn[5], cbb[5];
#pragma unroll
    for (int q = 0; q < 5; ++q) {
      const int cqq = (q == 0 ? hd * 64 : q == 1 ? 512 + hd * 64 : q == 2 ? 1024 + hd * 64 : q == 3 ? 1536 + dir * 64 : 1664) + ln;
      const float w0 = cw[cqq], w1 = cw[1728 + cqq], w2 = cw[2 * 1728 + cqq];
      cwp[q] = dir ? w2 : w0; cwc[q] = w1; cwn[q] = dir ? w0 : w2; cbb[q] = cb[cqq];
    }
    bf16x8 lf[2][2][4];
#pragma unroll
    for (int nb = 0; nb < 2; ++nb)
#pragma unroll
      for (int ks = 0; ks < 4; ++ks) {
        lf[0][nb][ks] = *(const bf16x8*)(wsrcW + nb * 32 * 64 + ks * 16);
        lf[1][nb][ks] = *(const bf16x8*)(wsrcA + nb * 32 * 64 + ks * 16);
      }
    const bf16_t* raw = (const bf16_t*)pwb;
    bf16_t* zt = (bf16_t*)(pwb + 6400); bf16_t* za = (bf16_t*)(pwb + 6400 + 8 * 144);
    float kreg[8];
#pragma unroll
    for (int hf = 0; hf < 2; ++hf) {
      float xr[6][5];
#pragma unroll
      for (int j = 0; j < 6; ++j) {
        const int vi = hf * 4 + j - 1;
        const int jj = dir ? 8 - vi : vi + 1;
#pragma unroll
        for (int q = 0; q < 5; ++q) xr[j][q] = bf2f(raw[jj * 320 + q * 64 + ln]);
      }
#pragma unroll
      for (int i = 0; i < 4; ++i) {
        float v[5];
#pragma unroll
        for (int q = 0; q < 5; ++q) v[q] = cbb[q] + cwp[q] * xr[i][q] + cwc[q] * xr[i + 1][q] + cwn[q] * xr[i + 2][q];
        const int ti = hf * 4 + i, s = 8 * pw + ti;
        oR[s * 64 + ln] = v[0];
        kreg[ti] = v[1];
        oV[s * 64 + ln] = v[2];
        zt[ti * 72 + ln] = f2bf(tanhf_(v[3]));
        za[ti * 72 + ln] = f2bf(v[4]);
      }
    }
    asm volatile("" ::: "memory");
    {
      const char* az = (const char*)zt + (r & 7) * 144 + hh * 16;
      const char* aa = (const char*)za + (r & 7) * 144 + hh * 16;
#pragma unroll
      for (int nb = 0; nb < 2; ++nb) {
        f32x16 accw, acca;
#pragma unroll
        for (int i = 0; i < 16; ++i) { accw[i] = 0.f; acca[i] = 0.f; }
#pragma unroll
        for (int ks = 0; ks < 4; ++ks) {
          const bf16x8 fz = *(const bf16x8*)(az + ks * 32);
          const bf16x8 fa = *(const bf16x8*)(aa + ks * 32);
          accw = MFMA(fz, lf[0][nb][ks], accw);
          acca = MFMA(fa, lf[1][nb][ks], acca);
        }
        const float w0v = w0p[nb * 32], a0v = a0p[nb * 32];
#pragma unroll
        for (int i = 0; i < 4; ++i) {
          const int s = 8 * pw + 4 * hh + i;
          oW[s * 64 + nb * 32 + r] = __expf(-0.6065306597126334f * sigmoidf_(w0v + accw[i]));
          oA[s * 64 + nb * 32 + r] = sigmoidf_(a0v + acca[i]);
        }
      }
    }
    asm volatile("" ::: "memory");
    {
      float ag[8], kk[8], ss[8], km[8], bn[8];
#pragma unroll
      for (int i = 0; i < 8; ++i) {
        const int s = 8 * pw + i;
        ag[i] = oA[s * 64 + ln];
        kk[i] = kreg[i] * c_kk;
        ss[i] = kk[i] * kk[i];
        km[i] = kreg[i] * (1.f + (ag[i] - 1.f) * c_ka);
        bn[i] = oR[s * 64 + ln] * km[i] * c_rk;
      }
      red64v<8>(ss);
      red64v<8>(bn);
      float g = 1.f;
#pragma unroll
      for (int i = 0; i < 8; ++i) {
        const int s = 8 * pw + i;
        const float kn = kk[i] * rsqrtf(ss[i] + 1e-12f);
        const float gprev = g;
        g *= oW[s * 64 + ln];
        const float ginv = __builtin_amdgcn_rcpf(g);
        oK[s * 64 + ln] = km[i] * ginv;
        oA[s * 64 + ln] = -kn * gprev;
        oB[s * 64 + ln] = kn * ag[i] * ginv;
        oR[s * 64 + ln] = oR[s * 64 + ln] * g;
        if (ln == 0) oBon[s] = bn[i];
      }
      ((float*)(cbuf + 6 * CB_OP + 128))[pw * 64 + ln] = g;
    }
  };

  __syncthreads();
  if (w >= 4) prepare(0, lds);
  __syncthreads();
  if (__builtin_amdgcn_readfirstlane(w) < 4) __builtin_amdgcn_s_setprio(2);

  for (int c = 0; c < nc; ++c) {
    char* cbuf = lds + (c & 1) * CB_BYTES;
    if (w < 4) {
      const float* sb = (const float*)cbuf;
      const float* oBon = (const float*)(cbuf + 6 * CB_OP);
      ScanOps cur = scan_load(sb, 0, scs * 8, srow0);
#pragma unroll 1
      for (int s8 = 0; s8 < TC; s8 += 8) {
        f32x2 ykeep = {0.f, 0.f};
#pragma unroll
        for (int u = 0; u < 8; ++u) {
          const int s = s8 + u;
          const ScanOps nxt = scan_load(sb, s + 1 < TC ? s + 1 : s, scs * 8, srow0);
          const f32x2 y = scan_step(st, cur);
          if (u == scs) ykeep = y;
          cur = nxt;
        }
        {
          const float* g8 = (const float*)(cbuf + 6 * CB_OP + 128) + (s8 >> 3) * 64 + scs * 8;
          const f32x4 ga = *(const f32x4*)g8, gb = *(const f32x4*)(g8 + 4);
          const f32x2 gg[4] = {lo2(ga), hi2(ga), lo2(gb), hi2(gb)};
#pragma unroll
          for (int rr = 0; rr < 2; ++rr)
#pragma unroll
            for (int j = 0; j < 4; ++j) st[rr][j] = st[rr][j] * gg[j];
        }
        const int s = s8 + scs;
        const int ts = dir ? S - 1 - (c * TC + s) : c * TC + s;
        const size_t lt = (size_t)b * S + ts;
        const unsigned yv = pack2(ykeep[0], ykeep[1]);
        if (dir == 0) {
          *(unsigned*)(P.X + ((size_t)G.tok0 + lt) * DM + hd * 64 + srow0) = yv;
          const float bon = oBon[s];
          const f32x2 vv = *(const f32x2*)(sb + 5 * TC * 64 + s * 64 + srow0);
          *(unsigned*)(P.BV + lt * 512 + hd * 64 + srow0) = pack2(bon * vv[0], bon * vv[1]);
        } else {
          *(unsigned*)(P.YB + lt * 512 + hd * 64 + srow0) = yv;
        }
      }
    } else if (c + 1 < nc) {
      prepare(c + 1, lds + ((c + 1) & 1) * CB_BYTES);
    }
    __syncthreads();
  }
  __builtin_amdgcn_s_setprio(0);
}

DI void phase_rwkv_final(const Params& P, int L, const Group& G) {
  const int tidp = opq(threadIdx.x);
  const int lane = tidp & 63;
  const int gw = blockIdx.x * (NTHREADS / 64) + (tidp >> 6), nw = gridDim.x * (NTHREADS / 64);
  const f32x4 g0 = *(const f32x4*)(P.ln_g + L * 512 + lane * 8), g1 = *(const f32x4*)(P.ln_g + L * 512 + lane * 8 + 4);
  const f32x4 b0 = *(const f32x4*)(P.ln_b + L * 512 + lane * 8), b1 = *(const f32x4*)(P.ln_b + L * 512 + lane * 8 + 4);
  const float lg[8] = {g0[0], g0[1], g0[2], g0[3], g1[0], g1[1], g1[2], g1[3]};
  const float lb[8] = {b0[0], b0[1], b0[2], b0[3], b1[0], b1[1], b1[2], b1[3]};
  for (int lt = gw; lt < G.ntok; lt += nw) {
    bf16_t* xp = P.X + ((size_t)G.tok0 + lt) * DM + lane * 8;
    const u32x4 yf = *(const u32x4*)xp;
    const u32x4 yb = *(const u32x4*)(P.YB + (size_t)lt * 512 + lane * 8);
    const u32x4 bv = *(const u32x4*)(P.BV + (size_t)lt * 512 + lane * 8);
    const u32x4 gt = *(const u32x4*)(P.GRW + (size_t)lt * 512 + lane * 8);
    float y[8];
    float sum = 0.f;
#pragma unroll
    for (int j = 0; j < 4; ++j) {
      y[2 * j] = bflo(yf[j]) + bflo(yb[j]); y[2 * j + 1] = bfhi(yf[j]) + bfhi(yb[j]);
      sum += y[2 * j] + y[2 * j + 1];
    }
    const float mu = red8(sum) * (1.f / 64.f);
    float vs = 0.f;
#pragma unroll
    for (int j = 0; j < 8; ++j) { y[j] -= mu; vs += y[j] * y[j]; }
    const float rstd = rsqrtf(red8(vs) * (1.f / 64.f) + 64e-5f);
    u32x4 o;
#pragma unroll
    for (int j = 0; j < 4; ++j) {
      const float o0 = (y[2 * j] * rstd * lg[2 * j] + lb[2 * j] + bflo(bv[j])) * bflo(gt[j]);
      const float o1 = (y[2 * j + 1] * rstd * lg[2 * j + 1] + lb[2 * j + 1] + bfhi(bv[j])) * bfhi(gt[j]);
      o[j] = pack2(o0, o1);
    }
    *(u32x4*)xp = o;
  }
}

constexpr int AT_K = 64 * GSTR;
constexpr int AT_STAGE = 2 * AT_K + 128 * GSTR;

DI void attn_item(const Params& P, int L_, const Group& G, int item, char* lds) {
  const int L = opqs(__builtin_amdgcn_readfirstlane(L_));
  const int tid = opq(threadIdx.x), lane = tid & 63, w = tid >> 6, hh = lane >> 5, r = lane & 31;
  const int S = G.S, nqb = S >> 7;
  const int qblk = item % nqb, bh = item / nqb, hd = bh & 3, b = bh >> 2;
  const int map = w & 1, qb = w >> 1;
  const int q0 = qblk * 128 + qb * 32;
  const size_t ltq = (size_t)b * S + q0 + r;
  bf16x8 qf[4];
  {
    const bf16_t* qp = P.Q + ltq * 512 + hd * 128 + map * 64 + hh * 8;
#pragma unroll
    for (int ks = 0; ks < 4; ++ks) qf[ks] = *(const bf16x8*)(qp + ks * 16);
  }
  f32x16 o[4];
#pragma unroll
  for (int d = 0; d < 4; ++d)
#pragma unroll
    for (int i = 0; i < 16; ++i) o[d][i] = 0.f;
  f32x16 accl;
#pragma unroll
  for (int i = 0; i < 16; ++i) accl[i] = 0.f;
  const float slope2 = exp2f(-2.f * (float)(hd + 1)) * LOG2E;
  float so[16];
#pragma unroll
  for (int i = 0; i < 16; ++i) so[i] = slope2 * (float)(16 * (i >> 3) + (i & 7));
  bf16x8 ones;
#pragma unroll
  for (int j = 0; j < 8; ++j) ones[j] = (short)0x3F80;
  const float lam = P.consts[L * 4 + 0], C2 = P.consts[L * 4 + 1], lam_init = P.consts[L * 4 + 2];
  const float qposf = (float)(q0 + r);
  const int Dz = (int)ceilf(150.f / slope2);
  const int Q0 = qblk * 128;
  const int tlo = (Q0 - 63 - Dz) < 0 ? 0 : (Q0 - 63 - Dz) / 64 + 1;
  const int thx = min(S >> 6, (Q0 + 127 + Dz + 63) / 64);
  const int nt = thx - tlo;
  const int lrow = tid >> 3, lck = tid & 7;
  const bf16_t* k0p = P.KB + ((size_t)b * S + tlo * 64 + lrow) * 512 + hd * 128 + lck * 8;
  const bf16_t* v0p = P.VT + ((size_t)((b * 4 + hd) * 128 + lrow)) * S + tlo * 64 + lck * 8;
  u32x4 ra0, ra1, ra2, ra3, rb0, rb1, rb2, rb3;
  auto ldtile = [&](int tt, u32x4& x0, u32x4& x1, u32x4& x2, u32x4& x3) {
    const int tc = tt < nt ? tt : nt - 1;
    x0 = *(const u32x4*)(k0p + (size_t)tc * 64 * 512); x1 = *(const u32x4*)(k0p + (size_t)tc * 64 * 512 + 64);
    x2 = *(const u32x4*)(v0p + tc * 64); x3 = *(const u32x4*)(v0p + (size_t)64 * S + tc * 64);
  };
  auto sttile = [&](int slot, const u32x4& x0, const u32x4& x1, const u32x4& x2, const u32x4& x3) {
    char* d = lds + slot * AT_STAGE;
    *(u32x4*)(d + lrow * GSTR + lck * 16) = x0;
    *(u32x4*)(d + AT_K + lrow * GSTR + lck * 16) = x1;
    *(u32x4*)(d + 2 * AT_K + lrow * GSTR + lck * 16) = x2;
    *(u32x4*)(d + 2 * AT_K + (lrow + 64) * GSTR + lck * 16) = x3;
  };
  ldtile(0, ra0, ra1, ra2, ra3);
  ldtile(1, rb0, rb1, rb2, rb3);
  __syncthreads();
  sttile(0, ra0, ra1, ra2, ra3);
  ldtile(2, ra0, ra1, ra2, ra3);
  __syncthreads();
  const int krow = (r & ~12) | ((r & 4) << 1) | ((r & 8) >> 1);
  auto compute = [&](int t) {
    const char* kbuf = lds + (t & 1) * AT_STAGE + map * AT_K;
    const char* vbuf = lds + (t & 1) * AT_STAGE + 2 * AT_K;
    f32x16 s0, s1;
    const int kt0 = (tlo + t) * 64;
    const float base = (float)(kt0 + 8 * hh) - qposf;
    if (kt0 + 63 < q0) {
      const float bl = fmaf(slope2, base, -C2), bl2 = bl + 32.f * slope2;
#pragma unroll
      for (int i = 0; i < 16; ++i) { s0[i] = bl + so[i]; s1[i] = bl2 + so[i]; }
    } else if (kt0 > q0 + 31) {
      const float br = fmaf(-slope2, base, -C2), br2 = br - 32.f * slope2;
#pragma unroll
      for (int i = 0; i < 16; ++i) { s0[i] = br - so[i]; s1[i] = br2 - so[i]; }
    } else {
#pragma unroll
      for (int i = 0; i < 16; ++i) {
        const float d0 = base + (float)(16 * (i >> 3) + (i & 7));
        s0[i] = fmaf(fabsf(d0), -slope2, -C2);
        s1[i] = fmaf(fabsf(d0 + 32.f), -slope2, -C2);
      }
    }
#pragma unroll
    for (int ks = 0; ks < 4; ++ks) {
      const bf16x8 a0 = *(const bf16x8*)(kbuf + krow * GSTR + ks * 32 + hh * 16);
      const bf16x8 a1 = *(const bf16x8*)(kbuf + (32 + krow) * GSTR + ks * 32 + hh * 16);
      s0 = MFMA(a0, qf[ks], s0);
      s1 = MFMA(a1, qf[ks], s1);
    }
    bf16x8 pf[4];
    {
      u32x4 pk[4];
#pragma unroll
      for (int i = 0; i < 16; i += 2) {
        const float e0 = __builtin_amdgcn_exp2f(s0[i]), e1 = __builtin_amdgcn_exp2f(s0[i + 1]);
        const float e2 = __builtin_amdgcn_exp2f(s1[i]), e3 = __builtin_amdgcn_exp2f(s1[i + 1]);
        pk[i >> 3][(i & 7) >> 1] = pack2(e0, e1);
        pk[2 + (i >> 3)][(i & 7) >> 1] = pack2(e2, e3);
      }
#pragma unroll
      for (int j = 0; j < 4; ++j) pf[j] = __builtin_bit_cast(bf16x8, pk[j]);
    }
#pragma unroll
    for (int j = 0; j < 4; ++j) accl = MFMA(ones, pf[j], accl);
#pragma unroll
    for (int dvb = 0; dvb < 4; ++dvb)
#pragma unroll
      for (int j = 0; j < 4; ++j) {
        const bf16x8 va = *(const bf16x8*)(vbuf + (dvb * 32 + r) * GSTR + (16 * j + 8 * hh) * 2);
        o[dvb] = MFMA(va, pf[j], o[dvb]);
      }
  };
  for (int t = 0; t < nt; t += 2) {
    compute(t);
    sttile(1, rb0, rb1, rb2, rb3);
    __builtin_amdgcn_sched_barrier(0);
    ldtile(t + 3, rb0, rb1, rb2, rb3);
    __builtin_amdgcn_sched_barrier(0);
    __syncthreads();
    if (t + 1 >= nt) break;
    compute(t + 1);
    sttile(0, ra0, ra1, ra2, ra3);
    __builtin_amdgcn_sched_barrier(0);
    ldtile(t + 4, ra0, ra1, ra2, ra3);
    __builtin_amdgcn_sched_barrier(0);
    __syncthreads();
  }
  const float linv = 1.f / accl[0];
  float* comb = (float*)lds;
  if (map == 1) {
#pragma unroll
    for (int dvb = 0; dvb < 4; ++dvb)
#pragma unroll
      for (int i = 0; i < 16; ++i) comb[(qb * 64 + dvb * 16 + i) * 64 + lane] = o[dvb][i] * linv;
  }
  __syncthreads();
  if (map == 0) {
    float ss = 0.f;
#pragma unroll
    for (int dvb = 0; dvb < 4; ++dvb)
#pragma unroll
      for (int i = 0; i < 16; ++i) {
        const float v = o[dvb][i] * linv - lam * comb[(qb * 64 + dvb * 16 + i) * 64 + lane];
        o[dvb][i] = v; ss += v * v;
      }
    ss += __shfl_xor(ss, 32);
    const float sc = rsqrtf(ss * (1.f / 128.f) + 1e-6f) * (1.f - lam_init);
    const bf16_t* gp = P.GDA + ltq * 512 + hd * 128;
    bf16_t* yp = P.X + ((size_t)G.tok0 + ltq) * DM + 512 + hd * 128;
    const float* sl = P.subln + L * 128;
#pragma unroll
    for (int dvb = 0; dvb < 4; ++dvb)
#pragma unroll
      for (int q4 = 0; q4 < 4; ++q4) {
        const int dv = dvb * 32 + 8 * q4 + 4 * hh;
        const u32x2 g = *(const u32x2*)(gp + dv);
        const f32x4 s4 = *(const f32x4*)(sl + dv);
        u32x2 ov = {pack2(o[dvb][4 * q4] * sc * s4[0] * bflo(g[0]), o[dvb][4 * q4 + 1] * sc * s4[1] * bfhi(g[0])),
                    pack2(o[dvb][4 * q4 + 2] * sc * s4[2] * bflo(g[1]), o[dvb][4 * q4 + 3] * sc * s4[3] * bfhi(g[1]))};
        *(u32x2*)(yp + dv) = ov;
      }
  }
}

DI void phase_mixers(const Params& P, int L, const Group& G, int* ctr, char* lds, int* s_item, int mode = 0) {
  const int nscan = mode == 2 ? 0 : G.B * 16;
  const int nattn = mode == 1 ? 0 : G.B * 4 * (G.S >> 7);
  const int total = nscan + nattn;
  for (;;) {
    __syncthreads();
    if (threadIdx.x == 0) *s_item = atomicAdd(ctr, 1);
    __syncthreads();
    const int it = *s_item;
    if (it >= total) break;
    if (it < nscan) scan_task(P, L, G, it, lds);
    else attn_item(P, L, G, it - nscan, lds);
  }
}

__global__ void __launch_bounds__(NTHREADS) fwd_megakernel(Params P) {
  __shared__ __attribute__((aligned(16))) char lds[LDS_BYTES];
  __shared__ int s_item;
  cg::grid_group grid = cg::this_grid();
  phase_weights(P, lds);
  for (int ph = 0; ph < 18; ++ph) {
    const int L = ph / 9, k = ph % 9;
    const int g = (k >= 4 && k <= 6) ? 1 : 0;
    Group G;
    G.tok0 = g ? NP : 0; G.B = g ? 8 : 16; G.S = g ? 8192 : 2048; G.ntok = g ? NS : NP;
#ifdef PROBE_SCAN
    if (k == 2 || k == 5) { phase_mixers(P, L, G, P.ctr + 64 + (L * 2 + g) * 16, lds, &s_item, 1); grid.sync(); }
#endif
#ifdef PROBE_ATTN
    if (k == 2 || k == 5) { phase_mixers(P, L, G, P.ctr + 128 + (L * 2 + g) * 16, lds, &s_item, 2); grid.sync(); }
#endif
#ifdef PROBE_INPROJ
    if (k == 1 || k == 4) { phase_inproj(P, L, G, lds); grid.sync(); }
#endif
    if (k == 0) phase_prep(P, L);
    else if (k == 1 || k == 4) phase_inproj(P, L, G, lds);
    else if (k == 2 || k == 5) phase_mixers(P, L, G, P.ctr + (L * 2 + g) * 16, lds, &s_item);
    else if (k == 3 || k == 6) phase_rwkv_final(P, L, G);
    else if (k == 7) phase_outproj(P, L, lds);
    else phase_gate(P, L, lds);
    grid.sync();
  }
}

extern "C" void kernel_launch(void* const* d_in, const int* in_sizes, int n_in, void* d_out, int out_size, void* d_ws,
                              size_t ws_size, hipStream_t stream) {
  Params P{};
  const float* const* in = (const float* const*)d_in;
  P.x_prompt = in[0]; P.x_sample = in[1]; P.p_prompt = in[2]; P.p_sample = in[3];
  P.norm_pre = in[4]; P.w_in = in[5]; P.w_out = in[6]; P.conv_w = in[7]; P.conv_b = in[8];
  P.w0 = in[9]; P.w_up = in[10]; P.a0 = in[11]; P.a_up = in[12]; P.k_k = in[13]; P.k_a = in[14];
  P.r_k = in[15]; P.ln_g = in[16]; P.ln_b = in[17]; P.q_norm = in[18]; P.k_norm = in[19];
  P.lam_vec = in[20]; P.subln = in[21]; P.ple_proj = in[22]; P.ple_norm = in[23];
  P.gate_w = in[24]; P.gate_b = in[25];
  P.out = (float*)d_out;
  char* ws = (char*)d_ws;
  size_t off = 0;
  auto take = [&](size_t bytes) { char* p = ws + off; off += (bytes + 255) & ~(size_t)255; return p; };
  P.ctr = (int*)take(1024);
  P.consts = (float*)take(1024);
  P.X = (bf16_t*)take((size_t)NTOK * DM * 2);
  P.PB = (bf16_t*)take((size_t)NTOK * DPLE * 2);
  P.RS = (float*)take((size_t)NTOK * 4);
  P.WIN = (bf16_t*)take((size_t)2 * NIN * DM * 2);
  P.WOUT = (bf16_t*)take((size_t)2 * DM * DM * 2);
  P.WPLE = (bf16_t*)take((size_t)2 * DM * DPLE * 2);
  P.WGATE = (bf16_t*)take((size_t)2 * DM * DM * 2);
  P.WUPT = (bf16_t*)take((size_t)4 * 512 * 64 * 2);
  P.AUPT = (bf16_t*)take((size_t)2 * 512 * 64 * 2);
  P.CR = (bf16_t*)take((size_t)GS * CRW * 2);
  P.GRW = (bf16_t*)take((size_t)GS * 512 * 2);
  P.Q = (bf16_t*)take((size_t)GS * 512 * 2);
  P.KB = (bf16_t*)take((size_t)GS * 512 * 2);
  P.VT = (bf16_t*)take((size_t)GS * 512 * 2);
  P.GDA = (bf16_t*)take((size_t)GS * 512 * 2);
  P.YB = (bf16_t*)take((size_t)GS * 512 * 2);
  P.BV = (bf16_t*)take((size_t)GS * 512 * 2);
  P.R1 = P.CR;
  P.R2 = P.GRW;
  P.EPART = (float*)P.VT;
  if (off > ws_size) { fprintf(stderr, "workspace too small: need %zu have %zu\n", off, ws_size); return; }
  hipMemsetAsync(P.ctr, 0, 1024, stream);
  static int grid_blocks = 0;
  if (!grid_blocks) {
    int dev = 0, cus = 0, per_cu = 0;
    hipGetDevice(&dev);
    hipDeviceGetAttribute(&cus, hipDeviceAttributeMultiprocessorCount, dev);
    hipOccupancyMaxActiveBlocksPerMultiprocessor(&per_cu, fwd_megakernel, NTHREADS, 0);
    if (per_cu < 1) { fprintf(stderr, "occupancy query returned %d\n", per_cu); per_cu = 1; }
    grid_blocks = 256;
    if (cus < 256) fprintf(stderr, "unexpected CU count %d\n", cus);
  }
  void* args[] = {&P};
  hipError_t e = hipLaunchCooperativeKernel((void*)fwd_megakernel, dim3(grid_blocks), dim3(NTHREADS), args, 0, stream);
  if (e != hipSuccess) fprintf(stderr, "cooperative launch failed: %s (grid %d)\n", hipGetErrorString(e), grid_blocks);
}
```

```cpp
#include <hip/hip_runtime.h>
#include <hip/hip_cooperative_groups.h>
#include <cstdio>
namespace cg = cooperative_groups;

#define DI __device__ __forceinline__
typedef __attribute__((ext_vector_type(8))) short bf16x8;
typedef __attribute__((ext_vector_type(16))) float f32x16;
typedef __attribute__((ext_vector_type(4))) float f32x4;
typedef __attribute__((ext_vector_type(2))) float f32x2;
typedef __attribute__((ext_vector_type(4))) unsigned u32x4;
typedef __attribute__((ext_vector_type(2))) unsigned u32x2;
typedef unsigned short bf16_t;
#define MFMA(a, b, c) __builtin_amdgcn_mfma_f32_32x32x16_bf16((a), (b), (c), 0, 0, 0)

constexpr int DM = 1024;
constexpr int NP = 16 * 2048;
constexpr int NS = 8 * 8192;
constexpr int NTOK = NP + NS;
constexpr int DPLE = 256;
constexpr int IN_COLS = 4288;
constexpr int NIN = 4352;
constexpr int CRW = 1792;
constexpr int GS = NS;
constexpr float LOG2E = 1.4426950408889634f;
constexpr int NTHREADS = 512;
constexpr int LDS_BYTES = 147456;

struct Params {
  const float* x_prompt; const float* x_sample; const float* p_prompt; const float* p_sample;
  const float* norm_pre; const float* w_in; const float* w_out; const float* conv_w; const float* conv_b;
  const float* w0; const float* w_up; const float* a0; const float* a_up; const float* k_k; const float* k_a;
  const float* r_k; const float* ln_g; const float* ln_b; const float* q_norm; const float* k_norm;
  const float* lam_vec; const float* subln; const float* ple_proj; const float* ple_norm;
  const float* gate_w; const float* gate_b;
  float* out;
  bf16_t* X; bf16_t* PB; float* RS;
  bf16_t* CR; bf16_t* GRW; bf16_t* Q; bf16_t* KB; bf16_t* VT; bf16_t* GDA;
  bf16_t* R1; bf16_t* R2; float* EPART; bf16_t* YB; bf16_t* BV;
  bf16_t* WIN; bf16_t* WOUT; bf16_t* WPLE; bf16_t* WGATE; bf16_t* WUPT; bf16_t* AUPT;
  float* consts; int* ctr;
};

struct Group { int tok0, B, S, ntok; };

DI unsigned pack2(float a, float b) {
  typedef __attribute__((ext_vector_type(2))) __bf16 bf2;
  f32x2 v = {a, b};
  bf2 r = __builtin_convertvector(v, bf2);
  return __builtin_bit_cast(unsigned, r);
}
DI bf16_t f2bf(float a) { return (bf16_t)(pack2(a, 0.f) & 0xffffu); }
DI float bf2f(unsigned short u) { return __uint_as_float(((unsigned)u) << 16); }
DI float bflo(unsigned u) { return __uint_as_float(u << 16); }
DI float bfhi(unsigned u) { return __uint_as_float(u & 0xffff0000u); }
template <int CTRL> DI float dppf(float x) {
  return __int_as_float(__builtin_amdgcn_update_dpp(0, __float_as_int(x), CTRL, 0xF, 0xF, true));
}
DI float red4(float x) { x += dppf<0xB1>(x); x += dppf<0x4E>(x); return x; }
DI float red8(float x) { x = red4(x); x += dppf<0x141>(x); return x; }
DI float red32(float x) {
  x += __shfl_xor(x, 1); x += __shfl_xor(x, 2); x += __shfl_xor(x, 4); x += __shfl_xor(x, 8); x += __shfl_xor(x, 16);
  return x;
}
DI float sigmoidf_(float x) { return __builtin_amdgcn_rcpf(1.f + __expf(-x)); }
DI float siluf_(float x) { return x * __builtin_amdgcn_rcpf(1.f + __expf(-x)); }
DI float tanhf_(float x) { return 1.f - 2.f * __builtin_amdgcn_rcpf(1.f + __expf(2.f * x)); }
DI int opq(int x) { asm volatile("" : "+v"(x)); return x; }
DI int opqs(int x) { asm volatile("" : "+s"(x)); return x; }
DI int crow(int i, int h) { return (i & 3) + 8 * (i >> 2) + 4 * h; }

DI void transpose_convert(const float* __restrict__ src, int K, int N, bf16_t* __restrict__ dst, int Nd, int mode,
                          const float* __restrict__ rowscale, float* lds) {
  const int tid = opq(threadIdx.x);
  const int tk = K >> 6, tn = Nd >> 6;
  for (int t = blockIdx.x; t < tk * tn; t += gridDim.x) {
    const int k0 = (t % tk) << 6, n0 = (t / tk) << 6;
    int sn0 = n0;
    if (mode == 1) sn0 = (n0 < 1728) ? n0 : (n0 < 1792 ? -1 : n0 - 64);
    __syncthreads();
#pragma unroll
    for (int it = 0; it < 2; ++it) {
      const int kk = (tid >> 4) + 32 * it, n4 = (tid & 15) * 4;
      f32x4 v = {0.f, 0.f, 0.f, 0.f};
      if (sn0 >= 0) v = *(const f32x4*)(src + (size_t)(k0 + kk) * N + sn0 + n4);
      const float sc = rowscale ? rowscale[k0 + kk] : 1.f;
      lds[kk * 65 + n4 + 0] = v[0] * sc; lds[kk * 65 + n4 + 1] = v[1] * sc;
      lds[kk * 65 + n4 + 2] = v[2] * sc; lds[kk * 65 + n4 + 3] = v[3] * sc;
    }
    __syncthreads();
    const int nn = tid >> 3, k8 = (tid & 7) * 8;
    u32x4 o;
    o[0] = pack2(lds[(k8 + 0) * 65 + nn], lds[(k8 + 1) * 65 + nn]);
    o[1] = pack2(lds[(k8 + 2) * 65 + nn], lds[(k8 + 3) * 65 + nn]);
    o[2] = pack2(lds[(k8 + 4) * 65 + nn], lds[(k8 + 5) * 65 + nn]);
    o[3] = pack2(lds[(k8 + 6) * 65 + nn], lds[(k8 + 7) * 65 + nn]);
    *(u32x4*)(dst + (size_t)(n0 + nn) * K + k0 + k8) = o;
  }
}

DI void phase_weights(const Params& P, char* lds) {
  float* l = (float*)lds;
  for (int L = 0; L < 2; ++L) {
    transpose_convert(P.w_in + (size_t)L * DM * IN_COLS, DM, IN_COLS, P.WIN + (size_t)L * NIN * DM, NIN, 1, P.norm_pre + L * DM, l);
    transpose_convert(P.w_out + (size_t)L * DM * DM, DM, DM, P.WOUT + (size_t)L * DM * DM, DM, 0, nullptr, l);
    transpose_convert(P.ple_proj + (size_t)L * DPLE * DM, DPLE, DM, P.WPLE + (size_t)L * DM * DPLE, DM, 0, nullptr, l);
    transpose_convert(P.gate_w + (size_t)L * DM * DM, DM, DM, P.WGATE + (size_t)L * DM * DM, DM, 0, nullptr, l);
    for (int d = 0; d < 2; ++d)
      transpose_convert(P.w_up + (size_t)(L * 2 + d) * 64 * 512, 64, 512, P.WUPT + (size_t)(L * 2 + d) * 512 * 64, 512, 0, nullptr, l);
    transpose_convert(P.a_up + (size_t)L * 64 * 512, 64, 512, P.AUPT + (size_t)L * 512 * 64, 512, 0, nullptr, l);
  }
  if (blockIdx.x == 0 && threadIdx.x < 128) {
    const int L = threadIdx.x >> 6, lane = threadIdx.x & 63;
    const float* lv = P.lam_vec + L * 256;
    float s01 = lv[lane] * lv[64 + lane], s23 = lv[128 + lane] * lv[192 + lane];
    float mq = fmaxf(fabsf(P.q_norm[L * 128 + lane]), fabsf(P.q_norm[L * 128 + 64 + lane]));
    float mk = fmaxf(fabsf(P.k_norm[L * 128 + lane]), fabsf(P.k_norm[L * 128 + 64 + lane]));
    for (int o = 32; o >= 1; o >>= 1) {
      s01 += __shfl_xor(s01, o); s23 += __shfl_xor(s23, o);
      mq = fmaxf(mq, __shfl_xor(mq, o)); mk = fmaxf(mk, __shfl_xor(mk, o));
    }
    if (lane == 0) {
      const float lam_init = 0.8f - 0.6f * expf(-0.3f * (float)L);
      P.consts[L * 4 + 0] = expf(s01) - expf(s23) + lam_init;
      P.consts[L * 4 + 1] = 8.25f * mq * mk * LOG2E;
      P.consts[L * 4 + 2] = lam_init;
    }
  }
}

DI void phase_prep(const Params& P, int L) {
  const float* h0 = L == 0 ? P.x_prompt : P.out;
  const float* h1 = L == 0 ? P.x_sample : P.out + (size_t)NP * DM;
  const float* p0 = P.p_prompt + (size_t)L * NP * DPLE;
  const float* p1 = P.p_sample + (size_t)L * NS * DPLE;
  const int tidp = opq(threadIdx.x);
  const int lane = tidp & 63;
  const int gw = blockIdx.x * (NTHREADS / 64) + (tidp >> 6), nw = gridDim.x * (NTHREADS / 64);
  for (int tok = gw; tok < NTOK; tok += nw) {
    const float* hr = tok < NP ? h0 + (size_t)tok * DM : h1 + (size_t)(tok - NP) * DM;
    float ss = 0.f;
#pragma unroll
    for (int i = 0; i < 4; ++i) {
      f32x4 v = *(const f32x4*)(hr + i * 256 + lane * 4);
      ss += v[0] * v[0] + v[1] * v[1] + v[2] * v[2] + v[3] * v[3];
      u32x2 o = {pack2(v[0], v[1]), pack2(v[2], v[3])};
      *(u32x2*)(P.X + (size_t)tok * DM + i * 256 + lane * 4) = o;
    }
    for (int o = 32; o >= 1; o >>= 1) ss += __shfl_xor(ss, o);
    if (lane == 0) P.RS[tok] = rsqrtf(ss * (1.f / DM) + 1e-6f);
    const float* pr = tok < NP ? p0 + (size_t)tok * DPLE : p1 + (size_t)(tok - NP) * DPLE;
    f32x4 v = *(const f32x4*)(pr + lane * 4);
    u32x2 o = {pack2(v[0], v[1]), pack2(v[2], v[3])};
    *(u32x2*)(P.PB + (size_t)tok * DPLE + lane * 4) = o;
  }
}

constexpr int GSTR = 144;
constexpr int GA_BYTES = 256 * GSTR;
constexpr int GSTAGE = 2 * GA_BYTES;

DI void gemm_mainloop(const bf16_t* __restrict__ A, int lda, const bf16_t* __restrict__ Bw, int ldb, int K,
                      int m0, int n0, char* lds, f32x16 (&acc)[2][4]) {
  const int tid = opq(threadIdx.x), lane = tid & 63, w = tid >> 6, hh = lane >> 5, r = lane & 31;
  const int wm = w >> 1, wn = w & 1;
#pragma unroll
  for (int mi = 0; mi < 2; ++mi)
#pragma unroll
    for (int ni = 0; ni < 4; ++ni)
#pragma unroll
      for (int i = 0; i < 16; ++i) acc[mi][ni][i] = 0.f;
  const int lrow = tid >> 3, lkc = tid & 7;
  const bf16_t* ap = A + (size_t)(m0 + lrow) * lda + lkc * 8;
  const bf16_t* bp = Bw + (size_t)(n0 + lrow) * ldb + lkc * 8;
  const int nk = K >> 6;
  u32x4 ra[4], rb[4];
#pragma unroll
  for (int i = 0; i < 4; ++i) {
    ra[i] = *(const u32x4*)(ap + (size_t)(64 * i) * lda);
    rb[i] = *(const u32x4*)(bp + (size_t)(64 * i) * ldb);
  }
  __syncthreads();
#pragma unroll
  for (int i = 0; i < 4; ++i) {
    *(u32x4*)(lds + (lrow + 64 * i) * GSTR + lkc * 16) = ra[i];
    *(u32x4*)(lds + GA_BYTES + (lrow + 64 * i) * GSTR + lkc * 16) = rb[i];
  }
  __syncthreads();
  for (int kt = 0; kt < nk; ++kt) {
    const bool more = kt + 1 < nk;
    if (more) {
#pragma unroll
      for (int i = 0; i < 4; ++i) {
        ra[i] = *(const u32x4*)(ap + (size_t)(64 * i) * lda + (kt + 1) * 64);
        rb[i] = *(const u32x4*)(bp + (size_t)(64 * i) * ldb + (kt + 1) * 64);
      }
    }
    __builtin_amdgcn_sched_barrier(0);
    const char* sa = lds + (kt & 1) * GSTAGE + (wm * 64 + r) * GSTR + hh * 16;
    const char* sb = lds + (kt & 1) * GSTAGE + GA_BYTES + (wn * 128 + r) * GSTR + hh * 16;
    bf16x8 fa[2][2], fb[2][4];
#pragma unroll
    for (int mi = 0; mi < 2; ++mi) fa[0][mi] = *(const bf16x8*)(sa + mi * 32 * GSTR);
#pragma unroll
    for (int ni = 0; ni < 4; ++ni) fb[0][ni] = *(const bf16x8*)(sb + ni * 32 * GSTR);
#pragma unroll
    for (int ks = 0; ks < 4; ++ks) {
      if (ks < 3) {
#pragma unroll
        for (int mi = 0; mi < 2; ++mi) fa[(ks + 1) & 1][mi] = *(const bf16x8*)(sa + mi * 32 * GSTR + (ks + 1) * 32);
#pragma unroll
        for (int ni = 0; ni < 4; ++ni) fb[(ks + 1) & 1][ni] = *(const bf16x8*)(sb + ni * 32 * GSTR + (ks + 1) * 32);
      }
      __builtin_amdgcn_sched_barrier(0);
#pragma unroll
      for (int mi = 0; mi < 2; ++mi)
#pragma unroll
        for (int ni = 0; ni < 4; ++ni) acc[mi][ni] = MFMA(fb[ks & 1][ni], fa[ks & 1][mi], acc[mi][ni]);
      __builtin_amdgcn_sched_barrier(0);
    }
    if (more) {
      char* d = lds + ((kt + 1) & 1) * GSTAGE;
#pragma unroll
      for (int i = 0; i < 4; ++i) {
        *(u32x4*)(d + (lrow + 64 * i) * GSTR + lkc * 16) = ra[i];
        *(u32x4*)(d + GA_BYTES + (lrow + 64 * i) * GSTR + lkc * 16) = rb[i];
      }
    }
    __syncthreads();
  }
}

DI bool xcd_tile(int rd, int nM, int nN, int& mt, int& nt) {
  const int xcd = blockIdx.x & 7, j = blockIdx.x >> 3;
  const int u = (rd * 8 + xcd) * 32 + j;
  if (u >= nM * nN) return false;
  const int band = u / (8 * nN), rem = u % (8 * nN);
  nt = rem >> 3; mt = band * 8 + (rem & 7);
  return true;
}

namespace pg8 {
#define PG8_LAS __attribute__((address_space(3)))
constexpr int BM = 256, BK = 64, HALF = 128, HTB = HALF * BK * 2  , STAGE_BYTES = 8 * HTB, NXCD = 8, WGM = 8;
__host__ __device__ __forceinline__ int lds_byte(int r, int c) { const int st = (r >> 4) * 2 + (c >> 5), rr = r & 15, cc = c & 31, ob = rr * 64 + cc * 2; return st * 1024 + (ob ^ (((ob >> 9) & 1) << 5)); }
__host__ __device__ __forceinline__ void stage_rc(int b, int& R, int& C) { const int st = b / 1024, sb = b % 1024, swz = sb ^ (((sb >> 9) & 1) << 5); R = (st >> 1) * 16 + swz / 64; C = (st & 1) * 32 + (swz % 64) / 2; }
__host__ __device__ __forceinline__ int perm32(int rho) { const int n = rho >> 4, i = rho & 15; return 8 * (i >> 2) + 4 * n + (i & 3); }

struct Unit { int pm, pn; };
struct Gemm { const bf16_t* A; const bf16_t* Bt; int M, N, K; };
template <class Epi, class Sched, bool ALIGN_EPI = false, bool SP2 = false>
__device__ __forceinline__ void gemm_phase(PG8_LAS unsigned char* lds, const Gemm g, const Sched& S, const Epi& E) {
    const int tid = opq(threadIdx.x), wid = __builtin_amdgcn_readfirstlane(tid >> 6), lane = tid & 63, wr = wid >> 2, wc = wid & 3, fr = lane & 15, fq = lane >> 4;
    const int K = g.K, nt = K / BK;
    unsigned voffA[2], voffB[2];
#pragma unroll
    for (int i = 0; i < 2; ++i) { int R, C; stage_rc(tid * 16 + i * 8192, R, C); const int Rb = Epi::PERM ? ((R & ~31) + perm32(R & 31)) : R;
        voffA[i] = (unsigned)(R * K + C) * 2u; voffB[i] = (unsigned)(Rb * K + C) * 2u; }
    const size_t kstep = (size_t)(BK * 2);
    const size_t hstep = (size_t)HALF * K * 2;
    const size_t tstep = 2 * hstep;
    const unsigned ldsw = (unsigned)wid * 1024u;
    const int aoff = lds_byte(wr * 64 + fr, fq * 8), boff = lds_byte(wc * 32 + fr, fq * 8);
#define PG8_SA(b, h) (((b) * 2 + (h)) * HTB)
#define PG8_SB(b, h) ((4 + (b) * 2 + (h)) * HTB)
#define PG8_STAGE(bufoff, gbase, voff) do { _Pragma("unroll") for (int _i = 0; _i < 2; ++_i) \
        __builtin_amdgcn_global_load_lds((const unsigned*)((const char*)(gbase) + (voff)[_i]), (PG8_LAS unsigned*)(lds + (bufoff) + ldsw + _i * 8192), 16, 0, 0); } while (0)
#define PG8_LDA(dst, b, h) do { _Pragma("unroll") for (int m = 0; m < 4; ++m) _Pragma("unroll") for (int k = 0; k < 2; ++k) dst[m][k] = *(const PG8_LAS bf16x8*)(lds + PG8_SA(b, h) + aoff + m * 2048 + k * 1024); } while (0)
#define PG8_LDB(dst, b, h) do { _Pragma("unroll") for (int n = 0; n < 2; ++n) _Pragma("unroll") for (int k = 0; k < 2; ++k) dst[n][k] = *(const PG8_LAS bf16x8*)(lds + PG8_SB(b, h) + boff + n * 2048 + k * 1024); } while (0)
#define PG8_MMA(ai, bj, At, Bt) do { __builtin_amdgcn_s_setprio(1); _Pragma("unroll") for (int m = 0; m < 4; ++m) _Pragma("unroll") for (int n = 0; n < 2; ++n) _Pragma("unroll") for (int k = 0; k < 2; ++k) \
        acc[ai][bj][m][n] = __builtin_amdgcn_mfma_f32_16x16x32_bf16(Bt[n][k], At[m][k], acc[ai][bj][m][n], 0, 0, 0); __builtin_amdgcn_s_setprio(0); } while (0)
#define PG8_WAIT_V(n) asm volatile("s_waitcnt vmcnt(" #n ")" ::: "memory")
#define PG8_WAIT_L(n) asm volatile("s_waitcnt lgkmcnt(" #n ")" ::: "memory")
#define PG8_BAR __builtin_amdgcn_s_barrier()
#define PG8_SCHED __builtin_amdgcn_sched_barrier(0)
    Unit cur, nxt; int ui = 0;
    if (!S.next(0, cur)) return;
    f32x4 acc[2][2][4][2];
#pragma unroll
    for (int a = 0; a < 2; ++a)
#pragma unroll
        for (int b = 0; b < 2; ++b)
#pragma unroll
            for (int m = 0; m < 4; ++m)
#pragma unroll
                for (int n = 0; n < 2; ++n) acc[a][b][m][n] = (f32x4){0.f, 0.f, 0.f, 0.f};
    bf16x8 At[4][2], B0[2][2], B1[2][2];
    const char* cA = (const char*)g.A + (size_t)cur.pm * tstep; const char* cB = (const char*)g.Bt + (size_t)cur.pn * tstep;
    S.a_ready(cur);
    if constexpr (SP2) {
        PG8_STAGE(PG8_SB(0, 0), cB, voffB); PG8_STAGE(PG8_SB(0, 1), cB + hstep, voffB); PG8_STAGE(PG8_SA(0, 0), cA, voffA); PG8_STAGE(PG8_SA(0, 1), cA + hstep, voffA);
        if (wr == 1) PG8_BAR;
        PG8_WAIT_V(2); PG8_BAR;
        PG8_STAGE(PG8_SB(1, 0), cB + kstep, voffB); PG8_STAGE(PG8_SA(1, 0), cA + kstep, voffA); PG8_STAGE(PG8_SB(1, 1), cB + hstep + kstep, voffB);
        PG8_WAIT_V(6); PG8_BAR;
    } else {
        PG8_STAGE(PG8_SB(0, 0), cB, voffB); PG8_STAGE(PG8_SA(0, 0), cA, voffA); PG8_STAGE(PG8_SB(0, 1), cB + hstep, voffB); PG8_STAGE(PG8_SA(0, 1), cA + hstep, voffA);
        if (wr == 1) PG8_BAR;
        PG8_WAIT_V(4); PG8_BAR;
        PG8_STAGE(PG8_SB(1, 0), cB + kstep, voffB); PG8_STAGE(PG8_SA(1, 0), cA + kstep, voffA); PG8_STAGE(PG8_SB(1, 1), cB + hstep + kstep, voffB);
        PG8_WAIT_V(6); PG8_BAR;
    }
    for (;;) {
        const bool has_next = S.next(ui + 1, nxt);
        const char* nA = has_next ? (const char*)g.A + (size_t)nxt.pm * tstep : cA; const char* nB = has_next ? (const char*)g.Bt + (size_t)nxt.pn * tstep : cB;
        for (int t = 0; t < nt; t += 2) {
            const bool last = (t == nt - 2);
            const char* a1 = cA + (size_t)(t + 1) * kstep;
            const char* a2 = last ? nA : cA + (size_t)(t + 2) * kstep; const char* b2 = last ? nB : cB + (size_t)(t + 2) * kstep;
            const char* a3 = a2 + kstep; const char* b3 = b2 + kstep;
            if (last && has_next) S.a_ready(nxt);
            if constexpr (SP2) {
            PG8_LDB(B0, 0, 0); PG8_LDB(B1, 0, 1); PG8_SCHED; PG8_LDA(At, 0, 0); PG8_STAGE(PG8_SA(1, 1), a1 + hstep, voffA);
            PG8_WAIT_V(8); PG8_WAIT_L(0); PG8_BAR; PG8_MMA(0, 0, At, B0); PG8_MMA(0, 1, At, B1); PG8_BAR; PG8_SCHED;
            PG8_LDA(At, 0, 1); PG8_STAGE(PG8_SB(0, 0), b2, voffB); PG8_STAGE(PG8_SB(0, 1), b2 + hstep, voffB); PG8_STAGE(PG8_SA(0, 0), a2, voffA);
            PG8_WAIT_V(8); PG8_WAIT_L(0); PG8_BAR; PG8_MMA(1, 0, At, B0); PG8_MMA(1, 1, At, B1); PG8_BAR; PG8_SCHED;
            PG8_LDB(B0, 1, 0); PG8_LDB(B1, 1, 1); PG8_SCHED; PG8_LDA(At, 1, 0); PG8_STAGE(PG8_SA(0, 1), a2 + hstep, voffA);
            PG8_WAIT_V(8); PG8_WAIT_L(0); PG8_BAR; PG8_MMA(0, 0, At, B0); PG8_MMA(0, 1, At, B1); PG8_BAR; PG8_SCHED;
            PG8_LDA(At, 1, 1); PG8_STAGE(PG8_SB(1, 0), b3, voffB); PG8_STAGE(PG8_SB(1, 1), b3 + hstep, voffB); PG8_STAGE(PG8_SA(1, 0), a3, voffA);
            PG8_WAIT_V(8); PG8_WAIT_L(0); PG8_BAR; PG8_MMA(1, 0, At, B0); PG8_MMA(1, 1, At, B1); PG8_BAR; PG8_SCHED;
            } else {
            PG8_LDB(B0, 0, 0); PG8_SCHED; PG8_LDA(At, 0, 0); PG8_STAGE(PG8_SA(1, 1), a1 + hstep, voffA);
            PG8_WAIT_L(8); PG8_BAR; PG8_WAIT_L(0); PG8_MMA(0, 0, At, B0); PG8_BAR; PG8_SCHED;
            PG8_LDB(B1, 0, 1); PG8_STAGE(PG8_SB(0, 0), b2, voffB);
            PG8_BAR; PG8_WAIT_L(0); PG8_MMA(0, 1, At, B1); PG8_BAR;
            PG8_LDA(At, 0, 1); PG8_STAGE(PG8_SA(0, 0), a2, voffA);
            PG8_BAR; PG8_WAIT_L(0); PG8_MMA(1, 0, At, B0); PG8_BAR; PG8_SCHED;
            PG8_STAGE(PG8_SB(0, 1), b2 + hstep, voffB);
            PG8_WAIT_V(6); PG8_BAR; PG8_MMA(1, 1, At, B1); PG8_BAR;
            PG8_LDB(B0, 1, 0); PG8_SCHED; PG8_LDA(At, 1, 0); PG8_STAGE(PG8_SA(0, 1), a2 + hstep, voffA);
            PG8_WAIT_L(8); PG8_BAR; PG8_WAIT_L(0); PG8_MMA(0, 0, At, B0); PG8_BAR; PG8_SCHED;
            PG8_LDB(B1, 1, 1); PG8_STAGE(PG8_SB(1, 0), b3, voffB);
            PG8_BAR; PG8_WAIT_L(0); PG8_MMA(0, 1, At, B1); PG8_BAR;
            PG8_LDA(At, 1, 1); PG8_STAGE(PG8_SA(1, 0), a3, voffA);
            PG8_BAR; PG8_WAIT_L(0); PG8_MMA(1, 0, At, B0); PG8_BAR; PG8_SCHED;
            PG8_STAGE(PG8_SB(1, 1), b3 + hstep, voffB);
            PG8_WAIT_V(6); PG8_BAR; PG8_MMA(1, 1, At, B1); PG8_BAR;
            }
        }
        if constexpr (ALIGN_EPI) { if (wr == 0) PG8_BAR; }
        if constexpr (!Epi::AFTER_DRAIN) { E(acc, cur, wr, wc, fr, fq); S.done(cur); }
        if (!has_next) break;
#pragma unroll
        for (int a = 0; a < 2; ++a)
#pragma unroll
            for (int b = 0; b < 2; ++b)
#pragma unroll
                for (int m = 0; m < 4; ++m)
#pragma unroll
                    for (int n = 0; n < 2; ++n) acc[a][b][m][n] = (f32x4){0.f, 0.f, 0.f, 0.f};
        cur = nxt; cA = nA; cB = nB; ++ui;
        if constexpr (ALIGN_EPI) { if (wr == 1) PG8_BAR; }
    }
    PG8_WAIT_V(0);
    if constexpr (!ALIGN_EPI) { if (wr == 0) PG8_BAR; }
    PG8_BAR;
    if constexpr (Epi::AFTER_DRAIN) { E.fused(acc, cur, wr, wc, fr, fq, lds, wid, lane); S.done(cur); }
#undef PG8_SA
#undef PG8_SB
#undef PG8_STAGE
#undef PG8_LDA
#undef PG8_LDB
#undef PG8_MMA
#undef PG8_WAIT_V
#undef PG8_WAIT_L
#undef PG8_BAR
#undef PG8_SCHED
}
}

struct TileSched {
  int nM, nN, skip_lo, skip_hi;
  DI bool next(int i, pg8::Unit& u) const {
    const int nNe = nN - (skip_hi - skip_lo);
    const int xcd = blockIdx.x & 7, j = blockIdx.x >> 3;
    const int t = (i * 8 + xcd) * 32 + j;
    if (t >= nM * nNe) return false;
    const int band = t / (8 * nNe), rem = t % (8 * nNe);
    int pn = rem >> 3; const int pm = band * 8 + (rem & 7);
    if (pn >= skip_lo) pn += skip_hi - skip_lo;
    u.pm = pm; u.pn = pn; return true;
  }
  DI void a_ready(const pg8::Unit&) const {}
  DI void done(const pg8::Unit&) const {}
};

DI u32x4 pack8(f32x4 a, f32x4 b) { u32x4 w = {pack2(a[0], a[1]), pack2(a[2], a[3]), pack2(b[0], b[1]), pack2(b[2], b[3])}; return w; }

struct InProjEpi {
  static constexpr bool PERM = true, AFTER_DRAIN = false;
  const float* RS; bf16_t* CR; bf16_t* GRW; bf16_t* GDA; bf16_t* VT; int tok0, S;
  DI void operator()(const f32x4 (&acc)[2][2][4][2], const pg8::Unit& u, int wr, int wc, int fr, int fq) const {
    const int row0 = u.pm * 256 + wr * 64 + fr, col0 = u.pn * 256 + wc * 32 + 8 * fq;
#pragma unroll
    for (int ai = 0; ai < 2; ++ai)
#pragma unroll
      for (int m = 0; m < 4; ++m) {
        const int row = row0 + ai * 128 + m * 16;
        const float rsv = RS[tok0 + row];
#pragma unroll
        for (int bj = 0; bj < 2; ++bj) {
          const int col = col0 + bj * 128;
          const f32x4 v0 = acc[ai][bj][m][0] * rsv, v1 = acc[ai][bj][m][1] * rsv;
          if (u.pn < 7) {
            *(u32x4*)(CR + (size_t)row * CRW + col) = pack8(v0, v1);
          } else if (u.pn < 9 || u.pn >= 15) {
            bf16_t* dst = (u.pn < 9 ? GRW + (col - 1792) : GDA + (col - 3840)) + (size_t)row * 512;
            const f32x4 s0 = {siluf_(v0[0]), siluf_(v0[1]), siluf_(v0[2]), siluf_(v0[3])};
            const f32x4 s1 = {siluf_(v1[0]), siluf_(v1[1]), siluf_(v1[2]), siluf_(v1[3])};
            *(u32x4*)dst = pack8(s0, s1);
          } else {
            const int cv = col - 3328, hd = cv >> 7, dv = cv & 127;
            const int b = row / S, s = row % S;
            bf16_t* dst = VT + ((size_t)((b * 4 + hd) * 128 + dv)) * S + s;
            const size_t Sz = (size_t)S;
            dst[0] = f2bf(v0[0]); dst[Sz] = f2bf(v0[1]); dst[2 * Sz] = f2bf(v0[2]); dst[3 * Sz] = f2bf(v0[3]);
            dst[4 * Sz] = f2bf(v1[0]); dst[5 * Sz] = f2bf(v1[1]); dst[6 * Sz] = f2bf(v1[2]); dst[7 * Sz] = f2bf(v1[3]);
          }
        }
        __builtin_amdgcn_sched_barrier(0);
      }
  }
};

struct OutProjEpi {
  static constexpr bool PERM = true, AFTER_DRAIN = false;
  const float* h0; const float* h1; float* out; bf16_t* R1;
  DI void operator()(const f32x4 (&acc)[2][2][4][2], const pg8::Unit& u, int wr, int wc, int fr, int fq) const {
    const int row0 = u.pm * 256 + wr * 64 + fr, col0 = u.pn * 256 + wc * 32 + 8 * fq;
#pragma unroll
    for (int ai = 0; ai < 2; ++ai)
#pragma unroll
      for (int m = 0; m < 4; ++m) {
        const int row = row0 + ai * 128 + m * 16;
        const float* hr = (row < NP ? h0 + (size_t)row * DM : h1 + (size_t)(row - NP) * DM);
#pragma unroll
        for (int bj = 0; bj < 2; ++bj) {
          const int col = col0 + bj * 128;
          const f32x4 a0 = *(const f32x4*)(hr + col) + acc[ai][bj][m][0];
          const f32x4 a1 = *(const f32x4*)(hr + col + 4) + acc[ai][bj][m][1];
          *(f32x4*)(out + (size_t)row * DM + col) = a0;
          *(f32x4*)(out + (size_t)row * DM + col + 4) = a1;
          *(u32x4*)(R1 + (size_t)row * DM + col) = pack8(a0, a1);
        }
        __builtin_amdgcn_sched_barrier(0);
      }
  }
};

struct EEpi {
  static constexpr bool PERM = true, AFTER_DRAIN = false;
  bf16_t* R2; float* EPART;
  DI void operator()(const f32x4 (&acc)[2][2][4][2], const pg8::Unit& u, int wr, int wc, int fr, int fq) const {
    const int row0 = u.pm * 256 + wr * 64 + fr, col0 = u.pn * 256 + wc * 32 + 8 * fq;
#pragma unroll
    for (int ai = 0; ai < 2; ++ai)
#pragma unroll
      for (int m = 0; m < 4; ++m) {
        const int row = row0 + ai * 128 + m * 16;
        float ss = 0.f;
#pragma unroll
        for (int bj = 0; bj < 2; ++bj) {
          const f32x4 v0 = acc[ai][bj][m][0], v1 = acc[ai][bj][m][1];
          ss += v0[0] * v0[0] + v0[1] * v0[1] + v0[2] * v0[2] + v0[3] * v0[3] + v1[0] * v1[0] + v1[1] * v1[1] + v1[2] * v1[2] + v1[3] * v1[3];
          *(u32x4*)(R2 + (size_t)row * DM + col0 + bj * 128) = pack8(v0, v1);
        }
        ss += __shfl_xor(ss, 16); ss += __shfl_xor(ss, 32);
        if (fq == 0) EPART[(size_t)(u.pn * 4 + wc) * NTOK + row] = ss;
        __builtin_amdgcn_sched_barrier(0);
      }
  }
};

struct GateEpi {
  static constexpr bool PERM = true, AFTER_DRAIN = false;
  float* out; const bf16_t* R2; const float* EPART; const float* gate_b; const float* ple_norm;
  DI void operator()(const f32x4 (&acc)[2][2][4][2], const pg8::Unit& u, int wr, int wc, int fr, int fq) const {
    const int row0 = u.pm * 256 + wr * 64 + fr, col0 = u.pn * 256 + wc * 32 + 8 * fq;
#pragma unroll
    for (int ai = 0; ai < 2; ++ai)
#pragma unroll
      for (int m = 0; m < 4; ++m) {
        const int row = row0 + ai * 128 + m * 16;
        float es = 0.f;
#pragma unroll
        for (int j = 0; j < 8; ++j) es += EPART[(size_t)j * NTOK + row];
        const float rse = rsqrtf(es * (1.f / DM) + 1e-6f);
#pragma unroll
        for (int bj = 0; bj < 2; ++bj) {
          const int col = col0 + bj * 128;
          const u32x4 ev = *(const u32x4*)(R2 + (size_t)row * DM + col);
          float* op = out + (size_t)row * DM + col;
#pragma unroll
          for (int n = 0; n < 2; ++n) {
            const f32x4 gb = *(const f32x4*)(gate_b + col + 4 * n), pn = *(const f32x4*)(ple_norm + col + 4 * n);
            f32x4 hv = *(const f32x4*)(op + 4 * n);
            const f32x4 a = acc[ai][bj][m][n];
            hv[0] += sigmoidf_(a[0] + gb[0]) * (bflo(ev[2 * n]) * rse * pn[0]);
            hv[1] += sigmoidf_(a[1] + gb[1]) * (bfhi(ev[2 * n]) * rse * pn[1]);
            hv[2] += sigmoidf_(a[2] + gb[2]) * (bflo(ev[2 * n + 1]) * rse * pn[2]);
            hv[3] += sigmoidf_(a[3] + gb[3]) * (bfhi(ev[2 * n + 1]) * rse * pn[3]);
            *(f32x4*)(op + 4 * n) = hv;
          }
        }
        __builtin_amdgcn_sched_barrier(0);
      }
  }
};

DI void phase_inproj(const Params& P, int L, const Group& G, char* lds) {
  const int tid = opq(threadIdx.x), lane = tid & 63, w = tid >> 6, hh = lane >> 5, r = lane & 31;
  const int wm = w >> 1, wn = w & 1;
  const int nmt = G.ntok >> 8, ntile = nmt * 17;
  const bf16_t* A = P.X + (size_t)G.tok0 * DM;
  const bf16_t* Bw = P.WIN + (size_t)L * NIN * DM;
  {
    const pg8::Gemm g = {A, Bw, G.ntok, NIN, DM};
    const TileSched sch = {nmt, 17, 9, 13};
    const InProjEpi epi = {P.RS, P.CR, P.GRW, P.GDA, P.VT, G.tok0, G.S};
    pg8::gemm_phase<InProjEpi, TileSched, true, true>((PG8_LAS unsigned char*)lds, g, sch, epi);
  }
  for (int t = blockIdx.x; t < nmt * 4; t += gridDim.x) {
    const int mt = t >> 2, nt = 9 + (t & 3);
    const int m0 = mt << 8, n0 = nt << 8;
    f32x16 acc[2][4];
    gemm_mainloop(A, DM, Bw, DM, DM, m0, n0, lds, acc);
    const int colw = n0 + wn * 128 + 4 * hh;
    if (nt < 7) {
#pragma unroll
      for (int mi = 0; mi < 2; ++mi) {
        const int row = m0 + wm * 64 + mi * 32 + r;
        const float rsv = P.RS[G.tok0 + row];
        bf16_t* dst = P.CR + (size_t)row * CRW + colw;
#pragma unroll
        for (int ni = 0; ni < 4; ++ni)
#pragma unroll
          for (int q4 = 0; q4 < 4; ++q4) {
            u32x2 o = {pack2(acc[mi][ni][4 * q4] * rsv, acc[mi][ni][4 * q4 + 1] * rsv),
                       pack2(acc[mi][ni][4 * q4 + 2] * rsv, acc[mi][ni][4 * q4 + 3] * rsv)};
            *(u32x2*)(dst + ni * 32 + q4 * 8) = o;
          }
      }
    } else if (nt < 9 || nt >= 15) {
      bf16_t* dbase = nt < 9 ? P.GRW : P.GDA;
      const int c0 = colw - (nt < 9 ? 1792 : 3840);
#pragma unroll
      for (int mi = 0; mi < 2; ++mi) {
        const int row = m0 + wm * 64 + mi * 32 + r;
        const float rsv = P.RS[G.tok0 + row];
        bf16_t* dst = dbase + (size_t)row * 512 + c0;
#pragma unroll
        for (int ni = 0; ni < 4; ++ni)
#pragma unroll
          for (int q4 = 0; q4 < 4; ++q4) {
            u32x2 o = {pack2(siluf_(acc[mi][ni][4 * q4] * rsv), siluf_(acc[mi][ni][4 * q4 + 1] * rsv)),
                       pack2(siluf_(acc[mi][ni][4 * q4 + 2] * rsv), siluf_(acc[mi][ni][4 * q4 + 3] * rsv))};
            *(u32x2*)(dst + ni * 32 + q4 * 8) = o;
          }
      }
    } else if (nt < 13) {
      const bool isq = nt < 11;
      bf16_t* dbase = isq ? P.Q : P.KB;
      const int c0 = colw - (isq ? 2304 : 2816);
      const float* g = (isq ? P.q_norm : P.k_norm) + L * 128 + 4 * hh;
      const float osc = isq ? 0.125f * LOG2E : 1.f;
#pragma unroll
      for (int mi = 0; mi < 2; ++mi) {
        const int row = m0 + wm * 64 + mi * 32 + r;
        const float rsv = P.RS[G.tok0 + row];
        bf16_t* dst = dbase + (size_t)row * 512 + c0;
#pragma unroll
        for (int gi = 0; gi < 2; ++gi) {
          float ss = 0.f;
#pragma unroll
          for (int t2 = 0; t2 < 2; ++t2)
#pragma unroll
            for (int i = 0; i < 16; ++i) { const float v = acc[mi][2 * gi + t2][i] * rsv; ss += v * v; }
          ss += __shfl_xor(ss, 32);
          const float sc = rsqrtf(ss * (1.f / 64.f) + 1e-6f) * rsv * osc;
#pragma unroll
          for (int t2 = 0; t2 < 2; ++t2)
#pragma unroll
            for (int q4 = 0; q4 < 4; ++q4) {
              const f32x4 gv = *(const f32x4*)(g + gi * 64 + t2 * 32 + q4 * 8);
              u32x2 o = {pack2(acc[mi][2 * gi + t2][4 * q4] * sc * gv[0], acc[mi][2 * gi + t2][4 * q4 + 1] * sc * gv[1]),
                         pack2(acc[mi][2 * gi + t2][4 * q4 + 2] * sc * gv[2], acc[mi][2 * gi + t2][4 * q4 + 3] * sc * gv[3])};
              *(u32x2*)(dst + (2 * gi + t2) * 32 + q4 * 8) = o;
            }
        }
      }
    } else {
      const int hd = (n0 + wn * 128 - 3328) >> 7;
      const int row0 = m0 + wm * 64;
      const int b = row0 / G.S, s0 = row0 % G.S;
#pragma unroll
      for (int mi = 0; mi < 2; ++mi) {
        const int s = s0 + mi * 32 + r;
        const float rsv = P.RS[G.tok0 + b * G.S + s];
        bf16_t* dst = P.VT + ((size_t)((b * 4 + hd) * 128 + 4 * hh)) * G.S + s;
        const size_t Sz = (size_t)G.S;
#pragma unroll
        for (int ni = 0; ni < 4; ++ni)
#pragma unroll
          for (int q4 = 0; q4 < 4; ++q4) {
            bf16_t* pq = dst + (size_t)(ni * 32 + 8 * q4) * Sz;
            pq[0] = f2bf(acc[mi][ni][4 * q4] * rsv);
            pq[Sz] = f2bf(acc[mi][ni][4 * q4 + 1] * rsv);
            pq[2 * Sz] = f2bf(acc[mi][ni][4 * q4 + 2] * rsv);
            pq[3 * Sz] = f2bf(acc[mi][ni][4 * q4 + 3] * rsv);
            __builtin_amdgcn_sched_barrier(0);
          }
      }
    }
  }
}

DI void phase_outproj(const Params& P, int L, char* lds) {
  const float* h0 = L == 0 ? P.x_prompt : P.out;
  const float* h1 = L == 0 ? P.x_sample : P.out + (size_t)NP * DM;
  {
    const pg8::Gemm g = {P.X, P.WOUT + (size_t)L * DM * DM, NTOK, DM, DM};
    const TileSched sch = {NTOK >> 8, 4, 0, 0};
    const OutProjEpi epi = {h0, h1, P.out, P.R1};
    pg8::gemm_phase<OutProjEpi, TileSched, true, true>((PG8_LAS unsigned char*)lds, g, sch, epi);
  }
  {
    const int tid = opq(threadIdx.x), lane = tid & 63, w = tid >> 6, hh = lane >> 5, r = lane & 31;
    const int wm = w >> 1, wn = w & 1;
    const int ntile = (NTOK >> 8) * 4;
    for (int tt = blockIdx.x; tt < ntile; tt += gridDim.x) {
      const int mt = tt >> 2, nt = tt & 3;
      const int m0 = mt << 8, n0 = nt << 8;
      const int colw = n0 + wn * 128 + 4 * hh;
      f32x16 acc[2][4];
      gemm_mainloop(P.PB, DPLE, P.WPLE + (size_t)L * DM * DPLE, DPLE, DPLE, m0, n0, lds, acc);
#pragma unroll
      for (int mi = 0; mi < 2; ++mi) {
        const int row = m0 + wm * 64 + mi * 32 + r;
        bf16_t* rp = P.R2 + (size_t)row * DM + colw;
        float ss = 0.f;
#pragma unroll
        for (int ni = 0; ni < 4; ++ni)
#pragma unroll
          for (int q4 = 0; q4 < 4; ++q4) {
            const float v0 = acc[mi][ni][4 * q4], v1 = acc[mi][ni][4 * q4 + 1], v2 = acc[mi][ni][4 * q4 + 2], v3 = acc[mi][ni][4 * q4 + 3];
            ss += v0 * v0 + v1 * v1 + v2 * v2 + v3 * v3;
            u32x2 o = {pack2(v0, v1), pack2(v2, v3)};
            *(u32x2*)(rp + ni * 32 + q4 * 8) = o;
          }
        ss += __shfl_xor(ss, 32);
        if (hh == 0) P.EPART[(size_t)(nt * 2 + wn) * NTOK + row] = ss;
      }
    }
  }
}

DI void phase_gate(const Params& P, int L, char* lds) {
  const pg8::Gemm g = {P.R1, P.WGATE + (size_t)L * DM * DM, NTOK, DM, DM};
  const TileSched sch = {NTOK >> 8, 4, 0, 0};
  const GateEpi epi = {P.out, P.R2, P.EPART, P.gate_b + L * DM, P.ple_norm + L * DM};
  pg8::gemm_phase<GateEpi, TileSched, true, true>((PG8_LAS unsigned char*)lds, g, sch, epi);
}

constexpr int TC = 32;
constexpr int CB_OP = TC * 64 * 4;
constexpr int CB_BYTES = 6 * CB_OP + 128 + 1024;
constexpr int PW_BYTES = 10 * 640 + 2 * 8 * 144;
constexpr int PW_BASE = 2 * CB_BYTES;

template <int N> DI void red64v(float (&x)[N]) {
#pragma unroll
  for (int i = 0; i < N; ++i) x[i] += dppf<0xB1>(x[i]);
#pragma unroll
  for (int i = 0; i < N; ++i) x[i] += dppf<0x4E>(x[i]);
#pragma unroll
  for (int i = 0; i < N; ++i) x[i] += dppf<0x141>(x[i]);
#pragma unroll
  for (int i = 0; i < N; ++i) x[i] += dppf<0x140>(x[i]);
#pragma unroll
  for (int i = 0; i < N; ++i) x[i] += __shfl_xor(x[i], 16);
#pragma unroll
  for (int i = 0; i < N; ++i) x[i] += __shfl_xor(x[i], 32);
}

struct ScanOps { f32x4 a0, a1, b0, b1, k0, k1, r0, r1; f32x2 v; };

DI ScanOps scan_load(const float* __restrict__ ob, int s, int coff, int row0) {
  ScanOps o;
  const float* p = ob + s * 64 + coff;
  o.a0 = *(const f32x4*)(p + TC * 64);       o.a1 = *(const f32x4*)(p + TC * 64 + 4);
  o.b0 = *(const f32x4*)(p + 2 * TC * 64);   o.b1 = *(const f32x4*)(p + 2 * TC * 64 + 4);
  o.k0 = *(const f32x4*)(p + 3 * TC * 64);   o.k1 = *(const f32x4*)(p + 3 * TC * 64 + 4);
  o.r0 = *(const f32x4*)(p + 4 * TC * 64);   o.r1 = *(const f32x4*)(p + 4 * TC * 64 + 4);
  o.v = *(const f32x2*)(ob + 5 * TC * 64 + s * 64 + row0);
  return o;
}

DI f32x2 lo2(f32x4 x) { return f32x2{x[0], x[1]}; }
DI f32x2 hi2(f32x4 x) { return f32x2{x[2], x[3]}; }

DI f32x2 scan_step(f32x2 (&st)[2][4], const ScanOps& o) {
  const f32x2 a[4] = {lo2(o.a0), hi2(o.a0), lo2(o.a1), hi2(o.a1)};
  const f32x2 bv[4] = {lo2(o.b0), hi2(o.b0), lo2(o.b1), hi2(o.b1)};
  const f32x2 kv[4] = {lo2(o.k0), hi2(o.k0), lo2(o.k1), hi2(o.k1)};
  const f32x2 rv[4] = {lo2(o.r0), hi2(o.r0), lo2(o.r1), hi2(o.r1)};
  f32x2 y;
#pragma unroll
  for (int rr = 0; rr < 2; ++rr) {
    f32x2 p = st[rr][0] * a[0];
    p = st[rr][1] * a[1] + p; p = st[rr][2] * a[2] + p; p = st[rr][3] * a[3] + p;
    const float sa = red8(p[0] + p[1]);
    const f32x2 sa2 = {sa, sa};
    const f32x2 v2 = {o.v[rr], o.v[rr]};
    f32x2 q = {0.f, 0.f};
#pragma unroll
    for (int j = 0; j < 4; ++j) {
      f32x2 x = sa2 * bv[j] + st[rr][j];
      x = v2 * kv[j] + x;
      st[rr][j] = x;
      q = x * rv[j] + q;
    }
    y[rr] = red8(q[0] + q[1]);
  }
  return y;
}

DI void scan_task(const Params& P, int L_, const Group& G, int task, char* lds) {
  const int L = opqs(__builtin_amdgcn_readfirstlane(L_));
  const int tid = opq(threadIdx.x), lane = tid & 63, w = tid >> 6;
  const int dir = task & 1, b = task >> 4, hd = (task >> 1) & 7;
  const int S = G.S, nc = S / TC;
  const int sg = dir ? -1 : 1;
  const bf16_t* crb = P.CR + (size_t)b * S * CRW;

  const int srow0 = (w & 3) * 16 + (lane >> 3) * 2, scs = lane & 7;
  f32x2 st[2][4];
#pragma unroll
  for (int rr = 0; rr < 2; ++rr)
#pragma unroll
    for (int j = 0; j < 4; ++j) st[rr][j] = f32x2{0.f, 0.f};

  const int pw = w & 3, ec = lane, hh = lane >> 5, r = lane & 31;
  char* pwb = lds + PW_BASE + pw * PW_BYTES;
  const int ch = hd * 64 + ec;
  const float c_kk = P.k_k[L * 512 + ch], c_ka = P.k_a[L * 512 + ch], c_rk = P.r_k[L * 512 + ch];
  const float* cw = P.conv_w + (size_t)L * 3 * 1728;
  const float* cb = P.conv_b + (size_t)L * 1728;
  const bf16_t* wsrcW = P.WUPT + (size_t)(L * 2 + dir) * 512 * 64 + (size_t)(hd * 64 + r) * 64 + hh * 8;
  const bf16_t* wsrcA = P.AUPT + (size_t)L * 512 * 64 + (size_t)(hd * 64 + r) * 64 + hh * 8;
  const float* w0p = P.w0 + (size_t)(L * 2 + dir) * 512 + hd * 64 + r;
  const float* a0p = P.a0 + (size_t)L * 512 + hd * 64 + r;

  auto prepare = [&](int cc, char* cbuf) {
    float* oW = (float*)cbuf; float* oA = (float*)(cbuf + CB_OP); float* oB = (float*)(cbuf + 2 * CB_OP);
    float* oK = (float*)(cbuf + 3 * CB_OP); float* oR = (float*)(cbuf + 4 * CB_OP); float* oV = (float*)(cbuf + 5 * CB_OP);
    float* oBon = (float*)(cbuf + 6 * CB_OP);
    const int ln = opq(lane);
    const int tbase = dir ? S - cc * TC - 8 * pw - 9 : cc * TC + 8 * pw - 1;
    {
      u32x4 rv[7];
#pragma unroll
      for (int it = 0; it < 7; ++it) {
        int id = ln + it * 64;
        id = id < 400 ? id : 399;
        const int rr = id / 40, cc8 = id % 40, q = cc8 >> 3, c8 = (cc8 & 7) * 8;
        const int tok = tbase + rr;
        const bool ok = tok >= 0 && tok < S;
        const int tokc = tok < 0 ? 0 : (tok >= S ? S - 1 : tok);
        const int col = (q == 0 ? hd * 64 : q == 1 ? 512 + hd * 64 : q == 2 ? 1024 + hd * 64 : q == 3 ? 1536 + dir * 64 : 1664) + c8;
        const u32x4 v = *(const u32x4*)(crb + (size_t)tokc * CRW + col);
        const u32x4 z = {0u, 0u, 0u, 0u};
        rv[it] = ok ? v : z;
      }
#pragma unroll
      for (int it = 0; it < 7; ++it) {
        int id = ln + it * 64;
        id = id < 400 ? id : 399;
        *(u32x4*)(pwb + (id / 40) * 640 + (id % 40) * 16) = rv[it];
      }
    }
    asm volatile("" ::: "memory");
    float cwp[5], cwc[5], cwn[5], cbb[5];
#pragma unroll
    for (int q = 0; q < 5; ++q) {
      const int cqq = (q == 0 ? hd * 64 : q == 1 ? 512 + hd * 64 : q == 2 ? 1024 + hd * 64 : q == 3 ? 1536 + dir * 64 : 1664) + ln;
      const float w0 = cw[cqq], w1 = cw[1728 + cqq], w2 = cw[2 * 1728 + cqq];
      cwp[q] = dir ? w2 : w0; cwc[q] = w1; cwn[q] = dir ? w0 : w2; cbb[q] = cb[cqq];
    }
    bf16x8 lf[2][2][4];
#pragma unroll
    for (int nb = 0; nb < 2; ++nb)
#pragma unroll
      for (int ks = 0; ks < 4; ++ks) {
        lf[0][nb][ks] = *(const bf16x8*)(wsrcW + nb * 32 * 64 + ks * 16);
        lf[1][nb][ks] = *(const bf16x8*)(wsrcA + nb * 32 * 64 + ks * 16);
      }
    const bf16_t* raw = (const bf16_t*)pwb;
    bf16_t* zt = (bf16_t*)(pwb + 6400); bf16_t* za = (bf16_t*)(pwb + 6400 + 8 * 144);
    float kreg[8];
#pragma unroll
    for (int hf = 0; hf < 2; ++hf) {
      float xr[6][5];
#pragma unroll
      for (int j = 0; j < 6; ++j) {
        const int vi = hf * 4 + j - 1;
        const int jj = dir ? 8 - vi : vi + 1;
#pragma unroll
        for (int q = 0; q < 5; ++q) xr[j][q] = bf2f(raw[jj * 320 + q * 64 + ln]);
      }
#pragma unroll
      for (int i = 0; i < 4; ++i) {
        float v[5];
#pragma unroll
        for (int q = 0; q < 5; ++q) v[q] = cbb[q] + cwp[q] * xr[i][q] + cwc[q] * xr[i + 1][q] + cwn[q] * xr[i + 2][q];
        const int ti = hf * 4 + i, s = 8 * pw + ti;
        oR[s * 64 + ln] = v[0];
        kreg[ti] = v[1];
        oV[s * 64 + ln] = v[2];
        zt[ti * 72 + ln] = f2bf(tanhf_(v[3]));
        za[ti * 72 + ln] = f2bf(v[4]);
      }
    }
    asm volatile("" ::: "memory");
    {
      const char* az = (const char*)zt + (r & 7) * 144 + hh * 16;
      const char* aa = (const char*)za + (r & 7) * 144 + hh * 16;
#pragma unroll
      for (int nb = 0; nb < 2; ++nb) {
        f32x16 accw, acca;
#pragma unroll
        for (int i = 0; i < 16; ++i) { accw[i] = 0.f; acca[i] = 0.f; }
#pragma unroll
        for (int ks = 0; ks < 4; ++ks) {
          const bf16x8 fz = *(const bf16x8*)(az + ks * 32);
          const bf16x8 fa = *(const bf16x8*)(aa + ks * 32);
          accw = MFMA(fz, lf[0][nb][ks], accw);
          acca = MFMA(fa, lf[1][nb][ks], acca);
        }
        const float w0v = w0p[nb * 32], a0v = a0p[nb * 32];
#pragma unroll
        for (int i = 0; i < 4; ++i) {
          const int s = 8 * pw + 4 * hh + i;
          oW[s * 64 + nb * 32 + r] = __expf(-0.6065306597126334f * sigmoidf_(w0v + accw[i]));
          oA[s * 64 + nb * 32 + r] = sigmoidf_(a0v + acca[i]);
        }
      }
    }
    asm volatile("" ::: "memory");
    {
      float ag[8], kk[8], ss[8], km[8], bn[8];
#pragma unroll
      for (int i = 0; i < 8; ++i) {
        const int s = 8 * pw + i;
        ag[i] = oA[s * 64 + ln];
        kk[i] = kreg[i] * c_kk;
        ss[i] = kk[i] * kk[i];
        km[i] = kreg[i] * (1.f + (ag[i] - 1.f) * c_ka);
        bn[i] = oR[s * 64 + ln] * km[i] * c_rk;
      }
      red64v<8>(ss);
      red64v<8>(bn);
      float g = 1.f;
#pragma unroll
      for (int i = 0; i < 8; ++i) {
        const int s = 8 * pw + i;
        const float kn = kk[i] * rsqrtf(ss[i] + 1e-12f);
        const float gprev = g;
        g *= oW[s * 64 + ln];
        const float ginv = __builtin_amdgcn_rcpf(g);
        oK[s * 64 + ln] = km[i] * ginv;
        oA[s * 64 + ln] = -kn * gprev;
        oB[s * 64 + ln] = kn * ag[i] * ginv;
        oR[s * 64 + ln] = oR[s * 64 + ln] * g;
        if (ln == 0) oBon[s] = bn[i];
      }
      ((float*)(cbuf + 6 * CB_OP + 128))[pw * 64 + ln] = g;
    }
  };

  __syncthreads();
  if (w >= 4) prepare(0, lds);
  __syncthreads();
  if (__builtin_amdgcn_readfirstlane(w) < 4) __builtin_amdgcn_s_setprio(2);

  for (int c = 0; c < nc; ++c) {
    char* cbuf = lds + (c & 1) * CB_BYTES;
    if (w < 4) {
      const float* sb = (const float*)cbuf;
      const float* oBon = (const float*)(cbuf + 6 * CB_OP);
      ScanOps cur = scan_load(sb, 0, scs * 8, srow0);
#pragma unroll 1
      for (int s8 = 0; s8 < TC; s8 += 8) {
        f32x2 ykeep = {0.f, 0.f};
#pragma unroll
        for (int u = 0; u < 8; ++u) {
          const int s = s8 + u;
          const ScanOps nxt = scan_load(sb, s + 1 < TC ? s + 1 : s, scs * 8, srow0);
          const f32x2 y = scan_step(st, cur);
          if (u == scs) ykeep = y;
          cur = nxt;
        }
        {
          const float* g8 = (const float*)(cbuf + 6 * CB_OP + 128) + (s8 >> 3) * 64 + scs * 8;
          const f32x4 ga = *(const f32x4*)g8, gb = *(const f32x4*)(g8 + 4);
          const f32x2 gg[4] = {lo2(ga), hi2(ga), lo2(gb), hi2(gb)};
#pragma unroll
          for (int rr = 0; rr < 2; ++rr)
#pragma unroll
            for (int j = 0; j < 4; ++j) st[rr][j] = st[rr][j] * gg[j];
        }
        const int s = s8 + scs;
        const int ts = dir ? S - 1 - (c * TC + s) : c * TC + s;
        const size_t lt = (size_t)b * S + ts;
        const unsigned yv = pack2(ykeep[0], ykeep[1]);
        if (dir == 0) {
          *(unsigned*)(P.X + ((size_t)G.tok0 + lt) * DM + hd * 64 + srow0) = yv;
          const float bon = oBon[s];
          const f32x2 vv = *(const f32x2*)(sb + 5 * TC * 64 + s * 64 + srow0);
          *(unsigned*)(P.BV + lt * 512 + hd * 64 + srow0) = pack2(bon * vv[0], bon * vv[1]);
        } else {
          *(unsigned*)(P.YB + lt * 512 + hd * 64 + srow0) = yv;
        }
      }
    } else if (c + 1 < nc) {
      prepare(c + 1, lds + ((c + 1) & 1) * CB_BYTES);
    }
    __syncthreads();
  }
  __builtin_amdgcn_s_setprio(0);
}

DI void phase_rwkv_final(const Params& P, int L, const Group& G) {
  const int tidp = opq(threadIdx.x);
  const int lane = tidp & 63;
  const int gw = blockIdx.x * (NTHREADS / 64) + (tidp >> 6), nw = gridDim.x * (NTHREADS / 64);
  const f32x4 g0 = *(const f32x4*)(P.ln_g + L * 512 + lane * 8), g1 = *(const f32x4*)(P.ln_g + L * 512 + lane * 8 + 4);
  const f32x4 b0 = *(const f32x4*)(P.ln_b + L * 512 + lane * 8), b1 = *(const f32x4*)(P.ln_b + L * 512 + lane * 8 + 4);
  const float lg[8] = {g0[0], g0[1], g0[2], g0[3], g1[0], g1[1], g1[2], g1[3]};
  const float lb[8] = {b0[0], b0[1], b0[2], b0[3], b1[0], b1[1], b1[2], b1[3]};
  for (int lt = gw; lt < G.ntok; lt += nw) {
    bf16_t* xp = P.X + ((size_t)G.tok0 + lt) * DM + lane * 8;
    const u32x4 yf = *(const u32x4*)xp;
    const u32x4 yb = *(const u32x4*)(P.YB + (size_t)lt * 512 + lane * 8);
    const u32x4 bv = *(const u32x4*)(P.BV + (size_t)lt * 512 + lane * 8);
    const u32x4 gt = *(const u32x4*)(P.GRW + (size_t)lt * 512 + lane * 8);
    float y[8];
    float sum = 0.f;
#pragma unroll
    for (int j = 0; j < 4; ++j) {
      y[2 * j] = bflo(yf[j]) + bflo(yb[j]); y[2 * j + 1] = bfhi(yf[j]) + bfhi(yb[j]);
      sum += y[2 * j] + y[2 * j + 1];
    }
    const float mu = red8(sum) * (1.f / 64.f);
    float vs = 0.f;
#pragma unroll
    for (int j = 0; j < 8; ++j) { y[j] -= mu; vs += y[j] * y[j]; }
    const float rstd = rsqrtf(red8(vs) * (1.f / 64.f) + 64e-5f);
    u32x4 o;
#pragma unroll
    for (int j = 0; j < 4; ++j) {
      const float o0 = (y[2 * j] * rstd * lg[2 * j] + lb[2 * j] + bflo(bv[j])) * bflo(gt[j]);
      const float o1 = (y[2 * j + 1] * rstd * lg[2 * j + 1] + lb[2 * j + 1] + bfhi(bv[j])) * bfhi(gt[j]);
      o[j] = pack2(o0, o1);
    }
    *(u32x4*)xp = o;
  }
}

constexpr int AT_K = 64 * GSTR;
constexpr int AT_STAGE = 2 * AT_K + 128 * GSTR;

DI void attn_item(const Params& P, int L_, const Group& G, int item, char* lds) {
  const int L = opqs(__builtin_amdgcn_readfirstlane(L_));
  const int tid = opq(threadIdx.x), lane = tid & 63, w = tid >> 6, hh = lane >> 5, r = lane & 31;
  const int S = G.S, nqb = S >> 7;
  const int qblk = item % nqb, bh = item / nqb, hd = bh & 3, b = bh >> 2;
  const int map = w & 1, qb = w >> 1;
  const int q0 = qblk * 128 + qb * 32;
  const size_t ltq = (size_t)b * S + q0 + r;
  bf16x8 qf[4];
  {
    const bf16_t* qp = P.Q + ltq * 512 + hd * 128 + map * 64 + hh * 8;
#pragma unroll
    for (int ks = 0; ks < 4; ++ks) qf[ks] = *(const bf16x8*)(qp + ks * 16);
  }
  f32x16 o[4];
#pragma unroll
  for (int d = 0; d < 4; ++d)
#pragma unroll
    for (int i = 0; i < 16; ++i) o[d][i] = 0.f;
  f32x16 accl;
#pragma unroll
  for (int i = 0; i < 16; ++i) accl[i] = 0.f;
  const float slope2 = exp2f(-2.f * (float)(hd + 1)) * LOG2E;
  float so[16];
#pragma unroll
  for (int i = 0; i < 16; ++i) so[i] = slope2 * (float)(16 * (i >> 3) + (i & 7));
  bf16x8 ones;
#pragma unroll
  for (int j = 0; j < 8; ++j) ones[j] = (short)0x3F80;
  const float lam = P.consts[L * 4 + 0], C2 = P.consts[L * 4 + 1], lam_init = P.consts[L * 4 + 2];
  const float qposf = (float)(q0 + r);
  const int Dz = (int)ceilf(150.f / slope2);
  const int Q0 = qblk * 128;
  const int tlo = (Q0 - 63 - Dz) < 0 ? 0 : (Q0 - 63 - Dz) / 64 + 1;
  const int thx = min(S >> 6, (Q0 + 127 + Dz + 63) / 64);
  const int nt = thx - tlo;
  const int lrow = tid >> 3, lck = tid & 7;
  const bf16_t* k0p = P.KB + ((size_t)b * S + tlo * 64 + lrow) * 512 + hd * 128 + lck * 8;
  const bf16_t* v0p = P.VT + ((size_t)((b * 4 + hd) * 128 + lrow)) * S + tlo * 64 + lck * 8;
  u32x4 ra0, ra1, ra2, ra3, rb0, rb1, rb2, rb3;
  auto ldtile = [&](int tt, u32x4& x0, u32x4& x1, u32x4& x2, u32x4& x3) {
    const int tc = tt < nt ? tt : nt - 1;
    x0 = *(const u32x4*)(k0p + (size_t)tc * 64 * 512); x1 = *(const u32x4*)(k0p + (size_t)tc * 64 * 512 + 64);
    x2 = *(const u32x4*)(v0p + tc * 64); x3 = *(const u32x4*)(v0p + (size_t)64 * S + tc * 64);
  };
  auto sttile = [&](int slot, const u32x4& x0, const u32x4& x1, const u32x4& x2, const u32x4& x3) {
    char* d = lds + slot * AT_STAGE;
    *(u32x4*)(d + lrow * GSTR + lck * 16) = x0;
    *(u32x4*)(d + AT_K + lrow * GSTR + lck * 16) = x1;
    *(u32x4*)(d + 2 * AT_K + lrow * GSTR + lck * 16) = x2;
    *(u32x4*)(d + 2 * AT_K + (lrow + 64) * GSTR + lck * 16) = x3;
  };
  ldtile(0, ra0, ra1, ra2, ra3);
  ldtile(1, rb0, rb1, rb2, rb3);
  __syncthreads();
  sttile(0, ra0, ra1, ra2, ra3);
  ldtile(2, ra0, ra1, ra2, ra3);
  __syncthreads();
  const int krow = (r & ~12) | ((r & 4) << 1) | ((r & 8) >> 1);
  auto compute = [&](int t) {
    const char* kbuf = lds + (t & 1) * AT_STAGE + map * AT_K;
    const char* vbuf = lds + (t & 1) * AT_STAGE + 2 * AT_K;
    f32x16 s0, s1;
    const int kt0 = (tlo + t) * 64;
    const float base = (float)(kt0 + 8 * hh) - qposf;
    if (kt0 + 63 < q0) {
      const float bl = fmaf(slope2, base, -C2), bl2 = bl + 32.f * slope2;
#pragma unroll
      for (int i = 0; i < 16; ++i) { s0[i] = bl + so[i]; s1[i] = bl2 + so[i]; }
    } else if (kt0 > q0 + 31) {
      const float br = fmaf(-slope2, base, -C2), br2 = br - 32.f * slope2;
#pragma unroll
      for (int i = 0; i < 16; ++i) { s0[i] = br - so[i]; s1[i] = br2 - so[i]; }
    } else {
#pragma unroll
      for (int i = 0; i < 16; ++i) {
        const float d0 = base + (float)(16 * (i >> 3) + (i & 7));
        s0[i] = fmaf(fabsf(d0), -slope2, -C2);
        s1[i] = fmaf(fabsf(d0 + 32.f), -slope2, -C2);
      }
    }
    __builtin_amdgcn_s_setprio(1);
#pragma unroll
    for (int ks = 0; ks < 4; ++ks) {
      const bf16x8 a0 = *(const bf16x8*)(kbuf + krow * GSTR + ks * 32 + hh * 16);
      const bf16x8 a1 = *(const bf16x8*)(kbuf + (32 + krow) * GSTR + ks * 32 + hh * 16);
      s0 = MFMA(a0, qf[ks], s0);
      s1 = MFMA(a1, qf[ks], s1);
    }
    __builtin_amdgcn_s_setprio(0);
    bf16x8 pf[4];
    {
      u32x4 pk[4];
#pragma unroll
      for (int i = 0; i < 16; i += 2) {
        const float e0 = __builtin_amdgcn_exp2f(s0[i]), e1 = __builtin_amdgcn_exp2f(s0[i + 1]);
        const float e2 = __builtin_amdgcn_exp2f(s1[i]), e3 = __builtin_amdgcn_exp2f(s1[i + 1]);
        pk[i >> 3][(i & 7) >> 1] = pack2(e0, e1);
        pk[2 + (i >> 3)][(i & 7) >> 1] = pack2(e2, e3);
      }
#pragma unroll
      for (int j = 0; j < 4; ++j) pf[j] = __builtin_bit_cast(bf16x8, pk[j]);
    }
    __builtin_amdgcn_s_setprio(1);
#pragma unroll
    for (int j = 0; j < 4; ++j) accl = MFMA(ones, pf[j], accl);
#pragma unroll
    for (int dvb = 0; dvb < 4; ++dvb)
#pragma unroll
      for (int j = 0; j < 4; ++j) {
        const bf16x8 va = *(const bf16x8*)(vbuf + (dvb * 32 + r) * GSTR + (16 * j + 8 * hh) * 2);
        o[dvb] = MFMA(va, pf[j], o[dvb]);
      }
    __builtin_amdgcn_s_setprio(0);
  };
  for (int t = 0; t < nt; t += 2) {
    compute(t);
    sttile(1, rb0, rb1, rb2, rb3);
    __builtin_amdgcn_sched_barrier(0);
    ldtile(t + 3, rb0, rb1, rb2, rb3);
    __builtin_amdgcn_sched_barrier(0);
    __syncthreads();
    if (t + 1 >= nt) break;
    compute(t + 1);
    sttile(0, ra0, ra1, ra2, ra3);
    __builtin_amdgcn_sched_barrier(0);
    ldtile(t + 4, ra0, ra1, ra2, ra3);
    __builtin_amdgcn_sched_barrier(0);
    __syncthreads();
  }
  const float linv = 1.f / accl[0];
  float* comb = (float*)lds;
  if (map == 1) {
#pragma unroll
    for (int dvb = 0; dvb < 4; ++dvb)
#pragma unroll
      for (int i = 0; i < 16; ++i) comb[(qb * 64 + dvb * 16 + i) * 64 + lane] = o[dvb][i] * linv;
  }
  __syncthreads();
  if (map == 0) {
    float ss = 0.f;
#pragma unroll
    for (int dvb = 0; dvb < 4; ++dvb)
#pragma unroll
      for (int i = 0; i < 16; ++i) {
        const float v = o[dvb][i] * linv - lam * comb[(qb * 64 + dvb * 16 + i) * 64 + lane];
        o[dvb][i] = v; ss += v * v;
      }
    ss += __shfl_xor(ss, 32);
    const float sc = rsqrtf(ss * (1.f / 128.f) + 1e-6f) * (1.f - lam_init);
    const bf16_t* gp = P.GDA + ltq * 512 + hd * 128;
    bf16_t* yp = P.X + ((size_t)G.tok0 + ltq) * DM + 512 + hd * 128;
    const float* sl = P.subln + L * 128;
#pragma unroll
    for (int dvb = 0; dvb < 4; ++dvb)
#pragma unroll
      for (int q4 = 0; q4 < 4; ++q4) {
        const int dv = dvb * 32 + 8 * q4 + 4 * hh;
        const u32x2 g = *(const u32x2*)(gp + dv);
        const f32x4 s4 = *(const f32x4*)(sl + dv);
        u32x2 ov = {pack2(o[dvb][4 * q4] * sc * s4[0] * bflo(g[0]), o[dvb][4 * q4 + 1] * sc * s4[1] * bfhi(g[0])),
                    pack2(o[dvb][4 * q4 + 2] * sc * s4[2] * bflo(g[1]), o[dvb][4 * q4 + 3] * sc * s4[3] * bfhi(g[1]))};
        *(u32x2*)(yp + dv) = ov;
      }
  }
}

DI void phase_mixers(const Params& P, int L, const Group& G, int* ctr, char* lds, int* s_item, int mode = 0) {
  const int nscan = mode == 2 ? 0 : G.B * 16;
  const int nattn = mode == 1 ? 0 : G.B * 4 * (G.S >> 7);
  const int total = nscan + nattn;
  for (;;) {
    __syncthreads();
    if (threadIdx.x == 0) *s_item = atomicAdd(ctr, 1);
    __syncthreads();
    const int it = *s_item;
    if (it >= total) break;
    if (it < nscan) scan_task(P, L, G, it, lds);
    else attn_item(P, L, G, it - nscan, lds);
  }
}

__global__ void __launch_bounds__(NTHREADS) fwd_megakernel(Params P) {
  __shared__ __attribute__((aligned(16))) char lds[LDS_BYTES];
  __shared__ int s_item;
  cg::grid_group grid = cg::this_grid();
  phase_weights(P, lds);
  for (int ph = 0; ph < 18; ++ph) {
    const int L = ph / 9, k = ph % 9;
    const int g = (k >= 4 && k <= 6) ? 1 : 0;
    Group G;
    G.tok0 = g ? NP : 0; G.B = g ? 8 : 16; G.S = g ? 8192 : 2048; G.ntok = g ? NS : NP;
#ifdef PROBE_SCAN
    if (k == 2 || k == 5) { phase_mixers(P, L, G, P.ctr + 64 + (L * 2 + g) * 16, lds, &s_item, 1); grid.sync(); }
#endif
#ifdef PROBE_ATTN
    if (k == 2 || k == 5) { phase_mixers(P, L, G, P.ctr + 128 + (L * 2 + g) * 16, lds, &s_item, 2); grid.sync(); }
#endif
#ifdef PROBE_INPROJ
    if (k == 1 || k == 4) { phase_inproj(P, L, G, lds); grid.sync(); }
#endif
    if (k == 0) phase_prep(P, L);
    else if (k == 1 || k == 4) phase_inproj(P, L, G, lds);
    else if (k == 2 || k == 5) phase_mixers(P, L, G, P.ctr + (L * 2 + g) * 16, lds, &s_item);
    else if (k == 3 || k == 6) phase_rwkv_final(P, L, G);
    else if (k == 7) phase_outproj(P, L, lds);
    else phase_gate(P, L, lds);
    grid.sync();
  }
}

extern "C" void kernel_launch(void* const* d_in, const int* in_sizes, int n_in, void* d_out, int out_size, void* d_ws,
                              size_t ws_size, hipStream_t stream) {
  Params P{};
  const float* const* in = (const float* const*)d_in;
  P.x_prompt = in[0]; P.x_sample = in[1]; P.p_prompt = in[2]; P.p_sample = in[3];
  P.norm_pre = in[4]; P.w_in = in[5]; P.w_out = in[6]; P.conv_w = in[7]; P.conv_b = in[8];
  P.w0 = in[9]; P.w_up = in[10]; P.a0 = in[11]; P.a_up = in[12]; P.k_k = in[13]; P.k_a = in[14];
  P.r_k = in[15]; P.ln_g = in[16]; P.ln_b = in[17]; P.q_norm = in[18]; P.k_norm = in[19];
  P.lam_vec = in[20]; P.subln = in[21]; P.ple_proj = in[22]; P.ple_norm = in[23];
  P.gate_w = in[24]; P.gate_b = in[25];
  P.out = (float*)d_out;
  char* ws = (char*)d_ws;
  size_t off = 0;
  auto take = [&](size_t bytes) { char* p = ws + off; off += (bytes + 255) & ~(size_t)255; return p; };
  P.ctr = (int*)take(1024);
  P.consts = (float*)take(1024);
  P.X = (bf16_t*)take((size_t)NTOK * DM * 2);
  P.PB = (bf16_t*)take((size_t)NTOK * DPLE * 2);
  P.RS = (float*)take((size_t)NTOK * 4);
  P.WIN = (bf16_t*)take((size_t)2 * NIN * DM * 2);
  P.WOUT = (bf16_t*)take((size_t)2 * DM * DM * 2);
  P.WPLE = (bf16_t*)take((size_t)2 * DM * DPLE * 2);
  P.WGATE = (bf16_t*)take((size_t)2 * DM * DM * 2);
  P.WUPT = (bf16_t*)take((size_t)4 * 512 * 64 * 2);
  P.AUPT = (bf16_t*)take((size_t)2 * 512 * 64 * 2);
  P.CR = (bf16_t*)take((size_t)GS * CRW * 2);
  P.GRW = (bf16_t*)take((size_t)GS * 512 * 2);
  P.Q = (bf16_t*)take((size_t)GS * 512 * 2);
  P.KB = (bf16_t*)take((size_t)GS * 512 * 2);
  P.VT = (bf16_t*)take((size_t)GS * 512 * 2);
  P.GDA = (bf16_t*)take((size_t)GS * 512 * 2);
  P.YB = (bf16_t*)take((size_t)GS * 512 * 2);
  P.BV = (bf16_t*)take((size_t)GS * 512 * 2);
  P.R1 = P.CR;
  P.R2 = P.GRW;
  P.EPART = (float*)P.VT;
  if (off > ws_size) { fprintf(stderr, "workspace too small: need %zu have %zu\n", off, ws_size); return; }
  hipMemsetAsync(P.ctr, 0, 1024, stream);
  static int grid_blocks = 0;
  if (!grid_blocks) {
    int dev = 0, cus = 0, per_cu = 0;
    hipGetDevice(&dev);
    hipDeviceGetAttribute(&cus, hipDeviceAttributeMultiprocessorCount, dev);
    hipOccupancyMaxActiveBlocksPerMultiprocessor(&per_cu, fwd_megakernel, NTHREADS, 0);
    if (per_cu < 1) { fprintf(stderr, "occupancy query returned %d\n", per_cu); per_cu = 1; }
    grid_blocks = 256;
    if (cus < 256) fprintf(stderr, "unexpected CU count %d\n", cus);
  }
  void* args[] = {&P};
  hipError_t e = hipLaunchCooperativeKernel((void*)fwd_megakernel, dim3(grid_blocks), dim3(NTHREADS), args, 0, stream);
  if (e != hipSuccess) fprintf(stderr, "cooperative launch failed: %s (grid %d)\n", hipGetErrorString(e), grid_blocks);
}
```
